# Optimizing an MI355X kernel written in HIP

```python
import jax, jax.numpy as jnp
from jax import lax
import numpy as np

D_MODEL = 1024
BATCH = 4
SEQ = 8192
DEPTH = 2

N_MIXERS = 2
N_ATT_LAYERS = (DEPTH + 1) // 2
N_HGRN_LAYERS = DEPTH // 2
FOX_HEADS = 16
FOX_HEAD_DIM = D_MODEL // FOX_HEADS
FOX_Q_BLOCK = 128
HGRN_EXPAND = 128
HGRN_HEADS = D_MODEL // HGRN_EXPAND
HGRN_DK = HGRN_EXPAND
HGRN_DV = D_MODEL // HGRN_HEADS
HGRN_CHUNK = 64
FFN_DIM = 2816
CONV_WIDTH = 3
RMS_EPS = 1e-6

kernel_name = "fox_hgrn2_convffn_hybrid"


def rmsnorm(x, g):
    x32 = x.astype(jnp.float32)
    y = x32 * lax.rsqrt(jnp.mean(x32 * x32, axis=-1, keepdims=True) + RMS_EPS)
    return (y * g.astype(jnp.float32)).astype(x.dtype)


def fox_mixer(h, w_in, b_f, w_out):
    B, S, D = h.shape
    H, hd, QB = FOX_HEADS, FOX_HEAD_DIM, FOX_Q_BLOCK
    nqb = S // QB
    proj = h @ w_in
    q, k, v, fl = jnp.split(proj, [D, 2 * D, 3 * D], axis=-1)
    logf = jax.nn.log_sigmoid((fl + b_f).astype(jnp.float32))
    c = jnp.cumsum(logf, axis=1).transpose(0, 2, 1)
    qb = q.reshape(B, nqb, QB, H, hd).transpose(1, 0, 3, 2, 4)
    k = k.reshape(B, S, H, hd).transpose(0, 2, 1, 3)
    v = v.reshape(B, S, H, hd).transpose(0, 2, 1, 3)
    cqb = c.reshape(B, H, nqb, QB).transpose(2, 0, 1, 3)
    starts = jnp.arange(nqb, dtype=jnp.int32) * QB
    s_pos = jnp.arange(S, dtype=jnp.int32)
    scale = 1.0 / np.sqrt(hd)

    def block(args):
        qi, cqi, st = args
        logits = jnp.einsum('bhqd,bhkd->bhqk', qi, k).astype(jnp.float32) * scale
        logits = logits + (cqi[..., :, None] - c[:, :, None, :])
        t_pos = st + jnp.arange(QB, dtype=jnp.int32)
        logits = jnp.where(s_pos[None, :] <= t_pos[:, None], logits, -jnp.inf)
        p = jax.nn.softmax(logits, axis=-1)
        return jnp.einsum('bhqk,bhkd->bhqd', p.astype(v.dtype), v)

    o = lax.map(block, (qb, cqb, starts))
    o = o.transpose(1, 0, 3, 2, 4).reshape(B, S, D)
    return o @ w_out


def hgrn2_mixer(h, w_in, lb, onorm_g, w_out):
    B, S, D = h.shape
    H, Dk, Dv, C = HGRN_HEADS, HGRN_DK, HGRN_DV, HGRN_CHUNK
    nc = S // C
    proj = h @ w_in
    q, fl, i, g = jnp.split(proj, 4, axis=-1)
    q = jax.nn.silu(q).astype(jnp.float32)
    f = lb + (1.0 - lb) * jax.nn.sigmoid(fl.astype(jnp.float32))
    k = 1.0 - f
    logf = jnp.log(f)

    def to_chunks(t, d):
        return t.reshape(B, nc, C, H, d).transpose(0, 3, 1, 2, 4)

    q, k, logf = to_chunks(q, Dk), to_chunks(k, Dk), to_chunks(logf, Dk)
    iv = to_chunks(i.astype(jnp.float32), Dv)
    b = jnp.cumsum(logf, axis=3)
    b_last = b[..., -1:, :]
    q_dec = q * jnp.exp(b)
    k_inv = k * jnp.exp(-b)
    k_state = k * jnp.exp(b_last - b)
    A = jnp.einsum('bhncd,bhnsd->bhncs', q_dec, k_inv)
    causal = jnp.tril(jnp.ones((C, C), dtype=bool))
    A = jnp.where(causal, A, 0.0)
    o_intra = jnp.einsum('bhncs,bhnsv->bhncv', A, iv)
    U = jnp.einsum('bhnsd,bhnsv->bhndv', k_state, iv)
    decay = jnp.exp(b_last[..., 0, :])

    def step(state, xs):
        dec, u = xs
        return dec[..., None] * state + u, state

    s0 = jnp.zeros((B, H, Dk, Dv), jnp.float32)
    _, s_prev = lax.scan(step, s0, (jnp.moveaxis(decay, 2, 0), jnp.moveaxis(U, 2, 0)))
    s_prev = jnp.moveaxis(s_prev, 0, 2)
    o = o_intra + jnp.einsum('bhncd,bhndv->bhncv', q_dec, s_prev)
    o = o.transpose(0, 2, 3, 1, 4).reshape(B, S, H, Dv)
    o = o * lax.rsqrt(jnp.mean(o * o, axis=-1, keepdims=True) + RMS_EPS)
    o = o * onorm_g.astype(jnp.float32).reshape(H, Dv)
    o = o.reshape(B, S, D).astype(h.dtype) * jax.nn.silu(g)
    return o @ w_out


def conv_ffn(h, w_up, conv_w, conv_b, w_down):
    S = h.shape[1]
    u = h @ w_up
    up = jnp.pad(u, ((0, 0), (CONV_WIDTH - 1, 0), (0, 0)))
    y = conv_b
    for j in range(CONV_WIDTH):
        y = y + conv_w[j] * up[:, j:j + S]
    gate, val = jnp.split(y, 2, axis=-1)
    return (jax.nn.silu(gate) * val) @ w_down


def setup_inputs(seed: int = 0) -> dict:
    key = jax.random.key(seed)
    ks = jax.random.split(key, 16)
    D, F = D_MODEL, FFN_DIM
    nrm = lambda k, shape, s: jax.random.normal(k, shape, jnp.float32) * s
    return {
        "x": nrm(ks[0], (BATCH, SEQ, D), 1.0),
        "att_norm_g": 1.0 + nrm(ks[1], (N_ATT_LAYERS, D), 0.02),
        "att_w_in": nrm(ks[2], (N_ATT_LAYERS, D, 3 * D + FOX_HEADS), D ** -0.5),
        "att_b_f": 3.0 + nrm(ks[3], (N_ATT_LAYERS, FOX_HEADS), 0.5),
        "att_w_out": nrm(ks[4], (N_ATT_LAYERS, D, D), D ** -0.5),
        "hgrn_norm_g": 1.0 + nrm(ks[5], (N_HGRN_LAYERS, D), 0.02),
        "hgrn_w_in": nrm(ks[6], (N_HGRN_LAYERS, D, 4 * D), D ** -0.5),
        "hgrn_lb_logits": nrm(ks[7], (DEPTH, D), 0.1),
        "hgrn_onorm_g": 1.0 + nrm(ks[8], (N_HGRN_LAYERS, D), 0.02),
        "hgrn_w_out": nrm(ks[9], (N_HGRN_LAYERS, D, D), D ** -0.5),
        "ffn_norm_g": 1.0 + nrm(ks[10], (DEPTH, D), 0.02),
        "ffn_w_up": nrm(ks[11], (DEPTH, D, 2 * F), D ** -0.5),
        "ffn_conv_w": nrm(ks[12], (DEPTH, CONV_WIDTH, 2 * F), CONV_WIDTH ** -0.5),
        "ffn_conv_b": nrm(ks[13], (DEPTH, 2 * F), 0.02),
        "ffn_w_down": nrm(ks[14], (DEPTH, F, D), F ** -0.5),
        "final_norm_g": 1.0 + nrm(ks[15], (D,), 0.02),
    }


def reference(x, att_norm_g, att_w_in, att_b_f, att_w_out, hgrn_norm_g, hgrn_w_in,
              hgrn_lb_logits, hgrn_onorm_g, hgrn_w_out, ffn_norm_g, ffn_w_up,
              ffn_conv_w, ffn_conv_b, ffn_w_down, final_norm_g):
    sm = jax.nn.softmax(hgrn_lb_logits.astype(jnp.float32), axis=0)
    lower_bounds = jnp.cumsum(sm, axis=0) - sm[0:1]
    for layer in range(DEPTH):
        j = layer // N_MIXERS
        if layer % N_MIXERS == 0:
            x = x + fox_mixer(rmsnorm(x, att_norm_g[j]), att_w_in[j], att_b_f[j], att_w_out[j])
        else:
            x = x + hgrn2_mixer(rmsnorm(x, hgrn_norm_g[j]), hgrn_w_in[j],
                                lower_bounds[layer], hgrn_onorm_g[j], hgrn_w_out[j])
        x = x + conv_ffn(rmsnorm(x, ffn_norm_g[layer]), ffn_w_up[layer], ffn_conv_w[layer],
                         ffn_conv_b[layer], ffn_w_down[layer])
    return rmsnorm(x, final_norm_g)
```

```cpp
#include <hip/hip_runtime.h>
#include <hip/hip_cooperative_groups.h>
#include <hip/hip_bf16.h>
#include <cstdio>
#include <cstdint>
#include <cmath>
namespace pg8 {
#define PG8_LAS __attribute__((address_space(3)))
typedef unsigned short bf16_t;
typedef short bf16x8 __attribute__((ext_vector_type(8)));
typedef float f32x4 __attribute__((ext_vector_type(4)));
typedef unsigned u32x4 __attribute__((ext_vector_type(4)));
constexpr int BM = 256, BK = 64, HALF = 128, HTB = HALF * BK * 2  , STAGE_BYTES = 8 * HTB, NXCD = 8, WGM = 8;

__host__ __device__ __forceinline__ int lds_byte(int r, int c) { const int st = (r >> 4) * 2 + (c >> 5), rr = r & 15, cc = c & 31, ob = rr * 64 + cc * 2; return st * 1024 + (ob ^ (((ob >> 9) & 1) << 5)); }
__host__ __device__ __forceinline__ void stage_rc(int b, int& R, int& C) { const int st = b / 1024, sb = b % 1024, swz = sb ^ (((sb >> 9) & 1) << 5); R = (st >> 1) * 16 + swz / 64; C = (st & 1) * 32 + (swz % 64) / 2; }
__host__ __device__ __forceinline__ int perm32(int rho) { const int n = rho >> 4, i = rho & 15; return 8 * (i >> 2) + 4 * n + (i & 3); }

struct Unit { int pm, pn; };
struct Gemm { const bf16_t* A; const bf16_t* Bt; int M, N, K, lda; };

struct StaticOrder {
    int nM, nN, nwg, G, c;
    __host__ __device__ void init(int M, int N, int G_, int c_) { nM = M / BM; nN = N / BM; nwg = nM * nN; G = G_; c = c_; }
    __host__ __device__ bool next(int i, Unit& u) const {
        const long L = (long)i * G + c; if (L >= nwg) return false;
        int wgid = (int)L; { const int q = nwg / NXCD, r = nwg % NXCD, xcd = wgid % NXCD, off = wgid / NXCD; wgid = (xcd < r ? xcd * (q + 1) : r * (q + 1) + (xcd - r) * q) + off; }
        const int nig = WGM * nN, gid = wgid / nig, fm = gid * WGM, gsz = (nM - fm) < WGM ? (nM - fm) : WGM;
        u.pm = fm + ((wgid % nig) % gsz); u.pn = (wgid % nig) / gsz; return true;
    }
    __device__ __forceinline__ void a_ready(const Unit&) const {}
    __device__ __forceinline__ void done(const Unit&) const {}
};
constexpr int MTOK = 32768, DMODEL = 1024, SEQL = 8192, FFN2 = 5632, FFN1 = 2816;
__device__ __forceinline__ unsigned cvt_pk_bf16(float lo, float hi) { unsigned r; asm volatile("v_cvt_pk_bf16_f32 %0, %1, %2" : "=v"(r) : "v"(lo), "v"(hi)); return r; }
typedef _Float16 h16x2 __attribute__((ext_vector_type(2)));
__device__ __forceinline__ unsigned cvt_pk_f16(float lo, float hi) { h16x2 v = {(_Float16)lo, (_Float16)hi}; return __builtin_bit_cast(unsigned, v); }
__device__ __forceinline__ float silu_f(float x) { return x * __builtin_amdgcn_rcpf(1.0f + __expf(-x)); }

struct EpiQKV {
    static constexpr bool PERM = true, AFTER_DRAIN = false;
    bf16_t* QKV; float* LFt; const float* b_f; float scale0;
    __device__ __forceinline__ void operator()(const f32x4 (&acc)[2][2][4][2], const Unit& u, int wr, int wc, int fr, int fq) const {
        const int row0 = u.pm * BM + wr * 64 + fr;
        if (u.pn < 12) {
            const int part = u.pn >> 2; bf16_t* base = QKV + (size_t)part * ((size_t)MTOK * DMODEL);
            const float sc = part == 0 ? scale0 : 1.f; const int col0 = (u.pn & 3) * BM + wc * 32 + 8 * fq;
#pragma unroll
            for (int ai = 0; ai < 2; ++ai)
#pragma unroll
                for (int m = 0; m < 4; ++m) { bf16_t* rowp = base + (size_t)(row0 + ai * HALF + m * 16) * DMODEL + col0;
#pragma unroll
                    for (int bj = 0; bj < 2; ++bj) { const f32x4 v0 = acc[ai][bj][m][0] * sc, v1 = acc[ai][bj][m][1] * sc;
                        u32x4 w; w.x = cvt_pk_bf16(v0[0], v0[1]); w.y = cvt_pk_bf16(v0[2], v0[3]); w.z = cvt_pk_bf16(v1[0], v1[1]); w.w = cvt_pk_bf16(v1[2], v1[3]);
                        *(u32x4*)(rowp + bj * HALF) = w; } }
        } else if (wc == 0 && fq < 2) {
            float bias[8];
#pragma unroll
            for (int e = 0; e < 8; ++e) bias[e] = b_f[8 * fq + e];
#pragma unroll
            for (int ai = 0; ai < 2; ++ai)
#pragma unroll
                for (int m = 0; m < 4; ++m) { const int row = row0 + ai * HALF + m * 16; const int b = row >> 13, t = row & (SEQL - 1);
#pragma unroll
                    for (int n = 0; n < 2; ++n)
#pragma unroll
                        for (int e = 0; e < 4; ++e) { const int hh = 8 * fq + 4 * n + e; const float z = acc[ai][0][m][n][e] + bias[4 * n + e];
                            const float lf = fminf(z, 0.f) - log1pf(__expf(-fabsf(z)));
                            LFt[(size_t)(b * 16 + hh) * SEQL + t] = lf; } }
        }
    }
};
struct EpiRes {
    static constexpr bool PERM = false, AFTER_DRAIN = false;
    const float* base; float* out;
    __device__ __forceinline__ void operator()(const f32x4 (&acc)[2][2][4][2], const Unit& u, int wr, int wc, int fr, int fq) const {
        const int col0 = u.pn * BM + wc * 32 + 4 * fq;
#pragma unroll
        for (int ai = 0; ai < 2; ++ai)
#pragma unroll
            for (int m = 0; m < 4; ++m) { const size_t off = (size_t)(u.pm * BM + ai * HALF + wr * 64 + m * 16 + fr) * DMODEL + col0;
                f32x4 bs[2][2];
#pragma unroll
                for (int bj = 0; bj < 2; ++bj)
#pragma unroll
                    for (int n = 0; n < 2; ++n) bs[bj][n] = *(const f32x4*)(base + off + bj * HALF + n * 16);
#pragma unroll
                for (int bj = 0; bj < 2; ++bj)
#pragma unroll
                    for (int n = 0; n < 2; ++n) *(f32x4*)(out + off + bj * HALF + n * 16) = bs[bj][n] + acc[ai][bj][m][n];
                if (m & 1) asm volatile("" ::: "memory"); }
    }
};
struct EpiUp {
    static constexpr bool PERM = true, AFTER_DRAIN = false;
    bf16_t* U; bf16_t* UH;
    __device__ __forceinline__ void operator()(const f32x4 (&acc)[2][2][4][2], const Unit& u, int wr, int wc, int fr, int fq) const {
        const int row0 = u.pm * BM + wr * 64 + fr, col0 = u.pn * BM + wc * 32 + 8 * fq;
#pragma unroll
        for (int ai = 0; ai < 2; ++ai)
#pragma unroll
            for (int m = 0; m < 4; ++m) { const int row = row0 + ai * HALF + m * 16;
#pragma unroll
                for (int bj = 0; bj < 2; ++bj) { const f32x4 v0 = acc[ai][bj][m][0], v1 = acc[ai][bj][m][1];
                    u32x4 w; w.x = cvt_pk_bf16(v0[0], v0[1]); w.y = cvt_pk_bf16(v0[2], v0[3]); w.z = cvt_pk_bf16(v1[0], v1[1]); w.w = cvt_pk_bf16(v1[2], v1[3]);
                    *(u32x4*)(U + (size_t)row * FFN2 + col0 + bj * HALF) = w;
                    if (m == 3 && fr >= 14) *(u32x4*)(UH + (size_t)((row >> 6) * 2 + (fr - 14)) * FFN2 + col0 + bj * HALF) = w; } }
    }
};
struct EpiHgrn {
    static constexpr bool PERM = true, AFTER_DRAIN = false;
    bf16_t* HB;
    __device__ __forceinline__ void operator()(const f32x4 (&acc)[2][2][4][2], const Unit& u, int wr, int wc, int fr, int fq) const {
        const int part = u.pn >> 2; const int row0 = u.pm * BM + wr * 64 + fr, col0 = (u.pn & 3) * BM + wc * 32 + 8 * fq;
        bf16_t* dst = HB + (size_t)(part == 0 ? 1 : (part == 1 ? 0 : part)) * ((size_t)MTOK * DMODEL); const bool act = (part == 0) || (part == 3);
#pragma unroll
        for (int ai = 0; ai < 2; ++ai)
#pragma unroll
            for (int m = 0; m < 4; ++m) { bf16_t* rowp = dst + (size_t)(row0 + ai * HALF + m * 16) * DMODEL + col0;
#pragma unroll
                for (int bj = 0; bj < 2; ++bj) { float r[8];
#pragma unroll
                    for (int e = 0; e < 8; ++e) { const float z = acc[ai][bj][m][e >> 2][e & 3]; r[e] = act ? silu_f(z) : z; }
                    u32x4 w;
                    if (part == 1) { w.x = cvt_pk_f16(r[0], r[1]); w.y = cvt_pk_f16(r[2], r[3]); w.z = cvt_pk_f16(r[4], r[5]); w.w = cvt_pk_f16(r[6], r[7]); }
                    else { w.x = cvt_pk_bf16(r[0], r[1]); w.y = cvt_pk_bf16(r[2], r[3]); w.z = cvt_pk_bf16(r[4], r[5]); w.w = cvt_pk_bf16(r[6], r[7]); }
                    *(u32x4*)(rowp + bj * HALF) = w; } }
    }
};

template <class Epi, class Sched, bool ALIGN_EPI = false, bool SP2 = false>
__device__ __forceinline__ void gemm_phase(PG8_LAS unsigned char* lds, const Gemm g, const Sched& S, const Epi& E) {
    int tid = threadIdx.x; asm volatile("" : "+v"(tid)); const int wid = __builtin_amdgcn_readfirstlane(tid >> 6), lane = tid & 63, wr = wid >> 2, wc = wid & 3, fr = lane & 15, fq = lane >> 4;
    const int K = g.K, nt = K / BK;
    unsigned voffA[2], voffB[2];
#pragma unroll
    for (int i = 0; i < 2; ++i) { int R, C; stage_rc(tid * 16 + i * 8192, R, C); const int Rb = Epi::PERM ? ((R & ~31) + perm32(R & 31)) : R;
        voffA[i] = (unsigned)(R * g.lda + C) * 2u; voffB[i] = (unsigned)(Rb * K + C) * 2u; }
    const size_t kstep = (size_t)(BK * 2);
    const size_t hstepA = (size_t)HALF * g.lda * 2, hstepB = (size_t)HALF * K * 2;
    const size_t tstepA = 2 * hstepA, tstepB = 2 * hstepB;
    const unsigned ldsw = (unsigned)wid * 1024u;
    const int aoff = lds_byte(wr * 64 + fr, fq * 8), boff = lds_byte(wc * 32 + fr, fq * 8);
#define PG8_SA(b, h) (((b) * 2 + (h)) * HTB)
#define PG8_SB(b, h) ((4 + (b) * 2 + (h)) * HTB)
#define PG8_STAGE(bufoff, gbase, voff) do { _Pragma("unroll") for (int _i = 0; _i < 2; ++_i) \
        __builtin_amdgcn_global_load_lds((const unsigned*)((const char*)(gbase) + (voff)[_i]), (PG8_LAS unsigned*)(lds + (bufoff) + ldsw + _i * 8192), 16, 0, 0); } while (0)
#define PG8_LDA(dst, b, h) do { _Pragma("unroll") for (int m = 0; m < 4; ++m) _Pragma("unroll") for (int k = 0; k < 2; ++k) dst[m][k] = *(const PG8_LAS bf16x8*)(lds + PG8_SA(b, h) + aoff + m * 2048 + k * 1024); } while (0)
#define PG8_LDB(dst, b, h) do { _Pragma("unroll") for (int n = 0; n < 2; ++n) _Pragma("unroll") for (int k = 0; k < 2; ++k) dst[n][k] = *(const PG8_LAS bf16x8*)(lds + PG8_SB(b, h) + boff + n * 2048 + k * 1024); } while (0)
#define PG8_MMA(ai, bj, At, Bt) do { __builtin_amdgcn_s_setprio(1); _Pragma("unroll") for (int m = 0; m < 4; ++m) _Pragma("unroll") for (int n = 0; n < 2; ++n) _Pragma("unroll") for (int k = 0; k < 2; ++k) \
        acc[ai][bj][m][n] = __builtin_amdgcn_mfma_f32_16x16x32_bf16(Bt[n][k], At[m][k], acc[ai][bj][m][n], 0, 0, 0); __builtin_amdgcn_s_setprio(0); } while (0)
#define PG8_WAIT_V(n) asm volatile("s_waitcnt vmcnt(" #n ")" ::: "memory")
#define PG8_WAIT_L(n) asm volatile("s_waitcnt lgkmcnt(" #n ")" ::: "memory")
#define PG8_BAR __builtin_amdgcn_s_barrier()
#define PG8_SCHED __builtin_amdgcn_sched_barrier(0)
    Unit cur, nxt; int ui = 0;
    if (!S.next(0, cur)) return;
    f32x4 acc[2][2][4][2];
#pragma unroll
    for (int a = 0; a < 2; ++a)
#pragma unroll
        for (int b = 0; b < 2; ++b)
#pragma unroll
            for (int m = 0; m < 4; ++m)
#pragma unroll
                for (int n = 0; n < 2; ++n) acc[a][b][m][n] = (f32x4){0.f, 0.f, 0.f, 0.f};
    bf16x8 At[4][2], B0[2][2], B1[2][2];
    const char* cA = (const char*)g.A + (size_t)cur.pm * tstepA; const char* cB = (const char*)g.Bt + (size_t)cur.pn * tstepB;
    S.a_ready(cur);
    if constexpr (SP2) {
        PG8_STAGE(PG8_SB(0, 0), cB, voffB); PG8_STAGE(PG8_SB(0, 1), cB + hstepB, voffB); PG8_STAGE(PG8_SA(0, 0), cA, voffA); PG8_STAGE(PG8_SA(0, 1), cA + hstepA, voffA);
        if (wr == 1) PG8_BAR;
        PG8_WAIT_V(2); PG8_BAR;
        PG8_STAGE(PG8_SB(1, 0), cB + kstep, voffB); PG8_STAGE(PG8_SA(1, 0), cA + kstep, voffA); PG8_STAGE(PG8_SB(1, 1), cB + hstepB + kstep, voffB);
        PG8_WAIT_V(6); PG8_BAR;
    } else {
        PG8_STAGE(PG8_SB(0, 0), cB, voffB); PG8_STAGE(PG8_SA(0, 0), cA, voffA); PG8_STAGE(PG8_SB(0, 1), cB + hstepB, voffB); PG8_STAGE(PG8_SA(0, 1), cA + hstepA, voffA);
        if (wr == 1) PG8_BAR;
        PG8_WAIT_V(4); PG8_BAR;
        PG8_STAGE(PG8_SB(1, 0), cB + kstep, voffB); PG8_STAGE(PG8_SA(1, 0), cA + kstep, voffA); PG8_STAGE(PG8_SB(1, 1), cB + hstepB + kstep, voffB);
        PG8_WAIT_V(6); PG8_BAR;
    }
    for (;;) {
        const bool has_next = S.next(ui + 1, nxt);
        const char* nA = has_next ? (const char*)g.A + (size_t)nxt.pm * tstepA : cA; const char* nB = has_next ? (const char*)g.Bt + (size_t)nxt.pn * tstepB : cB;
        for (int t = 0; t < nt; t += 2) {
            const bool last = (t == nt - 2);
            const char* a1 = cA + (size_t)(t + 1) * kstep;
            const char* a2 = last ? nA : cA + (size_t)(t + 2) * kstep; const char* b2 = last ? nB : cB + (size_t)(t + 2) * kstep;
            const char* a3 = a2 + kstep; const char* b3 = b2 + kstep;
            if (last && has_next) S.a_ready(nxt);
            if constexpr (SP2) {
            PG8_LDB(B0, 0, 0); PG8_LDB(B1, 0, 1); PG8_SCHED; PG8_LDA(At, 0, 0); PG8_STAGE(PG8_SA(1, 1), a1 + hstepA, voffA);
            PG8_WAIT_V(8); PG8_WAIT_L(0); PG8_BAR; PG8_MMA(0, 0, At, B0); PG8_MMA(0, 1, At, B1); PG8_BAR; PG8_SCHED;
            PG8_LDA(At, 0, 1); PG8_STAGE(PG8_SB(0, 0), b2, voffB); PG8_STAGE(PG8_SB(0, 1), b2 + hstepB, voffB); PG8_STAGE(PG8_SA(0, 0), a2, voffA);
            PG8_WAIT_V(8); PG8_WAIT_L(0); PG8_BAR; PG8_MMA(1, 0, At, B0); PG8_MMA(1, 1, At, B1); PG8_BAR; PG8_SCHED;
            PG8_LDB(B0, 1, 0); PG8_LDB(B1, 1, 1); PG8_SCHED; PG8_LDA(At, 1, 0); PG8_STAGE(PG8_SA(0, 1), a2 + hstepA, voffA);
            PG8_WAIT_V(8); PG8_WAIT_L(0); PG8_BAR; PG8_MMA(0, 0, At, B0); PG8_MMA(0, 1, At, B1); PG8_BAR; PG8_SCHED;
            PG8_LDA(At, 1, 1); PG8_STAGE(PG8_SB(1, 0), b3, voffB); PG8_STAGE(PG8_SB(1, 1), b3 + hstepB, voffB); PG8_STAGE(PG8_SA(1, 0), a3, voffA);
            PG8_WAIT_V(8); PG8_WAIT_L(0); PG8_BAR; PG8_MMA(1, 0, At, B0); PG8_MMA(1, 1, At, B1); PG8_BAR; PG8_SCHED;
            } else {
            PG8_LDB(B0, 0, 0); PG8_SCHED; PG8_LDA(At, 0, 0); PG8_STAGE(PG8_SA(1, 1), a1 + hstepA, voffA);
            PG8_WAIT_L(8); PG8_BAR; PG8_WAIT_L(0); PG8_MMA(0, 0, At, B0); PG8_BAR; PG8_SCHED;
            PG8_LDB(B1, 0, 1); PG8_STAGE(PG8_SB(0, 0), b2, voffB);
            PG8_BAR; PG8_WAIT_L(0); PG8_MMA(0, 1, At, B1); PG8_BAR;
            PG8_LDA(At, 0, 1); PG8_STAGE(PG8_SA(0, 0), a2, voffA);
            PG8_BAR; PG8_WAIT_L(0); PG8_MMA(1, 0, At, B0); PG8_BAR; PG8_SCHED;
            PG8_STAGE(PG8_SB(0, 1), b2 + hstepB, voffB);
            PG8_WAIT_V(6); PG8_BAR; PG8_MMA(1, 1, At, B1); PG8_BAR;
            PG8_LDB(B0, 1, 0); PG8_SCHED; PG8_LDA(At, 1, 0); PG8_STAGE(PG8_SA(0, 1), a2 + hstepA, voffA);
            PG8_WAIT_L(8); PG8_BAR; PG8_WAIT_L(0); PG8_MMA(0, 0, At, B0); PG8_BAR; PG8_SCHED;
            PG8_LDB(B1, 1, 1); PG8_STAGE(PG8_SB(1, 0), b3, voffB);
            PG8_BAR; PG8_WAIT_L(0); PG8_MMA(0, 1, At, B1); PG8_BAR;
            PG8_LDA(At, 1, 1); PG8_STAGE(PG8_SA(1, 0), a3, voffA);
            PG8_BAR; PG8_WAIT_L(0); PG8_MMA(1, 0, At, B0); PG8_BAR; PG8_SCHED;
            PG8_STAGE(PG8_SB(1, 1), b3 + hstepB, voffB);
            PG8_WAIT_V(6); PG8_BAR; PG8_MMA(1, 1, At, B1); PG8_BAR;
            }
        }
        if constexpr (ALIGN_EPI) { if (wr == 0) PG8_BAR; }
        if constexpr (!Epi::AFTER_DRAIN) { int l2_ = lane; asm volatile("" : "+v"(l2_)); E(acc, cur, wr, wc, l2_ & 15, l2_ >> 4); S.done(cur); }
        if (!has_next) break;
#pragma unroll
        for (int a = 0; a < 2; ++a)
#pragma unroll
            for (int b = 0; b < 2; ++b)
#pragma unroll
                for (int m = 0; m < 4; ++m)
#pragma unroll
                    for (int n = 0; n < 2; ++n) acc[a][b][m][n] = (f32x4){0.f, 0.f, 0.f, 0.f};
        cur = nxt; cA = nA; cB = nB; ++ui;
        if constexpr (ALIGN_EPI) { if (wr == 1) PG8_BAR; }
    }
    PG8_WAIT_V(0);
    if constexpr (!ALIGN_EPI) { if (wr == 0) PG8_BAR; }
    PG8_BAR;
    if constexpr (Epi::AFTER_DRAIN) { E.fused(acc, cur, wr, wc, fr, fq, lds, wid, lane); S.done(cur); }
#undef PG8_SA
#undef PG8_SB
#undef PG8_STAGE
#undef PG8_LDA
#undef PG8_LDB
#undef PG8_MMA
#undef PG8_WAIT_V
#undef PG8_WAIT_L
#undef PG8_BAR
#undef PG8_SCHED
}
}
namespace attn_body {
using bf16=__hip_bfloat16;
using bf16x8=__attribute__((ext_vector_type(8)))short;
using s16x4=__attribute__((ext_vector_type(4)))short;
using f32x16=__attribute__((ext_vector_type(16)))float;
using u32x4=__attribute__((ext_vector_type(4)))unsigned;
constexpr int BATCH=4,NHEAD=16,SEQ=8192,D=64,DM=NHEAD*D;
constexpr int NW=8,QBLK=32,QB=QBLK*NW,KVBLK=64,NQB=SEQ/QB;
constexpr int ATTN_PITCH=DM, ATTN_UNIT_ROWS=QB;
__device__ __forceinline__ int crow(int r,int hi){return (r&3)+8*(r>>2)+4*hi;}
#define SBAR() __builtin_amdgcn_sched_barrier(0)
__device__ __forceinline__ void cmask(f32x16&p0,f32x16&p1,int jb,int qrel,int hi){
  const float NEG=-INFINITY; int kb=64*jb+4*hi;
  #pragma unroll
  for(int r=0;r<16;++r){int kv=kb+(r&3)+8*(r>>2); if(kv>qrel)p0[r]=NEG; if(kv+32>qrel)p1[r]=NEG;}
}

constexpr int NSLOT=3, SLOTB=8192;
constexpr int LDS_K=0, LDS_V=NSLOT*SLOTB, LDS_WS=2*NSLOT*SLOTB, LDS_OST=LDS_WS+NW*64*4, LDS_BYTES=LDS_OST+NW*4096; constexpr int LDS_KX=LDS_BYTES, LDS_SCAN=LDS_KX+SEQ*8, LDS_TOTAL=LDS_SCAN+64;
constexpr float C2=0.125f*1.4426950408889634f;
__device__ __forceinline__ void glds16(const void*gsrc,unsigned lds_dst){unsigned keep;
  asm volatile("s_mov_b32 %0, m0\n\ts_mov_b32 m0, %2\n\ts_nop 0\n\tglobal_load_lds_dwordx4 %1, off\n\ts_mov_b32 m0, %0":"=&s"(keep):"v"(gsrc),"s"(lds_dst):"memory");}
__device__ __forceinline__ float max3f(float a,float b,float c){float r;asm("v_max3_f32 %0, %1, %2, %3":"=v"(r):"v"(a),"v"(b),"v"(c));return r;}
__device__ __forceinline__ float max2f(float a,float b){float r;asm("v_max_f32_e32 %0, %1, %2":"=v"(r):"v"(a),"v"(b));return r;}
__device__ __forceinline__ float fadd_s(float a,float b){float r;asm("v_add_f32_e32 %0, %1, %2":"=v"(r):"v"(a),"v"(b));return r;}
__device__ __forceinline__ float fsub_s(float a,float b){float r;asm("v_sub_f32_e32 %0, %1, %2":"=v"(r):"v"(a),"v"(b));return r;}
typedef float f32x2_t __attribute__((ext_vector_type(2))); typedef __bf16 bf16x2_t __attribute__((ext_vector_type(2)));
__device__ __forceinline__ unsigned cvtpk_s(float lo,float hi){f32x2_t v={lo,hi};bf16x2_t b=__builtin_convertvector(v,bf16x2_t);return __builtin_bit_cast(unsigned,b);}
#define WAIT_BAR(N) asm volatile("s_waitcnt vmcnt(" #N ") lgkmcnt(0)\n\ts_barrier":::"memory")

typedef unsigned u32x2_t __attribute__((ext_vector_type(2))); typedef float f32x4_t __attribute__((ext_vector_type(4)));
__device__ __forceinline__ u32x2_t split3(float x){ const unsigned p1=cvtpk_s(x,0.f)&0xffffu; const float r1=x-__uint_as_float(p1<<16); const unsigned p2=cvtpk_s(r1,0.f)&0xffffu; const float r2=r1-__uint_as_float(p2<<16);
  const unsigned p3=cvtpk_s(r2,0.f)&0xffffu; return (u32x2_t){p1|(p2<<16),p3|(0x3F80u<<16)}; }
__device__ __forceinline__ bf16x8 mkqx(float x,int hi){ const unsigned p1=cvtpk_s(x,0.f)&0xffffu; const float r1=x-__uint_as_float(p1<<16); const unsigned p2=cvtpk_s(r1,0.f)&0xffffu; const float r2=r1-__uint_as_float(p2<<16);
  const unsigned p3=cvtpk_s(r2,0.f)&0xffffu; u32x4 w=(u32x4){0x3F803F80u,0x3F80u|(p1<<16),p2|(p3<<16),0u}; if(hi)w=(u32x4){0u,0u,0u,0u}; return __builtin_bit_cast(bf16x8,w); }
__device__ __forceinline__ bf16x8 kxa(u32x2_t q){ return __builtin_bit_cast(bf16x8,(u32x4){q.x,q.y,0x3F803F80u,0u}); }
__device__ __forceinline__ void qkt(f32x16&p0,f32x16&p1,const char*Kslot,const bf16x8*qr,bf16x8 kx0,bf16x8 kx1,bf16x8 qx,int r32,int hi){
  const char*kb=Kslot+hi*1024+r32*16;
  p0=__builtin_amdgcn_mfma_f32_32x32x16_bf16(kx0,qx,f32x16{},0,0,0);p1=__builtin_amdgcn_mfma_f32_32x32x16_bf16(kx1,qx,f32x16{},0,0,0);
  #pragma unroll
  for(int d0=0;d0<4;++d0){
    const bf16x8 b0=*reinterpret_cast<const bf16x8*>(kb+d0*2048);
    const bf16x8 b1=*reinterpret_cast<const bf16x8*>(kb+d0*2048+512);
    p0=__builtin_amdgcn_mfma_f32_32x32x16_bf16(b0,qr[d0],p0,0,0,0);p1=__builtin_amdgcn_mfma_f32_32x32x16_bf16(b1,qr[d0],p1,0,0,0);}
}
typedef __attribute__((address_space(3))) const char* lds_cptr;
typedef short v4i16_t __attribute__((ext_vector_type(4)));
__device__ __forceinline__ void kload8(bf16x8*kf,lds_cptr kp){
  kf[0]=*(const __attribute__((address_space(3))) bf16x8*)(kp);      kf[1]=*(const __attribute__((address_space(3))) bf16x8*)(kp+512);
  kf[2]=*(const __attribute__((address_space(3))) bf16x8*)(kp+2048); kf[3]=*(const __attribute__((address_space(3))) bf16x8*)(kp+2560);
  kf[4]=*(const __attribute__((address_space(3))) bf16x8*)(kp+4096); kf[5]=*(const __attribute__((address_space(3))) bf16x8*)(kp+4608);
  kf[6]=*(const __attribute__((address_space(3))) bf16x8*)(kp+6144); kf[7]=*(const __attribute__((address_space(3))) bf16x8*)(kp+6656);
}
__device__ __forceinline__ void kload2(bf16x8*kf,lds_cptr kp,int j){ kf[2*j]=*(const __attribute__((address_space(3))) bf16x8*)(kp+j*2048); kf[2*j+1]=*(const __attribute__((address_space(3))) bf16x8*)(kp+j*2048+512); }
__device__ __forceinline__ s16x4 vtr(lds_cptr p){ return __builtin_bit_cast(s16x4,__builtin_amdgcn_ds_read_tr16_b64_v4i16((__attribute__((address_space(3))) v4i16_t*)p)); }
__device__ __forceinline__ float rowmax(const f32x16&p0,const f32x16&p1){
  float a=max3f(p0[0],p0[1],p1[0]),b=max3f(p0[2],p0[3],p1[1]);a=max3f(a,p1[2],p1[3]);
  #pragma unroll
  for(int r=4;r<16;r+=4){a=max3f(a,p0[r],p0[r+1]);b=max3f(b,p0[r+2],p0[r+3]);a=max3f(a,p1[r],p1[r+1]);b=max3f(b,p1[r+2],p1[r+3]);}
  const float m=max2f(a,b);
  auto rr=__builtin_amdgcn_permlane32_swap(__float_as_uint(m),__float_as_uint(m),false,false);
  return max2f(__uint_as_float(rr[0]),__uint_as_float(rr[1]));
}
__device__ __forceinline__ void pv(f32x16*o,int vb,bf16x8 pa0,bf16x8 pa1,bf16x8 pa2,bf16x8 pa3){
  #pragma unroll
  for(int d0=0;d0<2;++d0){s16x4 lo[4],hi[4];
    #pragma unroll
    for(int ks=0;ks<4;++ks){
      asm volatile("ds_read_b64_tr_b16 %0,%1 offset:%c2":"=&v"(lo[ks]):"v"(vb),"i"(d0*4096+ks*1024):"memory");
      asm volatile("ds_read_b64_tr_b16 %0,%1 offset:%c2":"=&v"(hi[ks]):"v"(vb),"i"(d0*4096+ks*1024+512):"memory");}
    asm volatile("s_waitcnt lgkmcnt(0)":::"memory");SBAR();
    #define PK(k) (bf16x8){lo[k][0],lo[k][1],lo[k][2],lo[k][3],hi[k][0],hi[k][1],hi[k][2],hi[k][3]}
    o[d0]=__builtin_amdgcn_mfma_f32_32x32x16_bf16(pa0,PK(0),o[d0],0,0,0);
    o[d0]=__builtin_amdgcn_mfma_f32_32x32x16_bf16(pa1,PK(1),o[d0],0,0,0);
    o[d0]=__builtin_amdgcn_mfma_f32_32x32x16_bf16(pa2,PK(2),o[d0],0,0,0);
    o[d0]=__builtin_amdgcn_mfma_f32_32x32x16_bf16(pa3,PK(3),o[d0],0,0,0);
    #undef PK
  }
}

#ifndef ATTN_STORE16
#define ATTN_STORE16(p,v) (*(u32x4*)(p)=(v))
#endif
template<int THRL> __device__ __forceinline__ void attn_unit(int b,int h,int qb,const bf16*Q,const bf16*__restrict__ K,const bf16*__restrict__ V,bf16*O,const float*__restrict__ LFt,char*shm){
  int tid=threadIdx.x; asm volatile("":"+v"(tid)); const int lane=tid&63,r32=lane&31,hi=lane>>5; const int wid=__builtin_amdgcn_readfirstlane(tid>>6);
  const long rowbase=(long)b*SEQ; const int q0=qb*QB;
  const bf16*Qw=Q+(rowbase+q0+wid*QBLK)*DM+h*D;
  const bf16*Kh=K+rowbase*DM+h*D,*Vh=V+rowbase*DM+h*D;
  const unsigned lds0=(unsigned)(uintptr_t)shm;
  float*wsf=(float*)(shm+LDS_WS)+wid*64;
  const bf16*ksrc=Kh+(long)lane*DM+wid*8;
  const bf16*vsrc=Vh+(long)(16*(wid&3)+(lane>>2))*DM+(wid>>2)*32+(lane&3)*8;
  const unsigned kdst=lds0+LDS_K+wid*1024, vdst=lds0+LDS_V+wid*1024;
  #define DMA_K(t,slot) glds16(ksrc+(long)(t)*KVBLK*DM,(unsigned)__builtin_amdgcn_readfirstlane(kdst+(slot)))
  #define DMA_V(t,slot) glds16(vsrc+(long)(t)*KVBLK*DM,(unsigned)__builtin_amdgcn_readfirstlane(vdst+(slot)))
  const int vb0=(int)(lds0+LDS_V)+((lane>>4)&1)*32+(lane&3)*8+(4*hi+((lane&15)>>2))*64;
  const char*Kbase=shm+LDS_K; bf16x8 kf[8];
  const lds_cptr shm3=(lds_cptr)shm; const lds_cptr kp0=shm3+LDS_K+hi*1024+r32*16; const lds_cptr vp0=shm3+LDS_V+((lane>>4)&1)*32+(lane&3)*8+(4*hi+((lane&15)>>2))*64;
  const int NT=(q0+QB)/KVBLK;
  {
    typedef __attribute__((address_space(3))) char* lds_wptr; const lds_wptr shmw=(lds_wptr)shm;
    const float*lp=LFt+((long)(b*NHEAD+h)*SEQ+16*tid);
    const f32x4_t a0=*(const f32x4_t*)lp,a1=*(const f32x4_t*)(lp+4),a2=*(const f32x4_t*)(lp+8),a3=*(const f32x4_t*)(lp+12);
    const float v_[16]={a0[0],a0[1],a0[2],a0[3],a1[0],a1[1],a1[2],a1[3],a2[0],a2[1],a2[2],a2[3],a3[0],a3[1],a3[2],a3[3]};
    float loc=0.f;
    #pragma unroll
    for(int i=0;i<16;++i)loc+=v_[i];
    float inc=loc;
    #pragma unroll
    for(int o_=1;o_<64;o_<<=1){const float t_=__shfl_up(inc,o_); if(lane>=o_)inc+=t_;}
    __attribute__((address_space(3))) float*wt=(__attribute__((address_space(3))) float*)(shmw+LDS_SCAN);
    if(lane==63)wt[wid]=inc;
    asm volatile("s_waitcnt vmcnt(0) lgkmcnt(0)\n\ts_barrier":::"memory");
    float run=inc-loc;
    #pragma unroll
    for(int w_=0;w_<NW;++w_){const float tw=wt[w_]; if(w_<wid)run+=tw;}
    __attribute__((address_space(3))) u32x4*kxw=(__attribute__((address_space(3))) u32x4*)(shmw+LDS_KX+tid*128);
    #pragma unroll
    for(int i=0;i<16;i+=2){ run+=v_[i]; const u32x2_t e0=split3(run*(-1.4426950408889634f)); run+=v_[i+1]; const u32x2_t e1=split3(run*(-1.4426950408889634f)); kxw[i>>1]=(u32x4){e0.x,e0.y,e1.x,e1.y}; }
    asm volatile("s_waitcnt lgkmcnt(0)\n\ts_barrier":::"memory");
  }
  DMA_K(0,0);DMA_V(0,0);DMA_K(1,SLOTB);
  bf16x8 qr[4];
  #pragma unroll
  for(int d0=0;d0<4;++d0)qr[d0]=*reinterpret_cast<const bf16x8*>(&Qw[(long)r32*DM+d0*16+hi*8]);
  float mhat=0.f,l_reg=0.f;f32x16 o[2];o[0]=f32x16{};o[1]=f32x16{};bf16x8 qx=mkqx(0.f,hi);u32x2_t kq0,kq1;
  const __attribute__((address_space(3))) char*kxp=shm3+LDS_KX+r32*8;
  #define LDKQ(t) do{ kq0=*(const __attribute__((address_space(3))) u32x2_t*)(kxp+(t)*512); kq1=*(const __attribute__((address_space(3))) u32x2_t*)(kxp+(t)*512+256); }while(0)
  const int qrel=wid*QBLK+r32;
  #define CMASK(P0,P1,t) do{int jb_=(t)-(NT-4); if(jb_>=0)cmask(P0,P1,jb_,qrel,hi);}while(0)
  bool resc=false;
  #define START(P0,P1) do{ const float rm=rowmax(P0,P1); resc=false; \
    { const float dl=rm; mhat=fadd_s(mhat,dl); \
      _Pragma("unroll") for(int r=0;r<16;++r){P0[r]=fsub_s(P0[r],dl);P1[r]=fsub_s(P1[r],dl);} \
      qx=mkqx(-mhat,hi); } \
    _Pragma("unroll") for(int r=0;r<16;++r)P0[r]=__builtin_amdgcn_exp2f(P0[r]); }while(0)
  #define RESC() do{ if(resc){ asm volatile("s_waitcnt lgkmcnt(0)":::"memory"); \
      _Pragma("unroll") for(int d_=0;d_<2;++d_) _Pragma("unroll") for(int r=0;r<16;++r)o[d_][r]*=wsf[crow(r,hi)]; } }while(0)
  f32x16 pA0,pA1,pB0,pB1;
  int sl_prev=0,sl_cur=0,sl_next=SLOTB;
  #define ROT() do{sl_prev=sl_cur;sl_cur=sl_next;sl_next=(sl_next==(NSLOT-1)*SLOTB)?0:sl_next+SLOTB;}while(0)
  DMA_K(2,2*SLOTB);
  WAIT_BAR(3);
  LDKQ(0); qkt(pA0,pA1,Kbase,qr,kxa(kq0),kxa(kq1),qx,r32,hi);asm volatile("s_nop 15\n\ts_nop 7":"+v"(pA0),"+v"(pA1));CMASK(pA0,pA1,0); LDKQ(1);
  START(pA0,pA1);
  _Pragma("unroll") for(int r=0;r<16;++r)pA1[r]=__builtin_amdgcn_exp2f(pA1[r]);
  WAIT_BAR(0);
  DMA_K(3,0);DMA_V(1,SLOTB);
  ROT();
  kload8(kf,kp0+sl_cur);
  WAIT_BAR(2);
  s16x4 vlo[8],vhi[8]; u32x4 pw0,pw1,pw2,pw3;
  #define PKW(P,B) cvtpk_s(P[B],P[B+1])
  #define PAF(k) __builtin_bit_cast(bf16x8,pw##k)
  #define VFR(i) (bf16x8){vlo[i][0],vlo[i][1],vlo[i][2],vlo[i][3],vhi[i][0],vhi[i][1],vhi[i][2],vhi[i][3]}
  #define PIN(x) asm volatile("":"+v"(x))
  #define MX3(a,b,c) __builtin_fmaxf(__builtin_fmaxf((a),(b)),(c))
  #define GAPA(MF,A0,A1,A2,A3,W0,W1,PW) do{ MF; sacc+=A0; sacc+=A1; sacc+=A2; sacc+=A3; PIN(sacc); W0; W1; PIN(PW); SBAR(); }while(0)
  #define EX(v) __builtin_amdgcn_exp2f(v)
  #define GAPB(MF,X,B) do{ MF; X[B]=EX(X[B]); X[B+1]=EX(X[B+1]); X[B+2]=EX(X[B+2]); X[B+3]=EX(X[B+3]); PIN(X); SBAR(); }while(0)
  #define VRD(i) do{ vlo[i]=vtr(vp_+(((i)>>2)*4096+((i)&3)*1024)); vhi[i]=vtr(vp_+(((i)>>2)*4096+((i)&3)*1024+512)); }while(0)
  #define KRD(G,j) do{ if(G){ kload2(kf,kp0+sl_next,j); SBAR(); } }while(0)
  #define STEP(C0,C1,P0,P1,t,GK,GV,GL) do{ SBAR(); \
    C0=__builtin_amdgcn_mfma_f32_32x32x16_bf16(kxa(kq0),qx,f32x16{},0,0,0); C1=__builtin_amdgcn_mfma_f32_32x32x16_bf16(kxa(kq1),qx,f32x16{},0,0,0); SBAR(); \
    const lds_cptr vp_=vp0+sl_prev; \
    VRD(0); SBAR(); float sacc=(P0[0]+P0[1]); \
    GAPA(C0=__builtin_amdgcn_mfma_f32_32x32x16_bf16(kf[0],qr[0],C0,0,0,0), P0[2],P0[3],P0[4],P0[5],     pw0[0]=PKW(P0,0), pw0[1]=PKW(P0,2), pw0); \
    VRD(4); SBAR(); GAPA(C1=__builtin_amdgcn_mfma_f32_32x32x16_bf16(kf[1],qr[0],C1,0,0,0), P0[6],P0[7],P0[8],P0[9],     pw0[2]=PKW(P0,4), pw0[3]=PKW(P0,6), pw0); \
    VRD(1); SBAR(); GAPA(C0=__builtin_amdgcn_mfma_f32_32x32x16_bf16(kf[2],qr[1],C0,0,0,0),   P0[10],P0[11],P0[12],P0[13], pw1[0]=PKW(P0,8), pw1[1]=PKW(P0,10), pw1); \
    VRD(5); SBAR(); GAPA(C1=__builtin_amdgcn_mfma_f32_32x32x16_bf16(kf[3],qr[1],C1,0,0,0),   P0[14],P0[15],P1[0],P1[1],   pw1[2]=PKW(P0,12),pw1[3]=PKW(P0,14), pw1); \
    VRD(2); SBAR(); GAPA(C0=__builtin_amdgcn_mfma_f32_32x32x16_bf16(kf[4],qr[2],C0,0,0,0),   P1[2],P1[3],P1[4],P1[5],     pw2[0]=PKW(P1,0), pw2[1]=PKW(P1,2), pw2); \
    VRD(6); SBAR(); GAPA(C1=__builtin_amdgcn_mfma_f32_32x32x16_bf16(kf[5],qr[2],C1,0,0,0),   P1[6],P1[7],P1[8],P1[9],     pw2[2]=PKW(P1,4), pw2[3]=PKW(P1,6), pw2); \
    VRD(3); SBAR(); GAPA(C0=__builtin_amdgcn_mfma_f32_32x32x16_bf16(kf[6],qr[3],C0,0,0,0),   P1[10],P1[11],P1[12],P1[13], pw3[0]=PKW(P1,8), pw3[1]=PKW(P1,10), pw3); \
    VRD(7); SBAR(); GAPA(C1=__builtin_amdgcn_mfma_f32_32x32x16_bf16(kf[7],qr[3],C1,0,0,0),   P1[14],P1[15],0.f,0.f,       pw3[2]=PKW(P1,12),pw3[3]=PKW(P1,14), pw3); \
    l_reg+=sacc; if(GL){LDKQ((t)+1);} \
    if(GK){DMA_K((t)+3,sl_cur);} if(GV){DMA_V((t)+1,sl_next);} \
    CMASK(C0,C1,t); \
    { float a=MX3(C0[0],C0[1],C1[0]),b=MX3(C0[2],C0[3],C1[1]); a=MX3(a,C1[2],C1[3]); \
      _Pragma("unroll") for(int r=4;r<16;r+=4){a=MX3(a,C0[r],C0[r+1]);b=MX3(b,C0[r+2],C0[r+3]);a=MX3(a,C1[r],C1[r+1]);b=MX3(b,C1[r+2],C1[r+3]);} \
      float rm=__builtin_fmaxf(a,b); { auto rr=__builtin_amdgcn_permlane32_swap(__float_as_uint(rm),__float_as_uint(rm),false,false); rm=__builtin_fmaxf(__uint_as_float(rr[0]),__uint_as_float(rr[1])); } \
      resc=false; \
      if(__builtin_expect(__any(rm>(float)THRL),0)){ const float dl=__builtin_fmaxf(rm,0.f); mhat+=dl; \
        _Pragma("unroll") for(int r=0;r<16;++r){C0[r]-=dl;C1[r]-=dl;} \
        qx=mkqx(-mhat,hi); \
        const float f=__builtin_amdgcn_exp2f(-dl); l_reg*=f; if(hi==0)wsf[r32]=f; resc=true; } } \
    SBAR(); \
    GAPB(o[0]=__builtin_amdgcn_mfma_f32_32x32x16_bf16(PAF(0),VFR(0),o[0],0,0,0), C0,0); \
    GAPB(o[1]=__builtin_amdgcn_mfma_f32_32x32x16_bf16(PAF(0),VFR(4),o[1],0,0,0), C0,4); \
    KRD(GL,0); GAPB(o[0]=__builtin_amdgcn_mfma_f32_32x32x16_bf16(PAF(1),VFR(1),o[0],0,0,0), C0,8); \
    KRD(GL,1); GAPB(o[1]=__builtin_amdgcn_mfma_f32_32x32x16_bf16(PAF(1),VFR(5),o[1],0,0,0), C0,12); \
    KRD(GL,2); GAPB(o[0]=__builtin_amdgcn_mfma_f32_32x32x16_bf16(PAF(2),VFR(2),o[0],0,0,0), C1,0); \
    KRD(GL,3); GAPB(o[1]=__builtin_amdgcn_mfma_f32_32x32x16_bf16(PAF(2),VFR(6),o[1],0,0,0), C1,4); \
    GAPB(o[0]=__builtin_amdgcn_mfma_f32_32x32x16_bf16(PAF(3),VFR(3),o[0],0,0,0), C1,8); \
    GAPB(o[1]=__builtin_amdgcn_mfma_f32_32x32x16_bf16(PAF(3),VFR(7),o[1],0,0,0), C1,12); \
    }while(0)
  int t=1;
  #undef CMASK
  #define CMASK(P0,P1,t) do{}while(0)
  for(;t+5<NT;t+=2){
    STEP(pB0,pB1,pA0,pA1,t,true,true,true);     WAIT_BAR(2); RESC(); ROT();
    STEP(pA0,pA1,pB0,pB1,t+1,true,true,true);   WAIT_BAR(2); RESC(); ROT();
  }
  #undef CMASK
  #define CMASK(P0,P1,t) do{int jb_=(t)-(NT-4); if(jb_>=0)cmask(P0,P1,jb_,qrel,hi);}while(0)
  #define ENDW(tt) do{ if((tt)+3<NT){WAIT_BAR(2);} else if((tt)+2<NT){WAIT_BAR(1);} else {WAIT_BAR(0);} }while(0)
  for(;t+1<NT;t+=2){
    STEP(pB0,pB1,pA0,pA1,t,(t+3<NT),(t+1<NT),(t+1<NT));       ENDW(t);   RESC(); ROT();
    STEP(pA0,pA1,pB0,pB1,t+1,(t+4<NT),(t+2<NT),(t+2<NT));     ENDW(t+1); RESC(); ROT();
  }
  STEP(pB0,pB1,pA0,pA1,NT-1,false,false,false); RESC();
  { float sacc=pB0[0]+pB0[1]; _Pragma("unroll") for(int r=2;r<16;++r)sacc+=pB0[r]; _Pragma("unroll") for(int r=0;r<16;++r)sacc+=pB1[r]; l_reg+=sacc;
    pw0=(u32x4){PKW(pB0,0),PKW(pB0,2),PKW(pB0,4),PKW(pB0,6)};pw1=(u32x4){PKW(pB0,8),PKW(pB0,10),PKW(pB0,12),PKW(pB0,14)};pw2=(u32x4){PKW(pB1,0),PKW(pB1,2),PKW(pB1,4),PKW(pB1,6)};pw3=(u32x4){PKW(pB1,8),PKW(pB1,10),PKW(pB1,12),PKW(pB1,14)};
    SBAR(); pv(o,vb0+sl_cur,PAF(0),PAF(1),PAF(2),PAF(3)); }
  #undef PKW
  #undef PAF
  #undef VFR
  #undef PIN
  #undef MX3
  #undef GAPA
  #undef GAPB
  #undef EX
  #undef VRD
  #undef KRD
  #undef STEP
  #undef ENDW
  {auto rr=__builtin_amdgcn_permlane32_swap(__float_as_uint(l_reg),__float_as_uint(l_reg),false,false);l_reg=__uint_as_float(rr[0])+__uint_as_float(rr[1]);}
  if(hi==0)wsf[32+r32]=l_reg;asm volatile("s_waitcnt lgkmcnt(0)":::"memory");
  float rli[16];
  #pragma unroll
  for(int r=0;r<16;++r)rli[r]=__builtin_amdgcn_rcpf(wsf[32+crow(r,hi)]);
  bf16*Ow=O+(rowbase+q0+wid*QBLK)*DM+h*D;
  { bf16*stg=(bf16*)(shm+LDS_OST)+wid*2048;
    #pragma unroll
    for(int r=0;r<16;++r){const int orow=crow(r,hi);
      #pragma unroll
      for(int d0=0;d0<2;++d0)stg[orow*64+d0*32+r32]=__float2bfloat16(o[d0][r]*rli[r]);}
    asm volatile("s_waitcnt lgkmcnt(0)":::"memory");
    #pragma unroll
    for(int i=0;i<4;++i){const int row=i*8+(lane>>3),ch=lane&7; const u32x4 v=*(const u32x4*)(stg+row*64+ch*8); ATTN_STORE16(Ow+(long)row*DM+ch*8,v);} }
  asm volatile("s_waitcnt lgkmcnt(0)\n\ts_barrier":::"memory");
  #undef DMA_K
  #undef DMA_V
  #undef CMASK
  #undef START
  #undef RESC
  #undef ROT
}
constexpr int ATTN_LDS_BYTES=LDS_TOTAL;
struct AttnTensors { const bf16* Q; const bf16* K; const bf16* V; bf16* O; const float* LFt; };
struct AttnUnit { int bh; int qb; };
struct StaticOrder {
  int vcu,G;
  __device__ __forceinline__ explicit StaticOrder(int grid,int v):vcu(v),G(grid){}
  __device__ __forceinline__ bool next(int i,AttnUnit&u)const{ const int v=vcu+(i>>3)*G; if(v>=256)return false; const int s=v&3,j=i&7,p=j>>1; u.bh=v>>2; u.qb=8*p+((j&1)?7-s:s); return true; }
  __device__ __forceinline__ void a_ready(const AttnUnit&)const{}
  __device__ __forceinline__ void done(const AttnUnit&)const{}
};
template<class Sched,int THRL=32> __device__ __forceinline__ void attn_phase(char*lds,const AttnTensors&T,const Sched&S){
  AttnUnit u;
  for(int i=0;S.next(i,u);++i){ S.a_ready(u); attn_unit<THRL>(u.bh/NHEAD,u.bh%NHEAD,u.qb,T.Q,T.K,T.V,T.O,T.LFt,lds); S.done(u); }
}
#undef SBAR
#undef WAIT_BAR
}
namespace hg {
#define HLAS __attribute__((address_space(3)))
typedef short bf16x8 __attribute__((ext_vector_type(8)));
typedef float f32x4 __attribute__((ext_vector_type(4)));
typedef unsigned u32x4 __attribute__((ext_vector_type(4)));
typedef unsigned u32x2 __attribute__((ext_vector_type(2)));
typedef unsigned short u16;
constexpr int L_QD = 0, L_KI = 17408, L_IVT = 34816, L_KST = 53248, L_AM = 71680, L_TOT = 80896, L_SSQ = 82944, L_END = 83456;
constexpr int P_QD = 272, P_T = 144;
constexpr int NUNITS = 4096;
__device__ __forceinline__ unsigned f2bf(float f) { unsigned u = __builtin_bit_cast(unsigned, f); return (u + 0x7fffu + ((u >> 16) & 1u)) >> 16; }
__device__ __forceinline__ unsigned pk2(float lo, float hi) { return f2bf(lo) | (f2bf(hi) << 16); }
__device__ __forceinline__ float bf2f(unsigned h) { return __builtin_bit_cast(float, h << 16); }
__device__ __forceinline__ float h2f(u16 h) { return (float)__builtin_bit_cast(_Float16, h); }

struct Tensors { const u16* HLF; u16* HQ; const u16* HI; const u16* HG; u16* US; float* DEC; const float* onorm_g; const float* LB; };

template <bool PA> __device__ __forceinline__ void prep(HLAS unsigned char* L, const Tensors& T, int unit, size_t rowbase, int h, int tid) {
    const int d = tid & 127, qt = tid >> 7;
    const u16* lfp = T.HLF + (rowbase + 16 * qt) * 1024 + 128 * h + d;
    float kk[16], cs[16]; float run = 0.f;
    const float lb = T.LB[128 * h + d];
#pragma unroll
    for (int i = 0; i < 16; ++i) kk[i] = h2f(lfp[(size_t)i * 1024]);
#pragma unroll
    for (int i = 0; i < 16; ++i) { const float sg = __builtin_amdgcn_rcpf(1.0f + __expf(-kk[i])); const float f = lb + (1.0f - lb) * sg;
        kk[i] = (1.0f - lb) * (1.0f - sg); run += __logf(f); cs[i] = run; }
    HLAS float* TOT = (HLAS float*)(L + L_TOT);
    TOT[qt * 128 + d] = run;
    __syncthreads();
    const float t0 = TOT[d], t1 = TOT[128 + d], t2 = TOT[256 + d], t3 = TOT[384 + d];
    const float pre = (qt > 0 ? t0 : 0.f) + (qt > 1 ? t1 : 0.f) + (qt > 2 ? t2 : 0.f);
    const float blast = ((t0 + t1) + t2) + t3;
    if (PA) {
        unsigned w[8];
#pragma unroll
        for (int i = 0; i < 16; i += 2) {
            const float k0 = kk[i], k1 = kk[i + 1];
            const float e0 = __expf(blast - (pre + cs[i])), e1 = __expf(blast - (pre + cs[i + 1]));
            w[i >> 1] = pk2(k0 * e0, k1 * e1);
        }
        HLAS u32x4* dst = (HLAS u32x4*)(L + L_KST + d * P_T + qt * 32);
        dst[0] = (u32x4){w[0], w[1], w[2], w[3]}; dst[1] = (u32x4){w[4], w[5], w[6], w[7]};
        if (qt == 0) T.DEC[(size_t)unit * 128 + d] = __expf(blast);
    } else {
        const u16* qp = T.HQ + (rowbase + 16 * qt) * 1024 + 128 * h + d;
        float q[16];
#pragma unroll
        for (int i = 0; i < 16; ++i) q[i] = bf2f(qp[(size_t)i * 1024]);
#pragma unroll
        for (int i = 0; i < 16; ++i) { const float bb = pre + cs[i]; const float k = kk[i];
            *(HLAS u16*)(L + L_QD + (16 * qt + i) * P_QD + d * 2) = (u16)f2bf(q[i] * __expf(bb));
            *(HLAS u16*)(L + L_KI + (16 * qt + i) * P_QD + d * 2) = (u16)f2bf(k * __expf(-bb)); }
    }
}
__device__ __forceinline__ void stage_ivt(HLAS unsigned char* L, const Tensors& T, size_t rowbase, int h, int tid) {
#pragma unroll
    for (int it = 0; it < 2; ++it) { const int idx = tid + it * 512; const int s = idx >> 4, vg = idx & 15;
        const u32x4 w = *(const u32x4*)(T.HI + (rowbase + s) * 1024 + 128 * h + 8 * vg);
#pragma unroll
        for (int j = 0; j < 8; ++j) { const unsigned dw = w[j >> 1]; *(HLAS u16*)(L + L_IVT + (8 * vg + j) * P_T + s * 2) = (u16)((j & 1) ? (dw >> 16) : (dw & 0xffffu)); } }
}
#define HG_MFMA(X, Y, C) __builtin_amdgcn_mfma_f32_16x16x32_bf16((X), (Y), (C), 0, 0, 0)

__device__ __forceinline__ void phaseA_unit(HLAS unsigned char* L, const Tensors& T, int unit, int tid) {
    const int bh = unit >> 7, n = unit & 127, b = bh >> 3, h = bh & 7; const size_t rowbase = (size_t)b * 8192 + (size_t)n * 64;
    const int lane = tid & 63, w = tid >> 6, lr = lane & 15, kq = lane >> 4;
    prep<true>(L, T, unit, rowbase, h, tid);
    stage_ivt(L, T, rowbase, h, tid);
    __syncthreads();
    f32x4 acc[8];
#pragma unroll
    for (int dt = 0; dt < 8; ++dt) acc[dt] = (f32x4){0.f, 0.f, 0.f, 0.f};
#pragma unroll
    for (int ks = 0; ks < 2; ++ks) {
        const bf16x8 Y = *(const HLAS bf16x8*)(L + L_IVT + (16 * w + lr) * P_T + (32 * ks + 8 * kq) * 2);
#pragma unroll
        for (int dt = 0; dt < 8; ++dt) { const bf16x8 X = *(const HLAS bf16x8*)(L + L_KST + (16 * dt + lr) * P_T + (32 * ks + 8 * kq) * 2); acc[dt] = HG_MFMA(X, Y, acc[dt]); }
    }
    u16* up = T.US + ((size_t)unit * 128 + 16 * w + lr) * 128 + 4 * kq;
#pragma unroll
    for (int dt = 0; dt < 8; ++dt) *(u32x2*)(up + 16 * dt) = (u32x2){pk2(acc[dt][0], acc[dt][1]), pk2(acc[dt][2], acc[dt][3])};
    __syncthreads();
}
__device__ __forceinline__ void phaseB(const Tensors& T, int vb, int tid) {
    const int g = vb * 512 + tid, d4 = g & 31, v = (g >> 5) & 127, bh = g >> 12;
    u32x2* p = (u32x2*)T.US + ((size_t)(bh * 128) * 128 + v) * 32 + d4;
    const f32x4* dp = (const f32x4*)T.DEC + (size_t)(bh * 128) * 32 + d4;
    f32x4 S = (f32x4){0.f, 0.f, 0.f, 0.f};
    for (int n0 = 0; n0 < 128; n0 += 8) {
        u32x2 u[8]; f32x4 dc[8];
#pragma unroll
        for (int j = 0; j < 8; ++j) { u[j] = p[(size_t)(n0 + j) * 4096]; dc[j] = dp[(size_t)(n0 + j) * 32]; }
#pragma unroll
        for (int j = 0; j < 8; ++j) {
            p[(size_t)(n0 + j) * 4096] = (u32x2){pk2(S[0], S[1]), pk2(S[2], S[3])};
            const f32x4 uu = (f32x4){bf2f(u[j].x & 0xffffu), bf2f(u[j].x >> 16), bf2f(u[j].y & 0xffffu), bf2f(u[j].y >> 16)};
            S = dc[j] * S + uu;
        }
    }
}
__device__ __forceinline__ void phaseC_unit(HLAS unsigned char* L, const Tensors& T, int unit, int tid) {
    const int bh = unit >> 7, n = unit & 127, b = bh >> 3, h = bh & 7; const size_t rowbase = (size_t)b * 8192 + (size_t)n * 64;
    const int lane = tid & 63, w = tid >> 6, lr = lane & 15, kq = lane >> 4;
    const int ct = w & 3, wh = w >> 2;
    prep<false>(L, T, unit, rowbase, h, tid);
    stage_ivt(L, T, rowbase, h, tid);
    __syncthreads();
#pragma unroll
    for (int sp = 0; sp < 2; ++sp) { const int st = 2 * wh + sp;
        f32x4 a = (f32x4){0.f, 0.f, 0.f, 0.f};
        if (st <= ct) {
#pragma unroll
            for (int ks = 0; ks < 4; ++ks) { const bf16x8 X = *(const HLAS bf16x8*)(L + L_KI + (16 * st + lr) * P_QD + (32 * ks + 8 * kq) * 2);
                const bf16x8 Y = *(const HLAS bf16x8*)(L + L_QD + (16 * ct + lr) * P_QD + (32 * ks + 8 * kq) * 2); a = HG_MFMA(X, Y, a); }
        }
        const int c = 16 * ct + lr, s0 = 16 * st + 4 * kq;
        float m[4];
#pragma unroll
        for (int e = 0; e < 4; ++e) m[e] = (st <= ct && s0 + e <= c) ? a[e] : 0.f;
        *(HLAS u32x2*)(L + L_AM + c * P_T + s0 * 2) = (u32x2){pk2(m[0], m[1]), pk2(m[2], m[3])};
    }
    __syncthreads();
    f32x4 acc[4];
#pragma unroll
    for (int vi = 0; vi < 4; ++vi) acc[vi] = (f32x4){0.f, 0.f, 0.f, 0.f};
    const u16* sp_ = T.US + ((size_t)unit * 128 + 64 * wh + lr) * 128 + 8 * kq;
#pragma unroll
    for (int vi = 0; vi < 4; ++vi) {
        bf16x8 XS[4];
#pragma unroll
        for (int ks = 0; ks < 4; ++ks) XS[ks] = *(const bf16x8*)(sp_ + (size_t)(16 * vi) * 128 + 32 * ks);
#pragma unroll
        for (int ks = 0; ks < 2; ++ks) { const bf16x8 X = *(const HLAS bf16x8*)(L + L_IVT + (64 * wh + 16 * vi + lr) * P_T + (32 * ks + 8 * kq) * 2);
            const bf16x8 Y = *(const HLAS bf16x8*)(L + L_AM + (16 * ct + lr) * P_T + (32 * ks + 8 * kq) * 2); acc[vi] = HG_MFMA(X, Y, acc[vi]); }
#pragma unroll
        for (int ks = 0; ks < 4; ++ks) { const bf16x8 Y = *(const HLAS bf16x8*)(L + L_QD + (16 * ct + lr) * P_QD + (32 * ks + 8 * kq) * 2); acc[vi] = HG_MFMA(XS[ks], Y, acc[vi]); }
    }
    float ss = 0.f;
#pragma unroll
    for (int vi = 0; vi < 4; ++vi) ss += (acc[vi][0] * acc[vi][0] + acc[vi][1] * acc[vi][1]) + (acc[vi][2] * acc[vi][2] + acc[vi][3] * acc[vi][3]);
    ss += __shfl_xor(ss, 16); ss += __shfl_xor(ss, 32);
    HLAS float* SSQ = (HLAS float*)(L + L_SSQ);
    if (kq == 0) SSQ[wh * 64 + 16 * ct + lr] = ss;
    __syncthreads();
    const float tot = SSQ[16 * ct + lr] + SSQ[64 + 16 * ct + lr];
    const float rstd = 1.0f / sqrtf(tot * (1.0f / 128.0f) + 1e-6f);
    const size_t orow = (rowbase + 16 * ct + lr) * 1024 + 128 * h;
#pragma unroll
    for (int vi = 0; vi < 4; ++vi) { const int v0 = 64 * wh + 16 * vi + 4 * kq;
        const f32x4 gn = *(const f32x4*)(T.onorm_g + 128 * h + v0);
        const u32x2 gg = *(const u32x2*)(T.HG + orow + v0);
        const float o0 = acc[vi][0] * rstd * gn[0] * bf2f(gg.x & 0xffffu), o1 = acc[vi][1] * rstd * gn[1] * bf2f(gg.x >> 16);
        const float o2 = acc[vi][2] * rstd * gn[2] * bf2f(gg.y & 0xffffu), o3 = acc[vi][3] * rstd * gn[3] * bf2f(gg.y >> 16);
        *(u32x2*)(T.HQ + orow + v0) = (u32x2){pk2(o0, o1), pk2(o2, o3)}; }
    __syncthreads();
}
}

namespace cg = cooperative_groups;
constexpr int NWAVES = 8;
constexpr int BATCH = 4, T = 8192, D = 1024, H = 16, HD = 64, FF = 2816, FF2 = 5632;
constexpr int M = BATCH * T;
constexpr float RMS_EPS = 1e-6f;
constexpr size_t MiB = 1u << 20;
constexpr size_t WS_WQKV = 1 * MiB;
constexpr size_t WS_WO = WS_WQKV + (size_t)3328 * 1024 * 2;
constexpr size_t WS_WUP0 = WS_WO + (size_t)1024 * 1024 * 2;
constexpr size_t WS_WDN0 = WS_WUP0 + (size_t)5632 * 1024 * 2;
constexpr size_t WS_WHIN = WS_WDN0 + (size_t)1024 * 2816 * 2;
constexpr size_t WS_WHO = WS_WHIN + (size_t)4096 * 1024 * 2;
constexpr size_t WS_WUP1 = WS_WHO + (size_t)1024 * 1024 * 2;
constexpr size_t WS_WDN1 = WS_WUP1 + (size_t)5632 * 1024 * 2;
constexpr size_t WS_WEND = WS_WDN1 + (size_t)1024 * 2816 * 2;
constexpr size_t WS_BIG = 56 * MiB;
constexpr size_t WS_Q = WS_BIG, WS_K = WS_BIG + 64 * MiB, WS_V = WS_BIG + 128 * MiB;
constexpr size_t WS_U = WS_BIG;
constexpr size_t WS_HLF = WS_BIG, WS_HQ = WS_BIG + 64 * MiB, WS_HI = WS_BIG + 128 * MiB, WS_HG = WS_BIG + 192 * MiB, WS_US = WS_BIG + 256 * MiB;
constexpr size_t WS_XN = 408 * MiB;
constexpr size_t WS_UH = 472 * MiB;
constexpr size_t WS_LFT = 484 * MiB;
constexpr size_t WS_DEC = 486 * MiB;
constexpr size_t WS_LB = 488 * MiB;
constexpr size_t WS_END = 489 * MiB;
static_assert(WS_WEND <= WS_BIG && WS_U + (size_t)M * FF2 * 2 <= WS_XN && WS_US + 128 * MiB <= WS_UH && WS_UH + (size_t)512 * 2 * FF2 * 2 <= WS_LFT, "d_ws map");
static_assert(WS_HQ == WS_HLF + 64 * MiB && WS_HI == WS_HLF + 128 * MiB && WS_HG == WS_HLF + 192 * MiB, "EpiHgrn buffer order");
constexpr int LDS_BYTES = 155648;
static_assert(attn_body::ATTN_LDS_BYTES <= LDS_BYTES && hg::L_END <= LDS_BYTES && pg8::STAGE_BYTES <= LDS_BYTES, "LDS map");

#define LAS __attribute__((address_space(3)))
typedef unsigned short bf16;
typedef unsigned v4u __attribute__((ext_vector_type(4)));
typedef float f32x4 __attribute__((ext_vector_type(4)));
__device__ __forceinline__ unsigned f2bf(float f) { unsigned u = __builtin_bit_cast(unsigned, f); return (u + 0x7fffu + ((u >> 16) & 1u)) >> 16; }
__device__ __forceinline__ unsigned pk2(float lo, float hi) { return f2bf(lo) | (f2bf(hi) << 16); }
__device__ __forceinline__ float wave_sum(float v) {
#pragma unroll
    for (int o = 1; o < 64; o <<= 1) v += __shfl_xor(v, o);
    return v;
}
__device__ __forceinline__ void transpose_item(const float* W, int ldw, int K, int nblk, bf16* WT, LAS float* scr, int item, int lane) {
    const int kb = item / nblk, nb = item % nblk, k0 = 64 * kb, n0 = 32 * nb;
#pragma unroll 8
    for (int i = 0; i < 32; ++i) { const int kk = 2 * i + (lane >> 5); scr[kk * 33 + (lane & 31)] = W[(size_t)(k0 + kk) * ldw + n0 + (lane & 31)]; }
    asm volatile("s_waitcnt lgkmcnt(0)" ::: "memory");
    const int c = lane & 7;
#pragma unroll
    for (int j = 0; j < 4; ++j) { const int n = (lane >> 3) + 8 * j; const LAS float* s = scr + (8 * c) * 33 + n;
        v4u o; o.x = pk2(s[0 * 33], s[1 * 33]); o.y = pk2(s[2 * 33], s[3 * 33]); o.z = pk2(s[4 * 33], s[5 * 33]); o.w = pk2(s[6 * 33], s[7 * 33]);
        *(v4u*)(WT + (size_t)(n0 + n) * K + k0 + 8 * c) = o; }
    asm volatile("s_waitcnt lgkmcnt(0)" ::: "memory");
}
__device__ __forceinline__ void norm_rows_bf16(const float* src, const float* g, bf16* dst, int gw, int NGW, int lane) {
    f32x4 gg[4];
#pragma unroll
    for (int j = 0; j < 4; ++j) gg[j] = ((const f32x4*)g)[lane + 64 * j];
    for (int m = gw; m < M; m += NGW) {
        const f32x4* xr = (const f32x4*)(src + (size_t)m * D) + lane; f32x4 v[4]; float s = 0.f;
#pragma unroll
        for (int j = 0; j < 4; ++j) { v[j] = xr[64 * j]; s += (v[j].x * v[j].x + v[j].y * v[j].y) + (v[j].z * v[j].z + v[j].w * v[j].w); }
        const float rstd = 1.0f / sqrtf(wave_sum(s) * (1.0f / D) + RMS_EPS);
        unsigned long long* o8 = (unsigned long long*)(dst + (size_t)m * D) + lane;
#pragma unroll
        for (int j = 0; j < 4; ++j) o8[64 * j] = (unsigned long long)pk2(v[j].x * rstd * gg[j].x, v[j].y * rstd * gg[j].y) | ((unsigned long long)pk2(v[j].z * rstd * gg[j].z, v[j].w * rstd * gg[j].w) << 32);
    }
}
__device__ __forceinline__ void norm_rows_f32(float* buf, const float* g, int gw, int NGW, int lane) {
    f32x4 gg[4];
#pragma unroll
    for (int j = 0; j < 4; ++j) gg[j] = ((const f32x4*)g)[lane + 64 * j];
    for (int m = gw; m < M; m += NGW) {
        f32x4* xr = (f32x4*)(buf + (size_t)m * D) + lane; f32x4 v[4]; float s = 0.f;
#pragma unroll
        for (int j = 0; j < 4; ++j) { v[j] = xr[64 * j]; s += (v[j].x * v[j].x + v[j].y * v[j].y) + (v[j].z * v[j].z + v[j].w * v[j].w); }
        const float rstd = 1.0f / sqrtf(wave_sum(s) * (1.0f / D) + RMS_EPS);
#pragma unroll
        for (int j = 0; j < 4; ++j) xr[64 * j] = v[j] * rstd * gg[j];
    }
}
__device__ __forceinline__ float bfe(const v4u& w, int e) { const unsigned dw = w[e >> 1]; return __builtin_bit_cast(float, (e & 1) ? (dw & 0xffff0000u) : (dw << 16)); }
__device__ __forceinline__ void conv_pass(bf16* U, const bf16* UH, const float* cw, const float* cb, int vcu, int tid) {
    for (int task = tid; task < 2 * 352; task += 512) {
        const int j = vcu * 2 + task / 352, cg_ = task % 352, c0 = 8 * cg_;
        float wg[3][8], wv[3][8], bg[8], bv[8];
#pragma unroll
        for (int k = 0; k < 3; ++k)
#pragma unroll
            for (int e = 0; e < 8; ++e) { wg[k][e] = cw[k * FF2 + c0 + e]; wv[k][e] = cw[k * FF2 + FF + c0 + e]; }
#pragma unroll
        for (int e = 0; e < 8; ++e) { bg[e] = cb[c0 + e]; bv[e] = cb[FF + c0 + e]; }
        const bool seq0 = (j & 127) == 0;
        for (int sl = 7; sl >= 0; --sl) {
            const int r0 = 64 * j + 8 * sl;
            v4u ug[10], uv[10];
#pragma unroll
            for (int i = 0; i < 10; ++i) {
                const bf16* p = U + (size_t)(r0 - 2 + i) * FF2 + c0;
                bool zero = false;
                if (i < 2 && sl == 0) { if (seq0) zero = true; else p = UH + (size_t)((j - 1) * 2 + i) * FF2 + c0; }
                if (zero) { ug[i] = (v4u){0u, 0u, 0u, 0u}; uv[i] = (v4u){0u, 0u, 0u, 0u}; }
                else { ug[i] = *(const v4u*)p; uv[i] = *(const v4u*)(p + FF); }
            }
#pragma unroll
            for (int i = 2; i < 10; ++i) {
                float a[8];
#pragma unroll
                for (int e = 0; e < 8; ++e) {
                    const float yg = bg[e] + wg[0][e] * bfe(ug[i - 2], e) + wg[1][e] * bfe(ug[i - 1], e) + wg[2][e] * bfe(ug[i], e);
                    const float yv = bv[e] + wv[0][e] * bfe(uv[i - 2], e) + wv[1][e] * bfe(uv[i - 1], e) + wv[2][e] * bfe(uv[i], e);
                    a[e] = yg * __builtin_amdgcn_rcpf(1.0f + __expf(-yg)) * yv;
                }
                v4u o; o.x = pk2(a[0], a[1]); o.y = pk2(a[2], a[3]); o.z = pk2(a[4], a[5]); o.w = pk2(a[6], a[7]);
                *(v4u*)(U + (size_t)(r0 - 2 + i) * FF2 + c0) = o;
            }
        }
    }
}

template <class T> __device__ __forceinline__ T* opq(T* p) { asm volatile("" : "+s"(p)); return p; }
struct Args { const float* in[16]; float* out; unsigned char* ws; };
__global__ void __launch_bounds__(NWAVES * 64, 2) fwd_kernel(Args args) {
    extern __shared__ __attribute__((aligned(16))) unsigned char lds[];
    cg::grid_group grid = cg::this_grid();
    LAS unsigned char* L = (LAS unsigned char*)lds;
#define FRESH_TID() ({ int t_ = threadIdx.x; asm volatile("" : "+v"(t_)); t_; })
    const int tid = threadIdx.x, lane = tid & 63, wave = __builtin_amdgcn_readfirstlane(tid >> 6);
    const int G = gridDim.x, bx = blockIdx.x; const int vcu = (G % 8 == 0) ? (bx % 8) * (G / 8) + bx / 8 : bx;
    const int gw = vcu * NWAVES + wave, NGW = G * NWAVES;
    unsigned char* ws = args.ws;
    const float* x = args.in[0]; float* out = args.out;
    bf16* Wqkv_t = (bf16*)(ws + WS_WQKV); bf16* Wo_t = (bf16*)(ws + WS_WO); bf16* Whin_t = (bf16*)(ws + WS_WHIN); bf16* Who_t = (bf16*)(ws + WS_WHO);
    bf16* XN = (bf16*)(ws + WS_XN); bf16* QO = (bf16*)(ws + WS_Q); bf16* U = (bf16*)(ws + WS_U); bf16* UH = (bf16*)(ws + WS_UH);
    float* LFt = (float*)(ws + WS_LFT);

    {
        LAS float* scr = (LAS float*)(L + wave * 16384);
        constexpr int I_QKV = 16 * 96, I_O = 16 * 32, I_UP = 16 * 176, I_DN = 44 * 32, I_HIN = 16 * 128;
        constexpr int NITEMS = I_QKV + 2 * I_O + 2 * I_UP + 2 * I_DN + I_HIN;
        for (int it = gw; it < NITEMS; it += NGW) {
            int r = it;
            if (r < I_QKV) { transpose_item(args.in[2], 3088, 1024, 96, Wqkv_t, scr, r, lane); continue; } r -= I_QKV;
            if (r < I_O) { transpose_item(args.in[4], 1024, 1024, 32, Wo_t, scr, r, lane); continue; } r -= I_O;
            if (r < I_O) { transpose_item(args.in[9], 1024, 1024, 32, Who_t, scr, r, lane); continue; } r -= I_O;
            if (r < I_HIN) { transpose_item(args.in[6], 4096, 1024, 128, Whin_t, scr, r, lane); continue; } r -= I_HIN;
            if (r < I_UP) { transpose_item(args.in[11], FF2, 1024, 176, (bf16*)(ws + WS_WUP0), scr, r, lane); continue; } r -= I_UP;
            if (r < I_UP) { transpose_item(args.in[11] + (size_t)1024 * FF2, FF2, 1024, 176, (bf16*)(ws + WS_WUP1), scr, r, lane); continue; } r -= I_UP;
            if (r < I_DN) { transpose_item(args.in[14], 1024, FF, 32, (bf16*)(ws + WS_WDN0), scr, r, lane); continue; } r -= I_DN;
            transpose_item(args.in[14] + (size_t)FF * 1024, 1024, FF, 32, (bf16*)(ws + WS_WDN1), scr, r, lane);
        }
        for (int idx = bx * 512 + tid; idx < 256 * 128; idx += G * 512) { const int row = 3072 + (idx >> 7), kc = (idx & 127) * 8;
            float v[8];
#pragma unroll
            for (int j = 0; j < 8; ++j) v[j] = row < 3088 ? args.in[2][(size_t)(kc + j) * 3088 + row] : 0.f;
            v4u o; o.x = pk2(v[0], v[1]); o.y = pk2(v[2], v[3]); o.z = pk2(v[4], v[5]); o.w = pk2(v[6], v[7]);
            *(v4u*)(Wqkv_t + (size_t)row * 1024 + kc) = o; }
        if (bx == 0) for (int c = tid; c < 1024; c += 512) ((float*)(ws + WS_LB))[c] = 1.0f / (1.0f + expf(args.in[7][c] - args.in[7][1024 + c]));
        norm_rows_bf16(x, args.in[1], XN, gw, NGW, lane);
    }
    grid.sync();

    { pg8::Gemm g{opq(XN), opq(Wqkv_t), M, 3328, 1024, 1024}; pg8::StaticOrder S; S.init(M, 3328, G, bx);
      pg8::EpiQKV E{QO, LFt, args.in[3], attn_body::C2};
#ifndef NO_EPIQKV_1
      pg8::gemm_phase<pg8::EpiQKV, pg8::StaticOrder, true, true>(L, g, S, E);
#endif
    }
    grid.sync();
    { const attn_body::AttnTensors AT{(const attn_body::bf16*)QO, (const attn_body::bf16*)(ws + WS_K), (const attn_body::bf16*)(ws + WS_V), (attn_body::bf16*)QO, LFt};
      const attn_body::StaticOrder S(G, vcu);
#ifndef NO_ATTN
      attn_body::attn_phase<attn_body::StaticOrder>((char*)lds, AT, S);
#endif
    }
    grid.sync();
#define LAYER_TAIL(LY, AOP, BOP, BASE) do { \
    { pg8::Gemm g{opq(AOP), opq(BOP), M, 1024, 1024, 1024}; pg8::StaticOrder S; S.init(M, 1024, G, bx); \
      pg8::EpiRes E{BASE, out}; \
      pg8::gemm_phase<pg8::EpiRes, pg8::StaticOrder, true, true>(L, g, S, E); } \
    grid.sync(); \
    norm_rows_bf16(out, args.in[10] + (LY) * D, XN, gw, NGW, FRESH_TID() & 63); \
    grid.sync(); \
    { pg8::Gemm g{opq(XN), opq((bf16*)(ws + ((LY) == 0 ? WS_WUP0 : WS_WUP1))), M, FF2, 1024, 1024}; pg8::StaticOrder S; S.init(M, FF2, G, bx); \
      pg8::EpiUp E{U, UH}; \
      pg8::gemm_phase<pg8::EpiUp, pg8::StaticOrder, true, true>(L, g, S, E); } \
    grid.sync(); \
    for (int v = vcu; v < 256; v += G) conv_pass(U, UH, args.in[12] + (size_t)(LY) * 3 * FF2, args.in[13] + (size_t)(LY) * FF2, v, FRESH_TID()); \
    grid.sync(); \
    { pg8::Gemm g{opq(U), opq((bf16*)(ws + ((LY) == 0 ? WS_WDN0 : WS_WDN1))), M, 1024, FF, FF2}; pg8::StaticOrder S; S.init(M, 1024, G, bx); \
      pg8::EpiRes E{out, out}; \
      pg8::gemm_phase<pg8::EpiRes, pg8::StaticOrder, true, true>(L, g, S, E); } \
    grid.sync(); } while (0)
    LAYER_TAIL(0, QO, Wo_t, x);
    norm_rows_bf16(out, args.in[5], XN, gw, NGW, FRESH_TID() & 63);
    grid.sync();
    { pg8::Gemm g{opq(XN), opq(Whin_t), M, 4096, 1024, 1024}; pg8::StaticOrder S; S.init(M, 4096, G, bx);
      pg8::EpiHgrn E{(bf16*)(ws + WS_HLF)};
      pg8::gemm_phase<pg8::EpiHgrn, pg8::StaticOrder, true, true>(L, g, S, E); }
    grid.sync();
    { const hg::Tensors HT{(const hg::u16*)(ws + WS_HLF), (hg::u16*)(ws + WS_HQ), (const hg::u16*)(ws + WS_HI), (const hg::u16*)(ws + WS_HG), (hg::u16*)(ws + WS_US), (float*)(ws + WS_DEC), args.in[8], (const float*)(ws + WS_LB)};
      const int upw = hg::NUNITS / G;
#ifndef NO_HGA
      for (int i = 0; i < upw; ++i) hg::phaseA_unit(L, HT, vcu * upw + i, FRESH_TID());
#endif
      grid.sync();
#ifndef NO_HGB
      for (int vb = bx; vb < 256; vb += G) hg::phaseB(HT, vb, FRESH_TID());
#endif
      grid.sync();
#ifndef NO_HGC
      for (int i = 0; i < upw; ++i) hg::phaseC_unit(L, HT, vcu * upw + i, FRESH_TID());
#endif
      grid.sync(); }
    LAYER_TAIL(1, (bf16*)(ws + WS_HQ), Who_t, (const float*)out);
    norm_rows_f32(out, args.in[15], gw, NGW, FRESH_TID() & 63);
}

extern "C" void kernel_launch(void* const* d_in, const int* in_sizes, int n_in, void* d_out, int out_size, void* d_ws, size_t ws_size, hipStream_t stream) {
    static int grid = 0;
    if (grid == 0) {
        if (n_in != 16 || in_sizes[0] != M * D || out_size != M * D || ws_size < WS_END) { fprintf(stderr, "kernel_launch: unexpected shapes / workspace (n_in %d, in0 %d, out %d, ws %zu); nothing launched\n", n_in, n_in > 0 ? in_sizes[0] : -1, out_size, ws_size); grid = -1; return; }
        int dev = 0, cus = 0, per_cu = 0;
        if (hipGetDevice(&dev) != hipSuccess || hipDeviceGetAttribute(&cus, hipDeviceAttributeMultiprocessorCount, dev) != hipSuccess) { grid = -1; return; }
        if (hipFuncSetAttribute((const void*)fwd_kernel, hipFuncAttributeMaxDynamicSharedMemorySize, LDS_BYTES) != hipSuccess) { fprintf(stderr, "kernel_launch: hipFuncSetAttribute failed\n"); grid = -1; return; }
        if (hipOccupancyMaxActiveBlocksPerMultiprocessor(&per_cu, (const void*)fwd_kernel, NWAVES * 64, LDS_BYTES) != hipSuccess || per_cu < 1) { fprintf(stderr, "kernel_launch: occupancy query gives %d\n", per_cu); per_cu = 1; }
        (void)hipGetLastError();
        grid = cus;
        if (grid != 256) { fprintf(stderr, "kernel_launch: built for 256 CUs, device has %d; nothing launched\n", cus); grid = -1; return; }
    }
    if (grid < 0) return;
    Args a{};
    for (int i = 0; i < 16; ++i) a.in[i] = (const float*)d_in[i];
    a.out = (float*)d_out; a.ws = (unsigned char*)d_ws;
    void* kargs[] = {&a};
    const hipError_t e = hipLaunchCooperativeKernel((const void*)fwd_kernel, dim3(grid), dim3(NWAVES * 64), kargs, LDS_BYTES, stream);
    if (e != hipSuccess) fprintf(stderr, "kernel_launch: cooperative launch failed: %s\n", hipGetErrorString(e));
}
```

```cpp
#include <hip/hip_runtime.h>
#include <hip/hip_cooperative_groups.h>
#include <hip/hip_bf16.h>
#include <cstdio>
#include <cstdint>
#include <cmath>
namespace pg8 {
#define PG8_LAS __attribute__((address_space(3)))
typedef unsigned short bf16_t;
typedef short bf16x8 __attribute__((ext_vector_type(8)));
typedef float f32x4 __attribute__((ext_vector_type(4)));
typedef unsigned u32x4 __attribute__((ext_vector_type(4)));
constexpr int BM = 256, BK = 64, HALF = 128, HTB = HALF * BK * 2  , STAGE_BYTES = 8 * HTB, NXCD = 8, WGM = 8;

__host__ __device__ __forceinline__ int lds_byte(int r, int c) { const int st = (r >> 4) * 2 + (c >> 5), rr = r & 15, cc = c & 31, ob = rr * 64 + cc * 2; return st * 1024 + (ob ^ (((ob >> 9) & 1) << 5)); }
__host__ __device__ __forceinline__ void stage_rc(int b, int& R, int& C) { const int st = b / 1024, sb = b % 1024, swz = sb ^ (((sb >> 9) & 1) << 5); R = (st >> 1) * 16 + swz / 64; C = (st & 1) * 32 + (swz % 64) / 2; }
__host__ __device__ __forceinline__ int perm32(int rho) { const int n = rho >> 4, i = rho & 15; return 8 * (i >> 2) + 4 * n + (i & 3); }

struct Unit { int pm, pn; };
struct Gemm { const bf16_t* A; const bf16_t* Bt; int M, N, K, lda; };

struct StaticOrder {
    int nM, nN, nwg, G, c;
    __host__ __device__ void init(int M, int N, int G_, int c_) { nM = M / BM; nN = N / BM; nwg = nM * nN; G = G_; c = c_; }
    __host__ __device__ bool next(int i, Unit& u) const {
        const long L = (long)i * G + c; if (L >= nwg) return false;
        int wgid = (int)L; { const int q = nwg / NXCD, r = nwg % NXCD, xcd = wgid % NXCD, off = wgid / NXCD; wgid = (xcd < r ? xcd * (q + 1) : r * (q + 1) + (xcd - r) * q) + off; }
        const int nig = WGM * nN, gid = wgid / nig, fm = gid * WGM, gsz = (nM - fm) < WGM ? (nM - fm) : WGM;
        u.pm = fm + ((wgid % nig) % gsz); u.pn = (wgid % nig) / gsz; return true;
    }
    __device__ __forceinline__ void a_ready(const Unit&) const {}
    __device__ __forceinline__ void done(const Unit&) const {}
};
constexpr int MTOK = 32768, DMODEL = 1024, SEQL = 8192, FFN2 = 5632, FFN1 = 2816;
__device__ __forceinline__ unsigned cvt_pk_bf16(float lo, float hi) { unsigned r; asm volatile("v_cvt_pk_bf16_f32 %0, %1, %2" : "=v"(r) : "v"(lo), "v"(hi)); return r; }
typedef _Float16 h16x2 __attribute__((ext_vector_type(2)));
__device__ __forceinline__ unsigned cvt_pk_f16(float lo, float hi) { h16x2 v = {(_Float16)lo, (_Float16)hi}; return __builtin_bit_cast(unsigned, v); }
__device__ __forceinline__ float silu_f(float x) { return x * __builtin_amdgcn_rcpf(1.0f + __expf(-x)); }

struct EpiQKV {
    static constexpr bool PERM = true, AFTER_DRAIN = false;
    bf16_t* QKV; float* LFt; const float* b_f; float scale0;
    __device__ __forceinline__ void operator()(const f32x4 (&acc)[2][2][4][2], const Unit& u, int wr, int wc, int fr, int fq) const {
        const int row0 = u.pm * BM + wr * 64 + fr;
        if (u.pn < 12) {
            const int part = u.pn >> 2; bf16_t* base = QKV + (size_t)part * ((size_t)MTOK * DMODEL);
            const float sc = part == 0 ? scale0 : 1.f; const int col0 = (u.pn & 3) * BM + wc * 32 + 8 * fq;
#pragma unroll
            for (int ai = 0; ai < 2; ++ai)
#pragma unroll
                for (int m = 0; m < 4; ++m) { bf16_t* rowp = base + (size_t)(row0 + ai * HALF + m * 16) * DMODEL + col0;
#pragma unroll
                    for (int bj = 0; bj < 2; ++bj) { const f32x4 v0 = acc[ai][bj][m][0] * sc, v1 = acc[ai][bj][m][1] * sc;
                        u32x4 w; w.x = cvt_pk_bf16(v0[0], v0[1]); w.y = cvt_pk_bf16(v0[2], v0[3]); w.z = cvt_pk_bf16(v1[0], v1[1]); w.w = cvt_pk_bf16(v1[2], v1[3]);
                        *(u32x4*)(rowp + bj * HALF) = w; } }
        } else if (wc == 0 && fq < 2) {
            float bias[8];
#pragma unroll
            for (int e = 0; e < 8; ++e) bias[e] = b_f[8 * fq + e];
#pragma unroll
            for (int ai = 0; ai < 2; ++ai)
#pragma unroll
                for (int m = 0; m < 4; ++m) { const int row = row0 + ai * HALF + m * 16; const int b = row >> 13, t = row & (SEQL - 1);
#pragma unroll
                    for (int n = 0; n < 2; ++n)
#pragma unroll
                        for (int e = 0; e < 4; ++e) { const int hh = 8 * fq + 4 * n + e; const float z = acc[ai][0][m][n][e] + bias[4 * n + e];
                            const float lf = fminf(z, 0.f) - log1pf(__expf(-fabsf(z)));
                            LFt[(size_t)(b * 16 + hh) * SEQL + t] = lf; } }
        }
    }
};
struct EpiRes {
    static constexpr bool PERM = false, AFTER_DRAIN = false;
    const float* base; float* out;
    __device__ __forceinline__ void operator()(const f32x4 (&acc)[2][2][4][2], const Unit& u, int wr, int wc, int fr, int fq) const {
        const int col0 = u.pn * BM + wc * 32 + 4 * fq;
#pragma unroll
        for (int ai = 0; ai < 2; ++ai)
#pragma unroll
            for (int m = 0; m < 4; ++m) { const size_t off = (size_t)(u.pm * BM + ai * HALF + wr * 64 + m * 16 + fr) * DMODEL + col0;
                f32x4 bs[2][2];
#pragma unroll
                for (int bj = 0; bj < 2; ++bj)
#pragma unroll
                    for (int n = 0; n < 2; ++n) bs[bj][n] = *(const f32x4*)(base + off + bj * HALF + n * 16);
#pragma unroll
                for (int bj = 0; bj < 2; ++bj)
#pragma unroll
                    for (int n = 0; n < 2; ++n) *(f32x4*)(out + off + bj * HALF + n * 16) = bs[bj][n] + acc[ai][bj][m][n];
                if (m & 1) asm volatile("" ::: "memory"); }
    }
};
template <int CTRL> __device__ __forceinline__ float dppz(float x) { return __builtin_bit_cast(float, __builtin_amdgcn_update_dpp(0, __builtin_bit_cast(int, x), CTRL, 0xf, 0xf, true)); }
__device__ __forceinline__ float bf_lo(unsigned w) { return __builtin_bit_cast(float, w << 16); }
__device__ __forceinline__ float bf_hi(unsigned w) { return __builtin_bit_cast(float, w & 0xffff0000u); }
struct EpiUpConv {
    static constexpr bool PERM = true, AFTER_DRAIN = false;
    bf16_t* ACT; float* UHf; const bf16_t* CWB; PG8_LAS f32x4* XH;
    __device__ __forceinline__ void operator()(const f32x4 (&acc)[2][2][4][2], const Unit& u, int wr, int wc, int fr, int fq) const {
        typedef unsigned u32x2 __attribute__((ext_vector_type(2)));
        const int cl0 = wc * 32 + 8 * fq, gc0 = u.pn * HALF + cl0;
        if (fr >= 14) {
#pragma unroll
            for (int ai = 0; ai < 2; ++ai) { PG8_LAS f32x4* dst = XH + ((((ai * 2 + wr) * 4 + wc) * 4 + fq) * 2 + (fr - 14)) * 4;
                dst[0] = acc[ai][0][3][0]; dst[1] = acc[ai][0][3][1]; dst[2] = acc[ai][1][3][0]; dst[3] = acc[ai][1][3][1]; }
        }
        if (wr == 0 && fr < 2) { float* p = UHf + (((size_t)u.pm * 2 + 0) * 2 + fr) * FFN2 + u.pn * BM + cl0;
            *(f32x4*)p = acc[0][0][0][0]; *(f32x4*)(p + 4) = acc[0][0][0][1]; *(f32x4*)(p + HALF) = acc[0][1][0][0]; *(f32x4*)(p + HALF + 4) = acc[0][1][0][1]; }
        if (wr == 1 && fr >= 14) { float* p = UHf + (((size_t)u.pm * 2 + 1) * 2 + (fr - 14)) * FFN2 + u.pn * BM + cl0;
            *(f32x4*)p = acc[1][0][3][0]; *(f32x4*)(p + 4) = acc[1][0][3][1]; *(f32x4*)(p + HALF) = acc[1][1][3][0]; *(f32x4*)(p + HALF + 4) = acc[1][1][3][1]; }
        asm volatile("s_waitcnt lgkmcnt(0)" ::: "memory"); __builtin_amdgcn_s_barrier(); asm volatile("" ::: "memory");
#pragma unroll
        for (int n = 0; n < 2; ++n) {
            u32x2 wt[2][4];
#pragma unroll
            for (int k = 0; k < 4; ++k) { wt[0][k] = *(const u32x2*)(CWB + k * FFN2 + gc0 + 4 * n); wt[1][k] = *(const u32x2*)(CWB + k * FFN2 + FFN1 + gc0 + 4 * n); }
#pragma unroll
            for (int ai = 0; ai < 2; ++ai) {
                const bool has = (wr == 1) || (ai == 1);
                const int pai = (wr == 1) ? ai : 0, pwr = (wr == 1) ? 0 : 1;
                const PG8_LAS f32x4* hsrc = XH + (((pai * 2 + pwr) * 4 + wc) * 4 + fq) * 8;
#pragma unroll
                for (int m = 0; m < 4; ++m) {
                    asm volatile("" : "+v"(wt[0][0]), "+v"(wt[0][1]), "+v"(wt[0][2]), "+v"(wt[0][3]), "+v"(wt[1][0]), "+v"(wt[1][1]), "+v"(wt[1][2]), "+v"(wt[1][3]));
                    float yg[4];
#pragma unroll
                    for (int bj = 0; bj < 2; ++bj) {
                        f32x4 p1, p2; const f32x4 x = acc[ai][bj][m][n];
                        if (m == 0) { f32x4 h14 = (f32x4){0.f, 0.f, 0.f, 0.f}, h15 = h14;
                            if (has) { h14 = hsrc[bj * 2 + n]; h15 = hsrc[4 + bj * 2 + n]; }
#pragma unroll
                            for (int e = 0; e < 4; ++e) { p1[e] = dppz<0x111>(x[e]) + (fr == 0 ? h15[e] : 0.f); p2[e] = dppz<0x112>(x[e]) + (fr == 0 ? h14[e] : (fr == 1 ? h15[e] : 0.f)); }
                        } else { const f32x4 xp = acc[ai][bj][m > 0 ? m - 1 : 0][n];
#pragma unroll
                            for (int e = 0; e < 4; ++e) { p1[e] = dppz<0x111>(x[e]) + dppz<0x10F>(xp[e]); p2[e] = dppz<0x112>(x[e]) + dppz<0x10E>(xp[e]); }
                        }
#pragma unroll
                        for (int e = 0; e < 4; ++e) { const unsigned w0 = wt[bj][0][e >> 1], w1 = wt[bj][1][e >> 1], w2 = wt[bj][2][e >> 1], wb = wt[bj][3][e >> 1];
                            const float t0 = (e & 1) ? bf_hi(w0) : bf_lo(w0), t1 = (e & 1) ? bf_hi(w1) : bf_lo(w1), t2 = (e & 1) ? bf_hi(w2) : bf_lo(w2), tb = (e & 1) ? bf_hi(wb) : bf_lo(wb);
                            const float y = tb + t0 * p2[e] + t1 * p1[e] + t2 * x[e];
                            if (bj == 0) yg[e] = y; else yg[e] = silu_f(yg[e]) * y; }
                    }
                    *(u32x2*)(ACT + (size_t)(u.pm * BM + ai * HALF + wr * 64 + m * 16 + fr) * FFN1 + gc0 + 4 * n) = (u32x2){cvt_pk_bf16(yg[0], yg[1]), cvt_pk_bf16(yg[2], yg[3])};
                    __builtin_amdgcn_sched_barrier(0);
                }
            }
        }
    }
};
struct EpiHgrn {
    static constexpr bool PERM = true, AFTER_DRAIN = false;
    bf16_t* HB;
    __device__ __forceinline__ void operator()(const f32x4 (&acc)[2][2][4][2], const Unit& u, int wr, int wc, int fr, int fq) const {
        const int part = u.pn >> 2; const int row0 = u.pm * BM + wr * 64 + fr, col0 = (u.pn & 3) * BM + wc * 32 + 8 * fq;
        bf16_t* dst = HB + (size_t)(part == 0 ? 1 : (part == 1 ? 0 : part)) * ((size_t)MTOK * DMODEL); const bool act = (part == 0) || (part == 3);
#pragma unroll
        for (int ai = 0; ai < 2; ++ai)
#pragma unroll
            for (int m = 0; m < 4; ++m) { bf16_t* rowp = dst + (size_t)(row0 + ai * HALF + m * 16) * DMODEL + col0;
#pragma unroll
                for (int bj = 0; bj < 2; ++bj) { float r[8];
#pragma unroll
                    for (int e = 0; e < 8; ++e) { const float z = acc[ai][bj][m][e >> 2][e & 3]; r[e] = act ? silu_f(z) : z; }
                    u32x4 w;
                    if (part == 1) { w.x = cvt_pk_f16(r[0], r[1]); w.y = cvt_pk_f16(r[2], r[3]); w.z = cvt_pk_f16(r[4], r[5]); w.w = cvt_pk_f16(r[6], r[7]); }
                    else { w.x = cvt_pk_bf16(r[0], r[1]); w.y = cvt_pk_bf16(r[2], r[3]); w.z = cvt_pk_bf16(r[4], r[5]); w.w = cvt_pk_bf16(r[6], r[7]); }
                    *(u32x4*)(rowp + bj * HALF) = w; } }
    }
};

template <class Epi, class Sched, bool ALIGN_EPI = false, bool SP2 = false>
__device__ __forceinline__ void gemm_phase(PG8_LAS unsigned char* lds, const Gemm g, const Sched& S, const Epi& E) {
    int tid = threadIdx.x; asm volatile("" : "+v"(tid)); const int wid = __builtin_amdgcn_readfirstlane(tid >> 6), lane = tid & 63, wr = wid >> 2, wc = wid & 3, fr = lane & 15, fq = lane >> 4;
    const int K = g.K, nt = K / BK;
    unsigned voffA[2], voffB[2];
#pragma unroll
    for (int i = 0; i < 2; ++i) { int R, C; stage_rc(tid * 16 + i * 8192, R, C); const int Rb = Epi::PERM ? ((R & ~31) + perm32(R & 31)) : R;
        voffA[i] = (unsigned)(R * g.lda + C) * 2u; voffB[i] = (unsigned)(Rb * K + C) * 2u; }
    const size_t kstep = (size_t)(BK * 2);
    const size_t hstepA = (size_t)HALF * g.lda * 2, hstepB = (size_t)HALF * K * 2;
    const size_t tstepA = 2 * hstepA, tstepB = 2 * hstepB;
    const unsigned ldsw = (unsigned)wid * 1024u;
    const int aoff = lds_byte(wr * 64 + fr, fq * 8), boff = lds_byte(wc * 32 + fr, fq * 8);
#define PG8_SA(b, h) (((b) * 2 + (h)) * HTB)
#define PG8_SB(b, h) ((4 + (b) * 2 + (h)) * HTB)
#define PG8_STAGE(bufoff, gbase, voff) do { _Pragma("unroll") for (int _i = 0; _i < 2; ++_i) \
        __builtin_amdgcn_global_load_lds((const unsigned*)((const char*)(gbase) + (voff)[_i]), (PG8_LAS unsigned*)(lds + (bufoff) + ldsw + _i * 8192), 16, 0, 0); } while (0)
#define PG8_LDA(dst, b, h) do { _Pragma("unroll") for (int m = 0; m < 4; ++m) _Pragma("unroll") for (int k = 0; k < 2; ++k) dst[m][k] = *(const PG8_LAS bf16x8*)(lds + PG8_SA(b, h) + aoff + m * 2048 + k * 1024); } while (0)
#define PG8_LDB(dst, b, h) do { _Pragma("unroll") for (int n = 0; n < 2; ++n) _Pragma("unroll") for (int k = 0; k < 2; ++k) dst[n][k] = *(const PG8_LAS bf16x8*)(lds + PG8_SB(b, h) + boff + n * 2048 + k * 1024); } while (0)
#define PG8_MMA(ai, bj, At, Bt) do { __builtin_amdgcn_s_setprio(1); _Pragma("unroll") for (int m = 0; m < 4; ++m) _Pragma("unroll") for (int n = 0; n < 2; ++n) _Pragma("unroll") for (int k = 0; k < 2; ++k) \
        acc[ai][bj][m][n] = __builtin_amdgcn_mfma_f32_16x16x32_bf16(Bt[n][k], At[m][k], acc[ai][bj][m][n], 0, 0, 0); __builtin_amdgcn_s_setprio(0); } while (0)
#define PG8_WAIT_V(n) asm volatile("s_waitcnt vmcnt(" #n ")" ::: "memory")
#define PG8_WAIT_L(n) asm volatile("s_waitcnt lgkmcnt(" #n ")" ::: "memory")
#define PG8_BAR __builtin_amdgcn_s_barrier()
#define PG8_SCHED __builtin_amdgcn_sched_barrier(0)
    Unit cur, nxt; int ui = 0;
    if (!S.next(0, cur)) return;
    f32x4 acc[2][2][4][2];
#pragma unroll
    for (int a = 0; a < 2; ++a)
#pragma unroll
        for (int b = 0; b < 2; ++b)
#pragma unroll
            for (int m = 0; m < 4; ++m)
#pragma unroll
                for (int n = 0; n < 2; ++n) acc[a][b][m][n] = (f32x4){0.f, 0.f, 0.f, 0.f};
    bf16x8 At[4][2], B0[2][2], B1[2][2];
    const char* cA = (const char*)g.A + (size_t)cur.pm * tstepA; const char* cB = (const char*)g.Bt + (size_t)cur.pn * tstepB;
    S.a_ready(cur);
    if constexpr (SP2) {
        PG8_STAGE(PG8_SB(0, 0), cB, voffB); PG8_STAGE(PG8_SB(0, 1), cB + hstepB, voffB); PG8_STAGE(PG8_SA(0, 0), cA, voffA); PG8_STAGE(PG8_SA(0, 1), cA + hstepA, voffA);
        if (wr == 1) PG8_BAR;
        PG8_WAIT_V(2); PG8_BAR;
        PG8_STAGE(PG8_SB(1, 0), cB + kstep, voffB); PG8_STAGE(PG8_SA(1, 0), cA + kstep, voffA); PG8_STAGE(PG8_SB(1, 1), cB + hstepB + kstep, voffB);
        PG8_WAIT_V(6); PG8_BAR;
    } else {
        PG8_STAGE(PG8_SB(0, 0), cB, voffB); PG8_STAGE(PG8_SA(0, 0), cA, voffA); PG8_STAGE(PG8_SB(0, 1), cB + hstepB, voffB); PG8_STAGE(PG8_SA(0, 1), cA + hstepA, voffA);
        if (wr == 1) PG8_BAR;
        PG8_WAIT_V(4); PG8_BAR;
        PG8_STAGE(PG8_SB(1, 0), cB + kstep, voffB); PG8_STAGE(PG8_SA(1, 0), cA + kstep, voffA); PG8_STAGE(PG8_SB(1, 1), cB + hstepB + kstep, voffB);
        PG8_WAIT_V(6); PG8_BAR;
    }
    for (;;) {
        const bool has_next = S.next(ui + 1, nxt);
        const char* nA = has_next ? (const char*)g.A + (size_t)nxt.pm * tstepA : cA; const char* nB = has_next ? (const char*)g.Bt + (size_t)nxt.pn * tstepB : cB;
        for (int t = 0; t < nt; t += 2) {
            const bool last = (t == nt - 2);
            const char* a1 = cA + (size_t)(t + 1) * kstep;
            const char* a2 = last ? nA : cA + (size_t)(t + 2) * kstep; const char* b2 = last ? nB : cB + (size_t)(t + 2) * kstep;
            const char* a3 = a2 + kstep; const char* b3 = b2 + kstep;
            if (last && has_next) S.a_ready(nxt);
            if constexpr (SP2) {
            PG8_LDB(B0, 0, 0); PG8_LDB(B1, 0, 1); PG8_SCHED; PG8_LDA(At, 0, 0); PG8_STAGE(PG8_SA(1, 1), a1 + hstepA, voffA);
            PG8_WAIT_V(8); PG8_WAIT_L(0); PG8_BAR; PG8_MMA(0, 0, At, B0); PG8_MMA(0, 1, At, B1); PG8_BAR; PG8_SCHED;
            PG8_LDA(At, 0, 1); PG8_STAGE(PG8_SB(0, 0), b2, voffB); PG8_STAGE(PG8_SB(0, 1), b2 + hstepB, voffB); PG8_STAGE(PG8_SA(0, 0), a2, voffA);
            PG8_WAIT_V(8); PG8_WAIT_L(0); PG8_BAR; PG8_MMA(1, 0, At, B0); PG8_MMA(1, 1, At, B1); PG8_BAR; PG8_SCHED;
            PG8_LDB(B0, 1, 0); PG8_LDB(B1, 1, 1); PG8_SCHED; PG8_LDA(At, 1, 0); PG8_STAGE(PG8_SA(0, 1), a2 + hstepA, voffA);
            PG8_WAIT_V(8); PG8_WAIT_L(0); PG8_BAR; PG8_MMA(0, 0, At, B0); PG8_MMA(0, 1, At, B1); PG8_BAR; PG8_SCHED;
            PG8_LDA(At, 1, 1); PG8_STAGE(PG8_SB(1, 0), b3, voffB); PG8_STAGE(PG8_SB(1, 1), b3 + hstepB, voffB); PG8_STAGE(PG8_SA(1, 0), a3, voffA);
            PG8_WAIT_V(8); PG8_WAIT_L(0); PG8_BAR; PG8_MMA(1, 0, At, B0); PG8_MMA(1, 1, At, B1); PG8_BAR; PG8_SCHED;
            } else {
            PG8_LDB(B0, 0, 0); PG8_SCHED; PG8_LDA(At, 0, 0); PG8_STAGE(PG8_SA(1, 1), a1 + hstepA, voffA);
            PG8_WAIT_L(8); PG8_BAR; PG8_WAIT_L(0); PG8_MMA(0, 0, At, B0); PG8_BAR; PG8_SCHED;
            PG8_LDB(B1, 0, 1); PG8_STAGE(PG8_SB(0, 0), b2, voffB);
            PG8_BAR; PG8_WAIT_L(0); PG8_MMA(0, 1, At, B1); PG8_BAR;
            PG8_LDA(At, 0, 1); PG8_STAGE(PG8_SA(0, 0), a2, voffA);
            PG8_BAR; PG8_WAIT_L(0); PG8_MMA(1, 0, At, B0); PG8_BAR; PG8_SCHED;
            PG8_STAGE(PG8_SB(0, 1), b2 + hstepB, voffB);
            PG8_WAIT_V(6); PG8_BAR; PG8_MMA(1, 1, At, B1); PG8_BAR;
            PG8_LDB(B0, 1, 0); PG8_SCHED; PG8_LDA(At, 1, 0); PG8_STAGE(PG8_SA(0, 1), a2 + hstepA, voffA);
            PG8_WAIT_L(8); PG8_BAR; PG8_WAIT_L(0); PG8_MMA(0, 0, At, B0); PG8_BAR; PG8_SCHED;
            PG8_LDB(B1, 1, 1); PG8_STAGE(PG8_SB(1, 0), b3, voffB);
            PG8_BAR; PG8_WAIT_L(0); PG8_MMA(0, 1, At, B1); PG8_BAR;
            PG8_LDA(At, 1, 1); PG8_STAGE(PG8_SA(1, 0), a3, voffA);
            PG8_BAR; PG8_WAIT_L(0); PG8_MMA(1, 0, At, B0); PG8_BAR; PG8_SCHED;
            PG8_STAGE(PG8_SB(1, 1), b3 + hstepB, voffB);
            PG8_WAIT_V(6); PG8_BAR; PG8_MMA(1, 1, At, B1); PG8_BAR;
            }
        }
        if constexpr (ALIGN_EPI) { if (wr == 0) PG8_BAR; }
        if constexpr (!Epi::AFTER_DRAIN) { int l2_ = lane; asm volatile("" : "+v"(l2_)); E(acc, cur, wr, wc, l2_ & 15, l2_ >> 4); S.done(cur); }
        if (!has_next) break;
#pragma unroll
        for (int a = 0; a < 2; ++a)
#pragma unroll
            for (int b = 0; b < 2; ++b)
#pragma unroll
                for (int m = 0; m < 4; ++m)
#pragma unroll
                    for (int n = 0; n < 2; ++n) acc[a][b][m][n] = (f32x4){0.f, 0.f, 0.f, 0.f};
        cur = nxt; cA = nA; cB = nB; ++ui;
        if constexpr (ALIGN_EPI) { if (wr == 1) PG8_BAR; }
    }
    PG8_WAIT_V(0);
    if constexpr (!ALIGN_EPI) { if (wr == 0) PG8_BAR; }
    PG8_BAR;
    if constexpr (Epi::AFTER_DRAIN) { E.fused(acc, cur, wr, wc, fr, fq, lds, wid, lane); S.done(cur); }
#undef PG8_SA
#undef PG8_SB
#undef PG8_STAGE
#undef PG8_LDA
#undef PG8_LDB
#undef PG8_MMA
#undef PG8_WAIT_V
#undef PG8_WAIT_L
#undef PG8_BAR
#undef PG8_SCHED
}
}
namespace attn_body {
using bf16=__hip_bfloat16;
using bf16x8=__attribute__((ext_vector_type(8)))short;
using s16x4=__attribute__((ext_vector_type(4)))short;
using f32x16=__attribute__((ext_vector_type(16)))float;
using u32x4=__attribute__((ext_vector_type(4)))unsigned;
constexpr int BATCH=4,NHEAD=16,SEQ=8192,D=64,DM=NHEAD*D;
constexpr int NW=8,QBLK=32,QB=QBLK*NW,KVBLK=64,NQB=SEQ/QB;
constexpr int ATTN_PITCH=DM, ATTN_UNIT_ROWS=QB;
__device__ __forceinline__ int crow(int r,int hi){return (r&3)+8*(r>>2)+4*hi;}
#define SBAR() __builtin_amdgcn_sched_barrier(0)
__device__ __forceinline__ void cmask(f32x16&p0,f32x16&p1,int jb,int qrel,int hi){
  const float NEG=-INFINITY; int kb=64*jb+4*hi;
  #pragma unroll
  for(int r=0;r<16;++r){int kv=kb+(r&3)+8*(r>>2); if(kv>qrel)p0[r]=NEG; if(kv+32>qrel)p1[r]=NEG;}
}

constexpr int NSLOT=3, SLOTB=8192;
constexpr int LDS_K=0, LDS_V=NSLOT*SLOTB, LDS_WS=2*NSLOT*SLOTB, LDS_OST=LDS_WS+NW*64*4, LDS_BYTES=LDS_OST+NW*4096; constexpr int LDS_KX=LDS_BYTES, LDS_SCAN=LDS_KX+SEQ*8, LDS_TOTAL=LDS_SCAN+64;
constexpr float C2=0.125f*1.4426950408889634f;
__device__ __forceinline__ void glds16(const void*gsrc,unsigned lds_dst){unsigned keep;
  asm volatile("s_mov_b32 %0, m0\n\ts_mov_b32 m0, %2\n\ts_nop 0\n\tglobal_load_lds_dwordx4 %1, off\n\ts_mov_b32 m0, %0":"=&s"(keep):"v"(gsrc),"s"(lds_dst):"memory");}
__device__ __forceinline__ float max3f(float a,float b,float c){float r;asm("v_max3_f32 %0, %1, %2, %3":"=v"(r):"v"(a),"v"(b),"v"(c));return r;}
__device__ __forceinline__ float max2f(float a,float b){float r;asm("v_max_f32_e32 %0, %1, %2":"=v"(r):"v"(a),"v"(b));return r;}
__device__ __forceinline__ float fadd_s(float a,float b){float r;asm("v_add_f32_e32 %0, %1, %2":"=v"(r):"v"(a),"v"(b));return r;}
__device__ __forceinline__ float fsub_s(float a,float b){float r;asm("v_sub_f32_e32 %0, %1, %2":"=v"(r):"v"(a),"v"(b));return r;}
typedef float f32x2_t __attribute__((ext_vector_type(2))); typedef __bf16 bf16x2_t __attribute__((ext_vector_type(2)));
__device__ __forceinline__ unsigned cvtpk_s(float lo,float hi){f32x2_t v={lo,hi};bf16x2_t b=__builtin_convertvector(v,bf16x2_t);return __builtin_bit_cast(unsigned,b);}
#define WAIT_BAR(N) asm volatile("s_waitcnt vmcnt(" #N ") lgkmcnt(0)\n\ts_barrier":::"memory")

typedef unsigned u32x2_t __attribute__((ext_vector_type(2))); typedef float f32x4_t __attribute__((ext_vector_type(4)));
__device__ __forceinline__ u32x2_t split3(float x){ const unsigned p1=cvtpk_s(x,0.f)&0xffffu; const float r1=x-__uint_as_float(p1<<16); const unsigned p2=cvtpk_s(r1,0.f)&0xffffu; const float r2=r1-__uint_as_float(p2<<16);
  const unsigned p3=cvtpk_s(r2,0.f)&0xffffu; return (u32x2_t){p1|(p2<<16),p3|(0x3F80u<<16)}; }
__device__ __forceinline__ bf16x8 mkqx(float x,int hi){ const unsigned p1=cvtpk_s(x,0.f)&0xffffu; const float r1=x-__uint_as_float(p1<<16); const unsigned p2=cvtpk_s(r1,0.f)&0xffffu; const float r2=r1-__uint_as_float(p2<<16);
  const unsigned p3=cvtpk_s(r2,0.f)&0xffffu; u32x4 w=(u32x4){0x3F803F80u,0x3F80u|(p1<<16),p2|(p3<<16),0u}; if(hi)w=(u32x4){0u,0u,0u,0u}; return __builtin_bit_cast(bf16x8,w); }
__device__ __forceinline__ bf16x8 kxa(u32x2_t q){ return __builtin_bit_cast(bf16x8,(u32x4){q.x,q.y,0x3F803F80u,0u}); }
__device__ __forceinline__ void qkt(f32x16&p0,f32x16&p1,const char*Kslot,const bf16x8*qr,bf16x8 kx0,bf16x8 kx1,bf16x8 qx,int r32,int hi){
  const char*kb=Kslot+hi*1024+r32*16;
  p0=__builtin_amdgcn_mfma_f32_32x32x16_bf16(kx0,qx,f32x16{},0,0,0);p1=__builtin_amdgcn_mfma_f32_32x32x16_bf16(kx1,qx,f32x16{},0,0,0);
  #pragma unroll
  for(int d0=0;d0<4;++d0){
    const bf16x8 b0=*reinterpret_cast<const bf16x8*>(kb+d0*2048);
    const bf16x8 b1=*reinterpret_cast<const bf16x8*>(kb+d0*2048+512);
    p0=__builtin_amdgcn_mfma_f32_32x32x16_bf16(b0,qr[d0],p0,0,0,0);p1=__builtin_amdgcn_mfma_f32_32x32x16_bf16(b1,qr[d0],p1,0,0,0);}
}
typedef __attribute__((address_space(3))) const char* lds_cptr;
typedef short v4i16_t __attribute__((ext_vector_type(4)));
__device__ __forceinline__ void kload8(bf16x8*kf,lds_cptr kp){
  kf[0]=*(const __attribute__((address_space(3))) bf16x8*)(kp);      kf[1]=*(const __attribute__((address_space(3))) bf16x8*)(kp+512);
  kf[2]=*(const __attribute__((address_space(3))) bf16x8*)(kp+2048); kf[3]=*(const __attribute__((address_space(3))) bf16x8*)(kp+2560);
  kf[4]=*(const __attribute__((address_space(3))) bf16x8*)(kp+4096); kf[5]=*(const __attribute__((address_space(3))) bf16x8*)(kp+4608);
  kf[6]=*(const __attribute__((address_space(3))) bf16x8*)(kp+6144); kf[7]=*(const __attribute__((address_space(3))) bf16x8*)(kp+6656);
}
__device__ __forceinline__ void kload2(bf16x8*kf,lds_cptr kp,int j){ kf[2*j]=*(const __attribute__((address_space(3))) bf16x8*)(kp+j*2048); kf[2*j+1]=*(const __attribute__((address_space(3))) bf16x8*)(kp+j*2048+512); }
__device__ __forceinline__ s16x4 vtr(lds_cptr p){ return __builtin_bit_cast(s16x4,__builtin_amdgcn_ds_read_tr16_b64_v4i16((__attribute__((address_space(3))) v4i16_t*)p)); }
__device__ __forceinline__ float rowmax(const f32x16&p0,const f32x16&p1){
  float a=max3f(p0[0],p0[1],p1[0]),b=max3f(p0[2],p0[3],p1[1]);a=max3f(a,p1[2],p1[3]);
  #pragma unroll
  for(int r=4;r<16;r+=4){a=max3f(a,p0[r],p0[r+1]);b=max3f(b,p0[r+2],p0[r+3]);a=max3f(a,p1[r],p1[r+1]);b=max3f(b,p1[r+2],p1[r+3]);}
  const float m=max2f(a,b);
  auto rr=__builtin_amdgcn_permlane32_swap(__float_as_uint(m),__float_as_uint(m),false,false);
  return max2f(__uint_as_float(rr[0]),__uint_as_float(rr[1]));
}
__device__ __forceinline__ void pv(f32x16*o,int vb,bf16x8 pa0,bf16x8 pa1,bf16x8 pa2,bf16x8 pa3){
  #pragma unroll
  for(int d0=0;d0<2;++d0){s16x4 lo[4],hi[4];
    #pragma unroll
    for(int ks=0;ks<4;++ks){
      asm volatile("ds_read_b64_tr_b16 %0,%1 offset:%c2":"=&v"(lo[ks]):"v"(vb),"i"(d0*4096+ks*1024):"memory");
      asm volatile("ds_read_b64_tr_b16 %0,%1 offset:%c2":"=&v"(hi[ks]):"v"(vb),"i"(d0*4096+ks*1024+512):"memory");}
    asm volatile("s_waitcnt lgkmcnt(0)":::"memory");SBAR();
    #define PK(k) (bf16x8){lo[k][0],lo[k][1],lo[k][2],lo[k][3],hi[k][0],hi[k][1],hi[k][2],hi[k][3]}
    o[d0]=__builtin_amdgcn_mfma_f32_32x32x16_bf16(pa0,PK(0),o[d0],0,0,0);
    o[d0]=__builtin_amdgcn_mfma_f32_32x32x16_bf16(pa1,PK(1),o[d0],0,0,0);
    o[d0]=__builtin_amdgcn_mfma_f32_32x32x16_bf16(pa2,PK(2),o[d0],0,0,0);
    o[d0]=__builtin_amdgcn_mfma_f32_32x32x16_bf16(pa3,PK(3),o[d0],0,0,0);
    #undef PK
  }
}

#ifndef ATTN_STORE16
#define ATTN_STORE16(p,v) (*(u32x4*)(p)=(v))
#endif
template<int THRL> __device__ __forceinline__ void attn_unit(int b,int h,int qb,const bf16*Q,const bf16*__restrict__ K,const bf16*__restrict__ V,bf16*O,const float*__restrict__ LFt,char*shm){
  int tid=threadIdx.x; asm volatile("":"+v"(tid)); const int lane=tid&63,r32=lane&31,hi=lane>>5; const int wid=__builtin_amdgcn_readfirstlane(tid>>6);
  const long rowbase=(long)b*SEQ; const int q0=qb*QB;
  const bf16*Qw=Q+(rowbase+q0+wid*QBLK)*DM+h*D;
  const bf16*Kh=K+rowbase*DM+h*D,*Vh=V+rowbase*DM+h*D;
  const unsigned lds0=(unsigned)(uintptr_t)shm;
  float*wsf=(float*)(shm+LDS_WS)+wid*64;
  const bf16*ksrc=Kh+(long)lane*DM+wid*8;
  const bf16*vsrc=Vh+(long)(16*(wid&3)+(lane>>2))*DM+(wid>>2)*32+(lane&3)*8;
  const unsigned kdst=lds0+LDS_K+wid*1024, vdst=lds0+LDS_V+wid*1024;
  #define DMA_K(t,slot) glds16(ksrc+(long)(t)*KVBLK*DM,(unsigned)__builtin_amdgcn_readfirstlane(kdst+(slot)))
  #define DMA_V(t,slot) glds16(vsrc+(long)(t)*KVBLK*DM,(unsigned)__builtin_amdgcn_readfirstlane(vdst+(slot)))
  const int vb0=(int)(lds0+LDS_V)+((lane>>4)&1)*32+(lane&3)*8+(4*hi+((lane&15)>>2))*64;
  const char*Kbase=shm+LDS_K; bf16x8 kf[8];
  const lds_cptr shm3=(lds_cptr)shm; const lds_cptr kp0=shm3+LDS_K+hi*1024+r32*16; const lds_cptr vp0=shm3+LDS_V+((lane>>4)&1)*32+(lane&3)*8+(4*hi+((lane&15)>>2))*64;
  const int NT=(q0+QB)/KVBLK;
  {
    typedef __attribute__((address_space(3))) char* lds_wptr; const lds_wptr shmw=(lds_wptr)shm;
    const float*lp=LFt+((long)(b*NHEAD+h)*SEQ+16*tid);
    const f32x4_t a0=*(const f32x4_t*)lp,a1=*(const f32x4_t*)(lp+4),a2=*(const f32x4_t*)(lp+8),a3=*(const f32x4_t*)(lp+12);
    const float v_[16]={a0[0],a0[1],a0[2],a0[3],a1[0],a1[1],a1[2],a1[3],a2[0],a2[1],a2[2],a2[3],a3[0],a3[1],a3[2],a3[3]};
    float loc=0.f;
    #pragma unroll
    for(int i=0;i<16;++i)loc+=v_[i];
    float inc=loc;
    #pragma unroll
    for(int o_=1;o_<64;o_<<=1){const float t_=__shfl_up(inc,o_); if(lane>=o_)inc+=t_;}
    __attribute__((address_space(3))) float*wt=(__attribute__((address_space(3))) float*)(shmw+LDS_SCAN);
    if(lane==63)wt[wid]=inc;
    asm volatile("s_waitcnt vmcnt(0) lgkmcnt(0)\n\ts_barrier":::"memory");
    float run=inc-loc;
    #pragma unroll
    for(int w_=0;w_<NW;++w_){const float tw=wt[w_]; if(w_<wid)run+=tw;}
    __attribute__((address_space(3))) u32x4*kxw=(__attribute__((address_space(3))) u32x4*)(shmw+LDS_KX+tid*128);
    #pragma unroll
    for(int i=0;i<16;i+=2){ run+=v_[i]; const u32x2_t e0=split3(run*(-1.4426950408889634f)); run+=v_[i+1]; const u32x2_t e1=split3(run*(-1.4426950408889634f)); kxw[i>>1]=(u32x4){e0.x,e0.y,e1.x,e1.y}; }
    asm volatile("s_waitcnt lgkmcnt(0)\n\ts_barrier":::"memory");
  }
  DMA_K(0,0);DMA_V(0,0);DMA_K(1,SLOTB);
  bf16x8 qr[4];
  #pragma unroll
  for(int d0=0;d0<4;++d0)qr[d0]=*reinterpret_cast<const bf16x8*>(&Qw[(long)r32*DM+d0*16+hi*8]);
  float mhat=0.f,l_reg=0.f;f32x16 o[2];o[0]=f32x16{};o[1]=f32x16{};bf16x8 qx=mkqx(0.f,hi);u32x2_t kq0,kq1;
  const __attribute__((address_space(3))) char*kxp=shm3+LDS_KX+r32*8;
  #define LDKQ(t) do{ kq0=*(const __attribute__((address_space(3))) u32x2_t*)(kxp+(t)*512); kq1=*(const __attribute__((address_space(3))) u32x2_t*)(kxp+(t)*512+256); }while(0)
  const int qrel=wid*QBLK+r32;
  #define CMASK(P0,P1,t) do{int jb_=(t)-(NT-4); if(jb_>=0)cmask(P0,P1,jb_,qrel,hi);}while(0)
  bool resc=false;
  #define START(P0,P1) do{ const float rm=rowmax(P0,P1); resc=false; \
    { const float dl=rm; mhat=fadd_s(mhat,dl); \
      _Pragma("unroll") for(int r=0;r<16;++r){P0[r]=fsub_s(P0[r],dl);P1[r]=fsub_s(P1[r],dl);} \
      qx=mkqx(-mhat,hi); } \
    _Pragma("unroll") for(int r=0;r<16;++r)P0[r]=__builtin_amdgcn_exp2f(P0[r]); }while(0)
  #define RESC() do{ if(resc){ asm volatile("s_waitcnt lgkmcnt(0)":::"memory"); \
      _Pragma("unroll") for(int d_=0;d_<2;++d_) _Pragma("unroll") for(int r=0;r<16;++r)o[d_][r]*=wsf[crow(r,hi)]; } }while(0)
  f32x16 pA0,pA1,pB0,pB1;
  int sl_prev=0,sl_cur=0,sl_next=SLOTB;
  #define ROT() do{sl_prev=sl_cur;sl_cur=sl_next;sl_next=(sl_next==(NSLOT-1)*SLOTB)?0:sl_next+SLOTB;}while(0)
  DMA_K(2,2*SLOTB);
  WAIT_BAR(3);
  LDKQ(0); qkt(pA0,pA1,Kbase,qr,kxa(kq0),kxa(kq1),qx,r32,hi);asm volatile("s_nop 15\n\ts_nop 7":"+v"(pA0),"+v"(pA1));CMASK(pA0,pA1,0); LDKQ(1);
  START(pA0,pA1);
  _Pragma("unroll") for(int r=0;r<16;++r)pA1[r]=__builtin_amdgcn_exp2f(pA1[r]);
  WAIT_BAR(0);
  DMA_K(3,0);DMA_V(1,SLOTB);
  ROT();
  kload8(kf,kp0+sl_cur);
  WAIT_BAR(2);
  s16x4 vlo[8],vhi[8]; u32x4 pw0,pw1,pw2,pw3;
  #define PKW(P,B) cvtpk_s(P[B],P[B+1])
  #define PAF(k) __builtin_bit_cast(bf16x8,pw##k)
  #define VFR(i) (bf16x8){vlo[i][0],vlo[i][1],vlo[i][2],vlo[i][3],vhi[i][0],vhi[i][1],vhi[i][2],vhi[i][3]}
  #define PIN(x) asm volatile("":"+v"(x))
  #define MX3(a,b,c) __builtin_fmaxf(__builtin_fmaxf((a),(b)),(c))
  #define GAPA(MF,A0,A1,A2,A3,W0,W1,PW) do{ MF; sacc+=A0; sacc+=A1; sacc+=A2; sacc+=A3; PIN(sacc); W0; W1; PIN(PW); SBAR(); }while(0)
  #define EX(v) __builtin_amdgcn_exp2f(v)
  #define GAPB(MF,X,B) do{ MF; X[B]=EX(X[B]); X[B+1]=EX(X[B+1]); X[B+2]=EX(X[B+2]); X[B+3]=EX(X[B+3]); PIN(X); SBAR(); }while(0)
  #define VRD(i) do{ vlo[i]=vtr(vp_+(((i)>>2)*4096+((i)&3)*1024)); vhi[i]=vtr(vp_+(((i)>>2)*4096+((i)&3)*1024+512)); }while(0)
  #define KRD(G,j) do{ if(G){ kload2(kf,kp0+sl_next,j); SBAR(); } }while(0)
  #define STEP(C0,C1,P0,P1,t,GK,GV,GL) do{ SBAR(); \
    C0=__builtin_amdgcn_mfma_f32_32x32x16_bf16(kxa(kq0),qx,f32x16{},0,0,0); C1=__builtin_amdgcn_mfma_f32_32x32x16_bf16(kxa(kq1),qx,f32x16{},0,0,0); SBAR(); \
    const lds_cptr vp_=vp0+sl_prev; \
    VRD(0); SBAR(); float sacc=(P0[0]+P0[1]); \
    GAPA(C0=__builtin_amdgcn_mfma_f32_32x32x16_bf16(kf[0],qr[0],C0,0,0,0), P0[2],P0[3],P0[4],P0[5],     pw0[0]=PKW(P0,0), pw0[1]=PKW(P0,2), pw0); \
    VRD(4); SBAR(); GAPA(C1=__builtin_amdgcn_mfma_f32_32x32x16_bf16(kf[1],qr[0],C1,0,0,0), P0[6],P0[7],P0[8],P0[9],     pw0[2]=PKW(P0,4), pw0[3]=PKW(P0,6), pw0); \
    VRD(1); SBAR(); GAPA(C0=__builtin_amdgcn_mfma_f32_32x32x16_bf16(kf[2],qr[1],C0,0,0,0),   P0[10],P0[11],P0[12],P0[13], pw1[0]=PKW(P0,8), pw1[1]=PKW(P0,10), pw1); \
    VRD(5); SBAR(); GAPA(C1=__builtin_amdgcn_mfma_f32_32x32x16_bf16(kf[3],qr[1],C1,0,0,0),   P0[14],P0[15],P1[0],P1[1],   pw1[2]=PKW(P0,12),pw1[3]=PKW(P0,14), pw1); \
    VRD(2); SBAR(); GAPA(C0=__builtin_amdgcn_mfma_f32_32x32x16_bf16(kf[4],qr[2],C0,0,0,0),   P1[2],P1[3],P1[4],P1[5],     pw2[0]=PKW(P1,0), pw2[1]=PKW(P1,2), pw2); \
    VRD(6); SBAR(); GAPA(C1=__builtin_amdgcn_mfma_f32_32x32x16_bf16(kf[5],qr[2],C1,0,0,0),   P1[6],P1[7],P1[8],P1[9],     pw2[2]=PKW(P1,4), pw2[3]=PKW(P1,6), pw2); \
    VRD(3); SBAR(); GAPA(C0=__builtin_amdgcn_mfma_f32_32x32x16_bf16(kf[6],qr[3],C0,0,0,0),   P1[10],P1[11],P1[12],P1[13], pw3[0]=PKW(P1,8), pw3[1]=PKW(P1,10), pw3); \
    VRD(7); SBAR(); GAPA(C1=__builtin_amdgcn_mfma_f32_32x32x16_bf16(kf[7],qr[3],C1,0,0,0),   P1[14],P1[15],0.f,0.f,       pw3[2]=PKW(P1,12),pw3[3]=PKW(P1,14), pw3); \
    l_reg+=sacc; if(GL){LDKQ((t)+1);} \
    if(GK){DMA_K((t)+3,sl_cur);} if(GV){DMA_V((t)+1,sl_next);} \
    CMASK(C0,C1,t); \
    { float a=MX3(C0[0],C0[1],C1[0]),b=MX3(C0[2],C0[3],C1[1]); a=MX3(a,C1[2],C1[3]); \
      _Pragma("unroll") for(int r=4;r<16;r+=4){a=MX3(a,C0[r],C0[r+1]);b=MX3(b,C0[r+2],C0[r+3]);a=MX3(a,C1[r],C1[r+1]);b=MX3(b,C1[r+2],C1[r+3]);} \
      float rm=__builtin_fmaxf(a,b); { auto rr=__builtin_amdgcn_permlane32_swap(__float_as_uint(rm),__float_as_uint(rm),false,false); rm=__builtin_fmaxf(__uint_as_float(rr[0]),__uint_as_float(rr[1])); } \
      resc=false; \
      if(__builtin_expect(__any(rm>(float)THRL),0)){ const float dl=__builtin_fmaxf(rm,0.f); mhat+=dl; \
        _Pragma("unroll") for(int r=0;r<16;++r){C0[r]-=dl;C1[r]-=dl;} \
        qx=mkqx(-mhat,hi); \
        const float f=__builtin_amdgcn_exp2f(-dl); l_reg*=f; if(hi==0)wsf[r32]=f; resc=true; } } \
    SBAR(); \
    GAPB(o[0]=__builtin_amdgcn_mfma_f32_32x32x16_bf16(PAF(0),VFR(0),o[0],0,0,0), C0,0); \
    GAPB(o[1]=__builtin_amdgcn_mfma_f32_32x32x16_bf16(PAF(0),VFR(4),o[1],0,0,0), C0,4); \
    KRD(GL,0); GAPB(o[0]=__builtin_amdgcn_mfma_f32_32x32x16_bf16(PAF(1),VFR(1),o[0],0,0,0), C0,8); \
    KRD(GL,1); GAPB(o[1]=__builtin_amdgcn_mfma_f32_32x32x16_bf16(PAF(1),VFR(5),o[1],0,0,0), C0,12); \
    KRD(GL,2); GAPB(o[0]=__builtin_amdgcn_mfma_f32_32x32x16_bf16(PAF(2),VFR(2),o[0],0,0,0), C1,0); \
    KRD(GL,3); GAPB(o[1]=__builtin_amdgcn_mfma_f32_32x32x16_bf16(PAF(2),VFR(6),o[1],0,0,0), C1,4); \
    GAPB(o[0]=__builtin_amdgcn_mfma_f32_32x32x16_bf16(PAF(3),VFR(3),o[0],0,0,0), C1,8); \
    GAPB(o[1]=__builtin_amdgcn_mfma_f32_32x32x16_bf16(PAF(3),VFR(7),o[1],0,0,0), C1,12); \
    }while(0)
  int t=1;
  #undef CMASK
  #define CMASK(P0,P1,t) do{}while(0)
  for(;t+5<NT;t+=2){
    STEP(pB0,pB1,pA0,pA1,t,true,true,true);     WAIT_BAR(2); RESC(); ROT();
    STEP(pA0,pA1,pB0,pB1,t+1,true,true,true);   WAIT_BAR(2); RESC(); ROT();
  }
  #undef CMASK
  #define CMASK(P0,P1,t) do{int jb_=(t)-(NT-4); if(jb_>=0)cmask(P0,P1,jb_,qrel,hi);}while(0)
  #define ENDW(tt) do{ if((tt)+3<NT){WAIT_BAR(2);} else if((tt)+2<NT){WAIT_BAR(1);} else {WAIT_BAR(0);} }while(0)
  for(;t+1<NT;t+=2){
    STEP(pB0,pB1,pA0,pA1,t,(t+3<NT),(t+1<NT),(t+1<NT));       ENDW(t);   RESC(); ROT();
    STEP(pA0,pA1,pB0,pB1,t+1,(t+4<NT),(t+2<NT),(t+2<NT));     ENDW(t+1); RESC(); ROT();
  }
  STEP(pB0,pB1,pA0,pA1,NT-1,false,false,false); RESC();
  { float sacc=pB0[0]+pB0[1]; _Pragma("unroll") for(int r=2;r<16;++r)sacc+=pB0[r]; _Pragma("unroll") for(int r=0;r<16;++r)sacc+=pB1[r]; l_reg+=sacc;
    pw0=(u32x4){PKW(pB0,0),PKW(pB0,2),PKW(pB0,4),PKW(pB0,6)};pw1=(u32x4){PKW(pB0,8),PKW(pB0,10),PKW(pB0,12),PKW(pB0,14)};pw2=(u32x4){PKW(pB1,0),PKW(pB1,2),PKW(pB1,4),PKW(pB1,6)};pw3=(u32x4){PKW(pB1,8),PKW(pB1,10),PKW(pB1,12),PKW(pB1,14)};
    SBAR(); pv(o,vb0+sl_cur,PAF(0),PAF(1),PAF(2),PAF(3)); }
  #undef PKW
  #undef PAF
  #undef VFR
  #undef PIN
  #undef MX3
  #undef GAPA
  #undef GAPB
  #undef EX
  #undef VRD
  #undef KRD
  #undef STEP
  #undef ENDW
  {auto rr=__builtin_amdgcn_permlane32_swap(__float_as_uint(l_reg),__float_as_uint(l_reg),false,false);l_reg=__uint_as_float(rr[0])+__uint_as_float(rr[1]);}
  if(hi==0)wsf[32+r32]=l_reg;asm volatile("s_waitcnt lgkmcnt(0)":::"memory");
  float rli[16];
  #pragma unroll
  for(int r=0;r<16;++r)rli[r]=__builtin_amdgcn_rcpf(wsf[32+crow(r,hi)]);
  bf16*Ow=O+(rowbase+q0+wid*QBLK)*DM+h*D;
  { bf16*stg=(bf16*)(shm+LDS_OST)+wid*2048;
    #pragma unroll
    for(int r=0;r<16;++r){const int orow=crow(r,hi);
      #pragma unroll
      for(int d0=0;d0<2;++d0)stg[orow*64+d0*32+r32]=__float2bfloat16(o[d0][r]*rli[r]);}
    asm volatile("s_waitcnt lgkmcnt(0)":::"memory");
    #pragma unroll
    for(int i=0;i<4;++i){const int row=i*8+(lane>>3),ch=lane&7; const u32x4 v=*(const u32x4*)(stg+row*64+ch*8); ATTN_STORE16(Ow+(long)row*DM+ch*8,v);} }
  asm volatile("s_waitcnt lgkmcnt(0)\n\ts_barrier":::"memory");
  #undef DMA_K
  #undef DMA_V
  #undef CMASK
  #undef START
  #undef RESC
  #undef ROT
}
constexpr int ATTN_LDS_BYTES=LDS_TOTAL;
struct AttnTensors { const bf16* Q; const bf16* K; const bf16* V; bf16* O; const float* LFt; };
struct AttnUnit { int bh; int qb; };
struct StaticOrder {
  int vcu,G;
  __device__ __forceinline__ explicit StaticOrder(int grid,int v):vcu(v),G(grid){}
  __device__ __forceinline__ bool next(int i,AttnUnit&u)const{ const int v=vcu+(i>>3)*G; if(v>=256)return false; const int s=v&3,j=i&7,p=j>>1; u.bh=v>>2; u.qb=8*p+((j&1)?7-s:s); return true; }
  __device__ __forceinline__ void a_ready(const AttnUnit&)const{}
  __device__ __forceinline__ void done(const AttnUnit&)const{}
};
template<class Sched,int THRL=32> __device__ __forceinline__ void attn_phase(char*lds,const AttnTensors&T,const Sched&S){
  AttnUnit u;
  for(int i=0;S.next(i,u);++i){ S.a_ready(u); attn_unit<THRL>(u.bh/NHEAD,u.bh%NHEAD,u.qb,T.Q,T.K,T.V,T.O,T.LFt,lds); S.done(u); }
}
#undef SBAR
#undef WAIT_BAR
}
namespace hg {
#define HLAS __attribute__((address_space(3)))
typedef short bf16x8 __attribute__((ext_vector_type(8)));
typedef float f32x4 __attribute__((ext_vector_type(4)));
typedef unsigned u32x4 __attribute__((ext_vector_type(4)));
typedef unsigned u32x2 __attribute__((ext_vector_type(2)));
typedef unsigned short u16;
constexpr int L_QD = 0, L_KI = 17408, L_IVT = 34816, L_KST = 53248, L_AM = 71680, L_TOT = 80896, L_SSQ = 82944, L_END = 83456;
constexpr int P_QD = 272, P_T = 144;
constexpr int NUNITS = 4096;
__device__ __forceinline__ unsigned f2bf(float f) { unsigned u = __builtin_bit_cast(unsigned, f); return (u + 0x7fffu + ((u >> 16) & 1u)) >> 16; }
__device__ __forceinline__ unsigned pk2(float lo, float hi) { return f2bf(lo) | (f2bf(hi) << 16); }
__device__ __forceinline__ float bf2f(unsigned h) { return __builtin_bit_cast(float, h << 16); }
__device__ __forceinline__ float h2f(u16 h) { return (float)__builtin_bit_cast(_Float16, h); }

struct Tensors { const u16* HLF; u16* HQ; const u16* HI; const u16* HG; u16* US; float* DEC; const float* onorm_g; const float* LB; };

template <bool PA> __device__ __forceinline__ void prep(HLAS unsigned char* L, const Tensors& T, int unit, size_t rowbase, int h, int tid) {
    const int d = tid & 127, qt = tid >> 7;
    const u16* lfp = T.HLF + (rowbase + 16 * qt) * 1024 + 128 * h + d;
    float kk[16], cs[16]; float run = 0.f;
    const float lb = T.LB[128 * h + d];
#pragma unroll
    for (int i = 0; i < 16; ++i) kk[i] = h2f(lfp[(size_t)i * 1024]);
#pragma unroll
    for (int i = 0; i < 16; ++i) { const float sg = __builtin_amdgcn_rcpf(1.0f + __expf(-kk[i])); const float f = lb + (1.0f - lb) * sg;
        kk[i] = (1.0f - lb) * (1.0f - sg); run += __logf(f); cs[i] = run; }
    HLAS float* TOT = (HLAS float*)(L + L_TOT);
    TOT[qt * 128 + d] = run;
    __syncthreads();
    const float t0 = TOT[d], t1 = TOT[128 + d], t2 = TOT[256 + d], t3 = TOT[384 + d];
    const float pre = (qt > 0 ? t0 : 0.f) + (qt > 1 ? t1 : 0.f) + (qt > 2 ? t2 : 0.f);
    const float blast = ((t0 + t1) + t2) + t3;
    if (PA) {
        unsigned w[8];
#pragma unroll
        for (int i = 0; i < 16; i += 2) {
            const float k0 = kk[i], k1 = kk[i + 1];
            const float e0 = __expf(blast - (pre + cs[i])), e1 = __expf(blast - (pre + cs[i + 1]));
            w[i >> 1] = pk2(k0 * e0, k1 * e1);
        }
        HLAS u32x4* dst = (HLAS u32x4*)(L + L_KST + d * P_T + qt * 32);
        dst[0] = (u32x4){w[0], w[1], w[2], w[3]}; dst[1] = (u32x4){w[4], w[5], w[6], w[7]};
        if (qt == 0) T.DEC[(size_t)unit * 128 + d] = __expf(blast);
    } else {
        const u16* qp = T.HQ + (rowbase + 16 * qt) * 1024 + 128 * h + d;
        float q[16];
#pragma unroll
        for (int i = 0; i < 16; ++i) q[i] = bf2f(qp[(size_t)i * 1024]);
#pragma unroll
        for (int i = 0; i < 16; ++i) { const float bb = pre + cs[i]; const float k = kk[i];
            *(HLAS u16*)(L + L_QD + (16 * qt + i) * P_QD + d * 2) = (u16)f2bf(q[i] * __expf(bb));
            *(HLAS u16*)(L + L_KI + (16 * qt + i) * P_QD + d * 2) = (u16)f2bf(k * __expf(-bb)); }
    }
}
__device__ __forceinline__ void stage_ivt(HLAS unsigned char* L, const Tensors& T, size_t rowbase, int h, int tid) {
#pragma unroll
    for (int it = 0; it < 2; ++it) { const int idx = tid + it * 512; const int s = idx >> 4, vg = idx & 15;
        const u32x4 w = *(const u32x4*)(T.HI + (rowbase + s) * 1024 + 128 * h + 8 * vg);
#pragma unroll
        for (int j = 0; j < 8; ++j) { const unsigned dw = w[j >> 1]; *(HLAS u16*)(L + L_IVT + (8 * vg + j) * P_T + s * 2) = (u16)((j & 1) ? (dw >> 16) : (dw & 0xffffu)); } }
}
#define HG_MFMA(X, Y, C) __builtin_amdgcn_mfma_f32_16x16x32_bf16((X), (Y), (C), 0, 0, 0)

__device__ __forceinline__ void phaseA_unit(HLAS unsigned char* L, const Tensors& T, int unit, int tid) {
    const int bh = unit >> 7, n = unit & 127, b = bh >> 3, h = bh & 7; const size_t rowbase = (size_t)b * 8192 + (size_t)n * 64;
    const int lane = tid & 63, w = tid >> 6, lr = lane & 15, kq = lane >> 4;
    prep<true>(L, T, unit, rowbase, h, tid);
    stage_ivt(L, T, rowbase, h, tid);
    __syncthreads();
    f32x4 acc[8];
#pragma unroll
    for (int dt = 0; dt < 8; ++dt) acc[dt] = (f32x4){0.f, 0.f, 0.f, 0.f};
#pragma unroll
    for (int ks = 0; ks < 2; ++ks) {
        const bf16x8 Y = *(const HLAS bf16x8*)(L + L_IVT + (16 * w + lr) * P_T + (32 * ks + 8 * kq) * 2);
#pragma unroll
        for (int dt = 0; dt < 8; ++dt) { const bf16x8 X = *(const HLAS bf16x8*)(L + L_KST + (16 * dt + lr) * P_T + (32 * ks + 8 * kq) * 2); acc[dt] = HG_MFMA(X, Y, acc[dt]); }
    }
    u16* up = T.US + ((size_t)unit * 128 + 16 * w + lr) * 128 + 4 * kq;
#pragma unroll
    for (int dt = 0; dt < 8; ++dt) *(u32x2*)(up + 16 * dt) = (u32x2){pk2(acc[dt][0], acc[dt][1]), pk2(acc[dt][2], acc[dt][3])};
    __syncthreads();
}
__device__ __forceinline__ void phaseB(const Tensors& T, int vb, int tid) {
    const int g = vb * 512 + tid, d4 = g & 31, v = (g >> 5) & 127, bh = g >> 12;
    u32x2* p = (u32x2*)T.US + ((size_t)(bh * 128) * 128 + v) * 32 + d4;
    const f32x4* dp = (const f32x4*)T.DEC + (size_t)(bh * 128) * 32 + d4;
    f32x4 S = (f32x4){0.f, 0.f, 0.f, 0.f};
    for (int n0 = 0; n0 < 128; n0 += 8) {
        u32x2 u[8]; f32x4 dc[8];
#pragma unroll
        for (int j = 0; j < 8; ++j) { u[j] = p[(size_t)(n0 + j) * 4096]; dc[j] = dp[(size_t)(n0 + j) * 32]; }
#pragma unroll
        for (int j = 0; j < 8; ++j) {
            p[(size_t)(n0 + j) * 4096] = (u32x2){pk2(S[0], S[1]), pk2(S[2], S[3])};
            const f32x4 uu = (f32x4){bf2f(u[j].x & 0xffffu), bf2f(u[j].x >> 16), bf2f(u[j].y & 0xffffu), bf2f(u[j].y >> 16)};
            S = dc[j] * S + uu;
        }
    }
}
__device__ __forceinline__ void phaseC_unit(HLAS unsigned char* L, const Tensors& T, int unit, int tid) {
    const int bh = unit >> 7, n = unit & 127, b = bh >> 3, h = bh & 7; const size_t rowbase = (size_t)b * 8192 + (size_t)n * 64;
    const int lane = tid & 63, w = tid >> 6, lr = lane & 15, kq = lane >> 4;
    const int ct = w & 3, wh = w >> 2;
    prep<false>(L, T, unit, rowbase, h, tid);
    stage_ivt(L, T, rowbase, h, tid);
    __syncthreads();
#pragma unroll
    for (int sp = 0; sp < 2; ++sp) { const int st = 2 * wh + sp;
        f32x4 a = (f32x4){0.f, 0.f, 0.f, 0.f};
        if (st <= ct) {
#pragma unroll
            for (int ks = 0; ks < 4; ++ks) { const bf16x8 X = *(const HLAS bf16x8*)(L + L_KI + (16 * st + lr) * P_QD + (32 * ks + 8 * kq) * 2);
                const bf16x8 Y = *(const HLAS bf16x8*)(L + L_QD + (16 * ct + lr) * P_QD + (32 * ks + 8 * kq) * 2); a = HG_MFMA(X, Y, a); }
        }
        const int c = 16 * ct + lr, s0 = 16 * st + 4 * kq;
        float m[4];
#pragma unroll
        for (int e = 0; e < 4; ++e) m[e] = (st <= ct && s0 + e <= c) ? a[e] : 0.f;
        *(HLAS u32x2*)(L + L_AM + c * P_T + s0 * 2) = (u32x2){pk2(m[0], m[1]), pk2(m[2], m[3])};
    }
    __syncthreads();
    f32x4 acc[4];
#pragma unroll
    for (int vi = 0; vi < 4; ++vi) acc[vi] = (f32x4){0.f, 0.f, 0.f, 0.f};
    const u16* sp_ = T.US + ((size_t)unit * 128 + 64 * wh + lr) * 128 + 8 * kq;
#pragma unroll
    for (int vi = 0; vi < 4; ++vi) {
        bf16x8 XS[4];
#pragma unroll
        for (int ks = 0; ks < 4; ++ks) XS[ks] = *(const bf16x8*)(sp_ + (size_t)(16 * vi) * 128 + 32 * ks);
#pragma unroll
        for (int ks = 0; ks < 2; ++ks) { const bf16x8 X = *(const HLAS bf16x8*)(L + L_IVT + (64 * wh + 16 * vi + lr) * P_T + (32 * ks + 8 * kq) * 2);
            const bf16x8 Y = *(const HLAS bf16x8*)(L + L_AM + (16 * ct + lr) * P_T + (32 * ks + 8 * kq) * 2); acc[vi] = HG_MFMA(X, Y, acc[vi]); }
#pragma unroll
        for (int ks = 0; ks < 4; ++ks) { const bf16x8 Y = *(const HLAS bf16x8*)(L + L_QD + (16 * ct + lr) * P_QD + (32 * ks + 8 * kq) * 2); acc[vi] = HG_MFMA(XS[ks], Y, acc[vi]); }
    }
    float ss = 0.f;
#pragma unroll
    for (int vi = 0; vi < 4; ++vi) ss += (acc[vi][0] * acc[vi][0] + acc[vi][1] * acc[vi][1]) + (acc[vi][2] * acc[vi][2] + acc[vi][3] * acc[vi][3]);
    ss += __shfl_xor(ss, 16); ss += __shfl_xor(ss, 32);
    HLAS float* SSQ = (HLAS float*)(L + L_SSQ);
    if (kq == 0) SSQ[wh * 64 + 16 * ct + lr] = ss;
    __syncthreads();
    const float tot = SSQ[16 * ct + lr] + SSQ[64 + 16 * ct + lr];
    const float rstd = 1.0f / sqrtf(tot * (1.0f / 128.0f) + 1e-6f);
    const size_t orow = (rowbase + 16 * ct + lr) * 1024 + 128 * h;
#pragma unroll
    for (int vi = 0; vi < 4; ++vi) { const int v0 = 64 * wh + 16 * vi + 4 * kq;
        const f32x4 gn = *(const f32x4*)(T.onorm_g + 128 * h + v0);
        const u32x2 gg = *(const u32x2*)(T.HG + orow + v0);
        const float o0 = acc[vi][0] * rstd * gn[0] * bf2f(gg.x & 0xffffu), o1 = acc[vi][1] * rstd * gn[1] * bf2f(gg.x >> 16);
        const float o2 = acc[vi][2] * rstd * gn[2] * bf2f(gg.y & 0xffffu), o3 = acc[vi][3] * rstd * gn[3] * bf2f(gg.y >> 16);
        *(u32x2*)(T.HQ + orow + v0) = (u32x2){pk2(o0, o1), pk2(o2, o3)}; }
    __syncthreads();
}
}

namespace cg = cooperative_groups;
constexpr int NWAVES = 8;
constexpr int BATCH = 4, T = 8192, D = 1024, H = 16, HD = 64, FF = 2816, FF2 = 5632;
constexpr int M = BATCH * T;
constexpr float RMS_EPS = 1e-6f;
constexpr size_t MiB = 1u << 20;
constexpr size_t WS_WQKV = 1 * MiB;
constexpr size_t WS_WO = WS_WQKV + (size_t)3328 * 1024 * 2;
constexpr size_t WS_WUP0 = WS_WO + (size_t)1024 * 1024 * 2;
constexpr size_t WS_WDN0 = WS_WUP0 + (size_t)5632 * 1024 * 2;
constexpr size_t WS_WHIN = WS_WDN0 + (size_t)1024 * 2816 * 2;
constexpr size_t WS_WHO = WS_WHIN + (size_t)4096 * 1024 * 2;
constexpr size_t WS_WUP1 = WS_WHO + (size_t)1024 * 1024 * 2;
constexpr size_t WS_WDN1 = WS_WUP1 + (size_t)5632 * 1024 * 2;
constexpr size_t WS_WEND = WS_WDN1 + (size_t)1024 * 2816 * 2;
constexpr size_t WS_BIG = 56 * MiB;
constexpr size_t WS_Q = WS_BIG, WS_K = WS_BIG + 64 * MiB, WS_V = WS_BIG + 128 * MiB;
constexpr size_t WS_U = WS_BIG;
constexpr size_t WS_HLF = WS_BIG, WS_HQ = WS_BIG + 64 * MiB, WS_HI = WS_BIG + 128 * MiB, WS_HG = WS_BIG + 192 * MiB, WS_US = WS_BIG + 256 * MiB;
constexpr size_t WS_XN = 408 * MiB;
constexpr size_t WS_UH = 472 * MiB;
constexpr size_t WS_LFT = 484 * MiB;
constexpr size_t WS_DEC = 486 * MiB;
constexpr size_t WS_LB = 488 * MiB;
constexpr size_t WS_CWB = 489 * MiB;
constexpr size_t WS_END = 490 * MiB;
static_assert(WS_WEND <= WS_BIG && WS_U + (size_t)M * FF2 * 2 <= WS_XN && WS_US + 128 * MiB <= WS_UH && WS_UH + (size_t)128 * 4 * FF2 * 4 <= WS_LFT, "d_ws map");
static_assert(WS_HQ == WS_HLF + 64 * MiB && WS_HI == WS_HLF + 128 * MiB && WS_HG == WS_HLF + 192 * MiB, "EpiHgrn buffer order");
constexpr int LDS_BYTES = 155648;
static_assert(pg8::STAGE_BYTES + 16384 <= LDS_BYTES, "conv halo exchange");
static_assert(attn_body::ATTN_LDS_BYTES <= LDS_BYTES && hg::L_END <= LDS_BYTES && pg8::STAGE_BYTES <= LDS_BYTES, "LDS map");

#define LAS __attribute__((address_space(3)))
typedef unsigned short bf16;
typedef unsigned v4u __attribute__((ext_vector_type(4)));
typedef float f32x4 __attribute__((ext_vector_type(4)));
__device__ __forceinline__ unsigned f2bf(float f) { unsigned u = __builtin_bit_cast(unsigned, f); return (u + 0x7fffu + ((u >> 16) & 1u)) >> 16; }
__device__ __forceinline__ unsigned pk2(float lo, float hi) { return f2bf(lo) | (f2bf(hi) << 16); }
__device__ __forceinline__ float wave_sum(float v) {
#pragma unroll
    for (int o = 1; o < 64; o <<= 1) v += __shfl_xor(v, o);
    return v;
}
__device__ __forceinline__ void transpose_item(const float* W, int ldw, int K, int nblk, bf16* WT, LAS float* scr, int item, int lane, bool perm_up = false) {
    const int kb = item / nblk, nb = item % nblk, k0 = 64 * kb, n0 = 32 * nb;
    const int n0p = !perm_up ? n0 : (n0 < FF ? 256 * (n0 / 128) + (n0 % 128) : 256 * ((n0 - FF) / 128) + 128 + ((n0 - FF) % 128));
#pragma unroll 8
    for (int i = 0; i < 32; ++i) { const int kk = 2 * i + (lane >> 5); scr[kk * 33 + (lane & 31)] = W[(size_t)(k0 + kk) * ldw + n0 + (lane & 31)]; }
    asm volatile("s_waitcnt lgkmcnt(0)" ::: "memory");
    const int c = lane & 7;
#pragma unroll
    for (int j = 0; j < 4; ++j) { const int n = (lane >> 3) + 8 * j; const LAS float* s = scr + (8 * c) * 33 + n;
        v4u o; o.x = pk2(s[0 * 33], s[1 * 33]); o.y = pk2(s[2 * 33], s[3 * 33]); o.z = pk2(s[4 * 33], s[5 * 33]); o.w = pk2(s[6 * 33], s[7 * 33]);
        *(v4u*)(WT + (size_t)(n0p + n) * K + k0 + 8 * c) = o; }
    asm volatile("s_waitcnt lgkmcnt(0)" ::: "memory");
}
__device__ __forceinline__ void norm_rows_bf16(const float* src, const float* g, bf16* dst, int gw, int NGW, int lane) {
    f32x4 gg[4];
#pragma unroll
    for (int j = 0; j < 4; ++j) gg[j] = ((const f32x4*)g)[lane + 64 * j];
    for (int m = gw; m < M; m += NGW) {
        const f32x4* xr = (const f32x4*)(src + (size_t)m * D) + lane; f32x4 v[4]; float s = 0.f;
#pragma unroll
        for (int j = 0; j < 4; ++j) { v[j] = xr[64 * j]; s += (v[j].x * v[j].x + v[j].y * v[j].y) + (v[j].z * v[j].z + v[j].w * v[j].w); }
        const float rstd = 1.0f / sqrtf(wave_sum(s) * (1.0f / D) + RMS_EPS);
        unsigned long long* o8 = (unsigned long long*)(dst + (size_t)m * D) + lane;
#pragma unroll
        for (int j = 0; j < 4; ++j) o8[64 * j] = (unsigned long long)pk2(v[j].x * rstd * gg[j].x, v[j].y * rstd * gg[j].y) | ((unsigned long long)pk2(v[j].z * rstd * gg[j].z, v[j].w * rstd * gg[j].w) << 32);
    }
}
__device__ __forceinline__ void norm_rows_f32(float* buf, const float* g, int gw, int NGW, int lane) {
    f32x4 gg[4];
#pragma unroll
    for (int j = 0; j < 4; ++j) gg[j] = ((const f32x4*)g)[lane + 64 * j];
    for (int m = gw; m < M; m += NGW) {
        f32x4* xr = (f32x4*)(buf + (size_t)m * D) + lane; f32x4 v[4]; float s = 0.f;
#pragma unroll
        for (int j = 0; j < 4; ++j) { v[j] = xr[64 * j]; s += (v[j].x * v[j].x + v[j].y * v[j].y) + (v[j].z * v[j].z + v[j].w * v[j].w); }
        const float rstd = 1.0f / sqrtf(wave_sum(s) * (1.0f / D) + RMS_EPS);
#pragma unroll
        for (int j = 0; j < 4; ++j) xr[64 * j] = v[j] * rstd * gg[j];
    }
}
__device__ __forceinline__ float bfs(const bf16* p) { return __builtin_bit_cast(float, (unsigned)(*p) << 16); }
__device__ __forceinline__ void conv_fixup(bf16* ACT, const float* UHf, const bf16* CWB, int pm, int tid) {
    const float* cur = UHf + ((size_t)pm * 2 + 0) * 2 * FF2;
    const float* prv = UHf + ((size_t)(pm - 1) * 2 + 1) * 2 * FF2;
    const bool seq0 = (pm & 31) == 0;
    for (int task = tid; task < 704; task += 512) {
        const int r = task / 352, g = task % 352, pn = g >> 4, cl0 = (g & 15) * 8, gc0 = pn * 128 + cl0, pc = pn * 256 + cl0;
        float a[8];
#pragma unroll
        for (int e = 0; e < 8; ++e) { float y[2];
#pragma unroll
            for (int bj = 0; bj < 2; ++bj) { const int pcb = pc + 128 * bj + e, col = bj * FF + gc0 + e;
                const float u0 = cur[pcb], u1 = cur[FF2 + pcb], p254 = seq0 ? 0.f : prv[pcb], p255 = seq0 ? 0.f : prv[FF2 + pcb];
                const float x = r == 0 ? u0 : u1, x1 = r == 0 ? p255 : u0, x2 = r == 0 ? p254 : p255;
                y[bj] = bfs(CWB + 3 * FF2 + col) + bfs(CWB + col) * x2 + bfs(CWB + FF2 + col) * x1 + bfs(CWB + 2 * FF2 + col) * x; }
            a[e] = y[0] * __builtin_amdgcn_rcpf(1.0f + __expf(-y[0])) * y[1]; }
        v4u o; o.x = pk2(a[0], a[1]); o.y = pk2(a[2], a[3]); o.z = pk2(a[4], a[5]); o.w = pk2(a[6], a[7]);
        *(v4u*)(ACT + (size_t)(pm * 256 + r) * FF + gc0) = o;
    }
}
template <class T> __device__ __forceinline__ T* opq(T* p) { asm volatile("" : "+s"(p)); return p; }
struct Args { const float* in[16]; float* out; unsigned char* ws; };
__global__ void __launch_bounds__(NWAVES * 64, 2) fwd_kernel(Args args) {
    extern __shared__ __attribute__((aligned(16))) unsigned char lds[];
    cg::grid_group grid = cg::this_grid();
    LAS unsigned char* L = (LAS unsigned char*)lds;
#define FRESH_TID() ({ int t_ = threadIdx.x; asm volatile("" : "+v"(t_)); t_; })
    const int tid = threadIdx.x, lane = tid & 63, wave = __builtin_amdgcn_readfirstlane(tid >> 6);
    const int G = gridDim.x, bx = blockIdx.x; const int vcu = (G % 8 == 0) ? (bx % 8) * (G / 8) + bx / 8 : bx;
    const int gw = vcu * NWAVES + wave, NGW = G * NWAVES;
    unsigned char* ws = args.ws;
    const float* x = args.in[0]; float* out = args.out;
    bf16* Wqkv_t = (bf16*)(ws + WS_WQKV); bf16* Wo_t = (bf16*)(ws + WS_WO); bf16* Whin_t = (bf16*)(ws + WS_WHIN); bf16* Who_t = (bf16*)(ws + WS_WHO);
    bf16* XN = (bf16*)(ws + WS_XN); bf16* QO = (bf16*)(ws + WS_Q); bf16* U = (bf16*)(ws + WS_U); float* UHf = (float*)(ws + WS_UH);
    float* LFt = (float*)(ws + WS_LFT);

    {
        LAS float* scr = (LAS float*)(L + wave * 16384);
        constexpr int I_QKV = 16 * 96, I_O = 16 * 32, I_UP = 16 * 176, I_DN = 44 * 32, I_HIN = 16 * 128;
        constexpr int NITEMS = I_QKV + 2 * I_O + 2 * I_UP + 2 * I_DN + I_HIN;
        for (int it = gw; it < NITEMS; it += NGW) {
            int r = it;
            if (r < I_QKV) { transpose_item(args.in[2], 3088, 1024, 96, Wqkv_t, scr, r, lane); continue; } r -= I_QKV;
            if (r < I_O) { transpose_item(args.in[4], 1024, 1024, 32, Wo_t, scr, r, lane); continue; } r -= I_O;
            if (r < I_O) { transpose_item(args.in[9], 1024, 1024, 32, Who_t, scr, r, lane); continue; } r -= I_O;
            if (r < I_HIN) { transpose_item(args.in[6], 4096, 1024, 128, Whin_t, scr, r, lane); continue; } r -= I_HIN;
            if (r < I_UP) { transpose_item(args.in[11], FF2, 1024, 176, (bf16*)(ws + WS_WUP0), scr, r, lane, true); continue; } r -= I_UP;
            if (r < I_UP) { transpose_item(args.in[11] + (size_t)1024 * FF2, FF2, 1024, 176, (bf16*)(ws + WS_WUP1), scr, r, lane, true); continue; } r -= I_UP;
            if (r < I_DN) { transpose_item(args.in[14], 1024, FF, 32, (bf16*)(ws + WS_WDN0), scr, r, lane); continue; } r -= I_DN;
            transpose_item(args.in[14] + (size_t)FF * 1024, 1024, FF, 32, (bf16*)(ws + WS_WDN1), scr, r, lane);
        }
        for (int idx = bx * 512 + tid; idx < 256 * 128; idx += G * 512) { const int row = 3072 + (idx >> 7), kc = (idx & 127) * 8;
            float v[8];
#pragma unroll
            for (int j = 0; j < 8; ++j) v[j] = row < 3088 ? args.in[2][(size_t)(kc + j) * 3088 + row] : 0.f;
            v4u o; o.x = pk2(v[0], v[1]); o.y = pk2(v[2], v[3]); o.z = pk2(v[4], v[5]); o.w = pk2(v[6], v[7]);
            *(v4u*)(Wqkv_t + (size_t)row * 1024 + kc) = o; }
        for (int i = bx * 512 + tid; i < 2 * 4 * FF2; i += G * 512) { const int l = i / (4 * FF2), k = (i / FF2) & 3, c = i % FF2;
            ((bf16*)(ws + WS_CWB))[i] = (bf16)f2bf(k < 3 ? args.in[12][(size_t)(l * 3 + k) * FF2 + c] : args.in[13][(size_t)l * FF2 + c]); }
        if (bx == 0) for (int c = tid; c < 1024; c += 512) ((float*)(ws + WS_LB))[c] = 1.0f / (1.0f + expf(args.in[7][c] - args.in[7][1024 + c]));
        norm_rows_bf16(x, args.in[1], XN, gw, NGW, lane);
    }
    grid.sync();

    { pg8::Gemm g{opq(XN), opq(Wqkv_t), M, 3328, 1024, 1024}; pg8::StaticOrder S; S.init(M, 3328, G, bx);
      pg8::EpiQKV E{QO, LFt, args.in[3], attn_body::C2};
#ifndef NO_EPIQKV_1
      pg8::gemm_phase<pg8::EpiQKV, pg8::StaticOrder, true, true>(L, g, S, E);
#endif
    }
    grid.sync();
    { const attn_body::AttnTensors AT{(const attn_body::bf16*)QO, (const attn_body::bf16*)(ws + WS_K), (const attn_body::bf16*)(ws + WS_V), (attn_body::bf16*)QO, LFt};
      const attn_body::StaticOrder S(G, vcu);
#ifndef NO_ATTN
      attn_body::attn_phase<attn_body::StaticOrder>((char*)lds, AT, S);
#endif
    }
    grid.sync();
#define LAYER_TAIL(LY, AOP, BOP, BASE) do { \
    { pg8::Gemm g{opq(AOP), opq(BOP), M, 1024, 1024, 1024}; pg8::StaticOrder S; S.init(M, 1024, G, bx); \
      pg8::EpiRes E{BASE, out}; \
      pg8::gemm_phase<pg8::EpiRes, pg8::StaticOrder, true, true>(L, g, S, E); } \
    grid.sync(); \
    norm_rows_bf16(out, args.in[10] + (LY) * D, XN, gw, NGW, FRESH_TID() & 63); \
    grid.sync(); \
    { pg8::Gemm g{opq(XN), opq((bf16*)(ws + ((LY) == 0 ? WS_WUP0 : WS_WUP1))), M, FF2, 1024, 1024}; pg8::StaticOrder S; S.init(M, FF2, G, bx); \
      pg8::EpiUpConv E{U, UHf, (const bf16*)(ws + WS_CWB) + (LY) * 4 * FF2, (LAS pg8::f32x4*)(L + pg8::STAGE_BYTES)}; \
      pg8::gemm_phase<pg8::EpiUpConv, pg8::StaticOrder, true, true>(L, g, S, E); } \
    grid.sync(); \
    { pg8::Gemm g{opq(U), opq((bf16*)(ws + ((LY) == 0 ? WS_WDN0 : WS_WDN1))), M, 1024, FF, FF}; pg8::StaticOrder S; S.init(M, 1024, G, bx); \
      { pg8::Unit fu; for (int i = 0; S.next(i, fu); ++i) conv_fixup(U, UHf, (const bf16*)(ws + WS_CWB) + (LY) * 4 * FF2, fu.pm, FRESH_TID()); \
        asm volatile("s_waitcnt vmcnt(0)" ::: "memory"); __syncthreads(); } \
      pg8::EpiRes E{out, out}; \
      pg8::gemm_phase<pg8::EpiRes, pg8::StaticOrder, true, true>(L, g, S, E); } \
    grid.sync(); } while (0)
    LAYER_TAIL(0, QO, Wo_t, x);
    norm_rows_bf16(out, args.in[5], XN, gw, NGW, FRESH_TID() & 63);
    grid.sync();
    { pg8::Gemm g{opq(XN), opq(Whin_t), M, 4096, 1024, 1024}; pg8::StaticOrder S; S.init(M, 4096, G, bx);
      pg8::EpiHgrn E{(bf16*)(ws + WS_HLF)};
      pg8::gemm_phase<pg8::EpiHgrn, pg8::StaticOrder, true, true>(L, g, S, E); }
    grid.sync();
    { const hg::Tensors HT{(const hg::u16*)(ws + WS_HLF), (hg::u16*)(ws + WS_HQ), (const hg::u16*)(ws + WS_HI), (const hg::u16*)(ws + WS_HG), (hg::u16*)(ws + WS_US), (float*)(ws + WS_DEC), args.in[8], (const float*)(ws + WS_LB)};
      const int upw = hg::NUNITS / G;
#ifndef NO_HGA
      for (int i = 0; i < upw; ++i) hg::phaseA_unit(L, HT, vcu * upw + i, FRESH_TID());
#endif
      grid.sync();
#ifndef NO_HGB
      for (int vb = bx; vb < 256; vb += G) hg::phaseB(HT, vb, FRESH_TID());
#endif
      grid.sync();
#ifndef NO_HGC
      for (int i = 0; i < upw; ++i) hg::phaseC_unit(L, HT, vcu * upw + i, FRESH_TID());
#endif
      grid.sync(); }
    LAYER_TAIL(1, (bf16*)(ws + WS_HQ), Who_t, (const float*)out);
    norm_rows_f32(out, args.in[15], gw, NGW, FRESH_TID() & 63);
}

extern "C" void kernel_launch(void* const* d_in, const int* in_sizes, int n_in, void* d_out, int out_size, void* d_ws, size_t ws_size, hipStream_t stream) {
    static int grid = 0;
    if (grid == 0) {
        if (n_in != 16 || in_sizes[0] != M * D || out_size != M * D || ws_size < WS_END) { fprintf(stderr, "kernel_launch: unexpected shapes / workspace (n_in %d, in0 %d, out %d, ws %zu); nothing launched\n", n_in, n_in > 0 ? in_sizes[0] : -1, out_size, ws_size); grid = -1; return; }
        int dev = 0, cus = 0, per_cu = 0;
        if (hipGetDevice(&dev) != hipSuccess || hipDeviceGetAttribute(&cus, hipDeviceAttributeMultiprocessorCount, dev) != hipSuccess) { grid = -1; return; }
        if (hipFuncSetAttribute((const void*)fwd_kernel, hipFuncAttributeMaxDynamicSharedMemorySize, LDS_BYTES) != hipSuccess) { fprintf(stderr, "kernel_launch: hipFuncSetAttribute failed\n"); grid = -1; return; }
        if (hipOccupancyMaxActiveBlocksPerMultiprocessor(&per_cu, (const void*)fwd_kernel, NWAVES * 64, LDS_BYTES) != hipSuccess || per_cu < 1) { fprintf(stderr, "kernel_launch: occupancy query gives %d\n", per_cu); per_cu = 1; }
        (void)hipGetLastError();
        grid = cus;
        if (grid != 256) { fprintf(stderr, "kernel_launch: built for 256 CUs, device has %d; nothing launched\n", cus); grid = -1; return; }
    }
    if (grid < 0) return;
    Args a{};
    for (int i = 0; i < 16; ++i) a.in[i] = (const float*)d_in[i];
    a.out = (float*)d_out; a.ws = (unsigned char*)d_ws;
    void* kargs[] = {&a};
    const hipError_t e = hipLaunchCooperativeKernel((const void*)fwd_kernel, dim3(grid), dim3(NWAVES * 64), kargs, LDS_BYTES, stream);
    if (e != hipSuccess) fprintf(stderr, "kernel_launch: cooperative launch failed: %s\n", hipGetErrorString(e));
}
```

```cpp
#include <hip/hip_runtime.h>
#include <hip/hip_cooperative_groups.h>
#include <hip/hip_bf16.h>
#include <cstdio>
#include <cstdint>
#include <cmath>
namespace pg8 {
#define PG8_LAS __attribute__((address_space(3)))
typedef unsigned short bf16_t;
typedef short bf16x8 __attribute__((ext_vector_type(8)));
typedef float f32x4 __attribute__((ext_vector_type(4)));
typedef unsigned u32x4 __attribute__((ext_vector_type(4)));
constexpr int BM = 256, BK = 64, HALF = 128, HTB = HALF * BK * 2  , STAGE_BYTES = 8 * HTB, NXCD = 8, WGM = 8;

__host__ __device__ __forceinline__ int lds_byte(int r, int c) { const int st = (r >> 4) * 2 + (c >> 5), rr = r & 15, cc = c & 31, ob = rr * 64 + cc * 2; return st * 1024 + (ob ^ (((ob >> 9) & 1) << 5)); }
__host__ __device__ __forceinline__ void stage_rc(int b, int& R, int& C) { const int st = b / 1024, sb = b % 1024, swz = sb ^ (((sb >> 9) & 1) << 5); R = (st >> 1) * 16 + swz / 64; C = (st & 1) * 32 + (swz % 64) / 2; }
__host__ __device__ __forceinline__ int perm32(int rho) { const int n = rho >> 4, i = rho & 15; return 8 * (i >> 2) + 4 * n + (i & 3); }

struct Unit { int pm, pn, ui, npn, npm; };
struct Gemm { const bf16_t* A; const bf16_t* Bt; int M, N, K, lda; };

struct StaticOrder {
    int nM, nN, nwg, G, c;
    __host__ __device__ __forceinline__ void init(int M, int N, int G_, int c_) { nM = M / BM; nN = N / BM; nwg = nM * nN; G = G_; c = c_; }
    __host__ __device__ __forceinline__ bool next(int i, Unit& u) const {
        const long L = (long)i * G + c; if (L >= nwg) return false;
        int wgid = (int)L; { const int q = nwg / NXCD, r = nwg % NXCD, xcd = wgid % NXCD, off = wgid / NXCD; wgid = (xcd < r ? xcd * (q + 1) : r * (q + 1) + (xcd - r) * q) + off; }
        const int nig = WGM * nN, gid = wgid / nig, fm = gid * WGM, gsz = (nM - fm) < WGM ? (nM - fm) : WGM;
        u.pm = fm + ((wgid % nig) % gsz); u.pn = (wgid % nig) / gsz; return true;
    }
    __device__ __forceinline__ void a_ready(const Unit&) const {}
    __device__ __forceinline__ void done(const Unit&) const {}
};
constexpr int MTOK = 32768, DMODEL = 1024, SEQL = 8192, FFN2 = 5632, FFN1 = 2816;
__device__ __forceinline__ unsigned cvt_pk_bf16(float lo, float hi) { unsigned r; asm volatile("v_cvt_pk_bf16_f32 %0, %1, %2" : "=v"(r) : "v"(lo), "v"(hi)); return r; }
typedef _Float16 h16x2 __attribute__((ext_vector_type(2)));
typedef unsigned u32x2_e __attribute__((ext_vector_type(2)));
__device__ __forceinline__ unsigned cvt_pk_f16(float lo, float hi) { h16x2 v = {(_Float16)lo, (_Float16)hi}; return __builtin_bit_cast(unsigned, v); }
__device__ __forceinline__ float bf_lo(unsigned w) { return __builtin_bit_cast(float, w << 16); }
__device__ __forceinline__ float bf_hi(unsigned w) { return __builtin_bit_cast(float, w & 0xffff0000u); }
__device__ __forceinline__ float silu_f(float x) { return x * __builtin_amdgcn_rcpf(1.0f + __expf(-x)); }

struct EpiQKV {
    static constexpr bool PERM = true, AFTER_DRAIN = false;
    bf16_t* QKV; float* LFt; const float* b_f; float scale0;
    __device__ __forceinline__ void operator()(const f32x4 (&acc)[2][2][4][2], const Unit& u, int wr, int wc, int fr, int fq) const {
        const int row0 = u.pm * BM + wr * 64 + fr;
        if (u.pn < 12) {
            const int part = u.pn >> 2; bf16_t* base = QKV + (size_t)part * ((size_t)MTOK * DMODEL);
            const float sc = part == 0 ? scale0 : 1.f; const int col0 = (u.pn & 3) * BM + wc * 32 + 8 * fq;
#pragma unroll
            for (int ai = 0; ai < 2; ++ai)
#pragma unroll
                for (int m = 0; m < 4; ++m) { bf16_t* rowp = base + (size_t)(row0 + ai * HALF + m * 16) * DMODEL + col0;
#pragma unroll
                    for (int bj = 0; bj < 2; ++bj) { const f32x4 v0 = acc[ai][bj][m][0] * sc, v1 = acc[ai][bj][m][1] * sc;
                        u32x4 w; w.x = cvt_pk_bf16(v0[0], v0[1]); w.y = cvt_pk_bf16(v0[2], v0[3]); w.z = cvt_pk_bf16(v1[0], v1[1]); w.w = cvt_pk_bf16(v1[2], v1[3]);
                        *(u32x4*)(rowp + bj * HALF) = w; } }
        } else if (wc == 0 && fq < 2) {
            float bias[8];
#pragma unroll
            for (int e = 0; e < 8; ++e) bias[e] = b_f[8 * fq + e];
#pragma unroll
            for (int ai = 0; ai < 2; ++ai)
#pragma unroll
                for (int m = 0; m < 4; ++m) { const int row = row0 + ai * HALF + m * 16; const int b = row >> 13, t = row & (SEQL - 1);
#pragma unroll
                    for (int n = 0; n < 2; ++n)
#pragma unroll
                        for (int e = 0; e < 4; ++e) { const int hh = 8 * fq + 4 * n + e; const float z = acc[ai][0][m][n][e] + bias[4 * n + e];
                            const float lf = fminf(z, 0.f) - log1pf(__expf(-fabsf(z)));
                            LFt[(size_t)(b * 16 + hh) * SEQL + t] = lf; } }
        }
    }
};
struct EpiRes {
    static constexpr bool PERM = true, AFTER_DRAIN = false;
    const float* basef; const bf16_t* baseb; bf16_t* out; float* SSQ; PG8_LAS float* XS;
    __device__ __forceinline__ void operator()(const f32x4 (&acc)[2][2][4][2], const Unit& u, int wr, int wc, int fr, int fq) const {
        const int col0 = u.pn * BM + wc * 32 + 8 * fq;
#pragma unroll
        for (int ai = 0; ai < 2; ++ai)
#pragma unroll
            for (int m = 0; m < 4; ++m) { const size_t off = (size_t)(u.pm * BM + ai * HALF + wr * 64 + m * 16 + fr) * DMODEL + col0;
                f32x4 b[2][2];
                if (basef) {
#pragma unroll
                    for (int bj = 0; bj < 2; ++bj) { b[bj][0] = *(const f32x4*)(basef + off + bj * HALF); b[bj][1] = *(const f32x4*)(basef + off + bj * HALF + 4); }
                } else {
#pragma unroll
                    for (int bj = 0; bj < 2; ++bj) { const u32x4 w = *(const u32x4*)(baseb + off + bj * HALF);
                        b[bj][0] = (f32x4){bf_lo(w.x), bf_hi(w.x), bf_lo(w.y), bf_hi(w.y)}; b[bj][1] = (f32x4){bf_lo(w.z), bf_hi(w.z), bf_lo(w.w), bf_hi(w.w)}; }
                }
                float ss = 0.f;
#pragma unroll
                for (int bj = 0; bj < 2; ++bj) { const f32x4 v0 = b[bj][0] + acc[ai][bj][m][0], v1 = b[bj][1] + acc[ai][bj][m][1];
                    ss += ((v0[0] * v0[0] + v0[1] * v0[1]) + (v0[2] * v0[2] + v0[3] * v0[3])) + ((v1[0] * v1[0] + v1[1] * v1[1]) + (v1[2] * v1[2] + v1[3] * v1[3]));
                    u32x4 w; w.x = cvt_pk_bf16(v0[0], v0[1]); w.y = cvt_pk_bf16(v0[2], v0[3]); w.z = cvt_pk_bf16(v1[0], v1[1]); w.w = cvt_pk_bf16(v1[2], v1[3]);
                    *(u32x4*)(out + off + bj * HALF) = w; }
                ss += __shfl_xor(ss, 16); ss += __shfl_xor(ss, 32);
                if (fq == 0) XS[(ai * HALF + wr * 64 + m * 16 + fr) * 4 + wc] = ss;
                if (m & 1) asm volatile("" ::: "memory"); }
        asm volatile("s_waitcnt lgkmcnt(0)" ::: "memory"); __builtin_amdgcn_s_barrier(); asm volatile("" ::: "memory");
        { const int t = (wr * 4 + wc) * 64 + fq * 16 + fr;
          if (t < 256) { const f32x4 p = *(const PG8_LAS f32x4*)(XS + t * 4); SSQ[(size_t)(u.pm * BM + t) * 4 + u.pn] = (p[0] + p[1]) + (p[2] + p[3]); } }
    }
};
__device__ __forceinline__ f32x4 rstd_issue(const float* SSQ, int pm, int t) { return t < 256 ? *(const f32x4*)(SSQ + (size_t)(pm * BM + t) * 4) : (f32x4){0.f, 0.f, 0.f, 0.f}; }
__device__ __forceinline__ void rstd_commit(PG8_LAS float* RSL, int buf, int t, const f32x4& p) { if (t < 256) RSL[buf * 256 + t] = 1.0f / sqrtf(((p[0] + p[1]) + (p[2] + p[3])) * (1.0f / DMODEL) + 1e-6f); }
__device__ __forceinline__ void scale_rows(const f32x4 (&acc)[2][2][4][2], const PG8_LAS float* RSL, int buf, int wr, int fr) {
    f32x4 (&a_)[2][2][4][2] = const_cast<f32x4 (&)[2][2][4][2]>(acc);
#pragma unroll
    for (int ai = 0; ai < 2; ++ai)
#pragma unroll
        for (int m = 0; m < 4; ++m) { const float r = RSL[buf * 256 + ai * HALF + wr * 64 + m * 16 + fr];
#pragma unroll
            for (int bj = 0; bj < 2; ++bj)
#pragma unroll
                for (int n = 0; n < 2; ++n) { typedef float f32x2_ __attribute__((ext_vector_type(2))); const f32x2_ rr = {r, r}; const f32x4 x = a_[ai][bj][m][n];
                    const f32x2_ lo = (f32x2_){x[0], x[1]} * rr, hi = (f32x2_){x[2], x[3]} * rr; a_[ai][bj][m][n] = (f32x4){lo[0], lo[1], hi[0], hi[1]}; } }
}
template <int CTRL> __device__ __forceinline__ float dppz(float x) { return __builtin_bit_cast(float, __builtin_amdgcn_update_dpp(0, __builtin_bit_cast(int, x), CTRL, 0xf, 0xf, true)); }
struct EpiUpConv {
    static constexpr bool PERM = true, AFTER_DRAIN = false;
    bf16_t* ACT; float* UHf; const bf16_t* CWB; PG8_LAS f32x4* XH; PG8_LAS unsigned char* TAPL; const float* SSQ; PG8_LAS float* RSL;
    __device__ __forceinline__ void operator()(const f32x4 (&acc)[2][2][4][2], const Unit& u, int wr, int wc, int fr, int fq) const {
        typedef unsigned u32x2 __attribute__((ext_vector_type(2)));
        const int cl0 = wc * 32 + 8 * fq, gc0 = u.pn * HALF + cl0;
        const int tid0_ = (wr * 4 + wc) * 64 + fq * 16 + fr; const f32x4 nstat = rstd_issue(SSQ, u.npm, tid0_);
        scale_rows(acc, RSL, u.ui & 1, wr, fr);
        if (fr >= 14) {
#pragma unroll
            for (int ai = 0; ai < 2; ++ai) { PG8_LAS f32x4* dst = XH + ((((ai * 2 + wr) * 4 + wc) * 4 + fq) * 2 + (fr - 14)) * 4;
                dst[0] = acc[ai][0][3][0]; dst[1] = acc[ai][0][3][1]; dst[2] = acc[ai][1][3][0]; dst[3] = acc[ai][1][3][1]; }
        }
        if (wr == 0 && fr < 2) { float* p = UHf + (((size_t)u.pm * 2 + 0) * 2 + fr) * FFN2 + u.pn * BM + cl0;
            *(f32x4*)p = acc[0][0][0][0]; *(f32x4*)(p + 4) = acc[0][0][0][1]; *(f32x4*)(p + HALF) = acc[0][1][0][0]; *(f32x4*)(p + HALF + 4) = acc[0][1][0][1]; }
        if (wr == 1 && fr >= 14) { float* p = UHf + (((size_t)u.pm * 2 + 1) * 2 + (fr - 14)) * FFN2 + u.pn * BM + cl0;
            *(f32x4*)p = acc[1][0][3][0]; *(f32x4*)(p + 4) = acc[1][0][3][1]; *(f32x4*)(p + HALF) = acc[1][1][3][0]; *(f32x4*)(p + HALF + 4) = acc[1][1][3][1]; }
        const int tid_ = (wr * 4 + wc) * 64 + fq * 16 + fr; u32x2 ntap = (u32x2){0u, 0u};
        if (tid_ < 256) { const int k = tid_ >> 6, ch = (tid_ & 63) * 4; ntap = *(const u32x2*)(CWB + k * FFN2 + (ch < HALF ? u.npn * HALF + ch : FFN1 + u.npn * HALF + (ch - HALF))); }
        asm volatile("s_waitcnt lgkmcnt(0)" ::: "memory"); __builtin_amdgcn_s_barrier(); asm volatile("" ::: "memory");
        const PG8_LAS unsigned char* tapb = TAPL + (u.ui & 1) * 2048 + cl0 * 2;
#define PG8_FD(Y, X, T, CTRL) asm("v_fmac_f32_dpp %0, %1, %2 " CTRL " row_mask:0xf bank_mask:0xf bound_ctrl:1" : "+v"(Y) : "v"(X), "v"(T))
#pragma unroll
        for (int n = 0; n < 2; ++n) {
            float tp[2][4][4];
#pragma unroll
            for (int bj = 0; bj < 2; ++bj)
#pragma unroll
                for (int k = 0; k < 4; ++k) { const u32x2 w = *(const PG8_LAS u32x2*)(tapb + k * 512 + bj * 256 + 8 * n);
                    tp[bj][k][0] = bf_lo(w.x); tp[bj][k][1] = bf_hi(w.x); tp[bj][k][2] = bf_lo(w.y); tp[bj][k][3] = bf_hi(w.y); }
#pragma unroll
            for (int ai = 0; ai < 2; ++ai) {
                const bool has = (wr == 1) || (ai == 1);
                const int pai = (wr == 1) ? ai : 0, pwr = (wr == 1) ? 0 : 1;
                const PG8_LAS f32x4* hsrc = XH + (((pai * 2 + pwr) * 4 + wc) * 4 + fq) * 8;
#pragma unroll
                for (int m = 0; m < 4; ++m) {
                    float yg[4];
#pragma unroll
                    for (int bj = 0; bj < 2; ++bj) {
                        const f32x4 x = acc[ai][bj][m][n];
                        f32x4 h14 = (f32x4){0.f, 0.f, 0.f, 0.f}, h15 = h14;
                        if (m == 0 && has) { h14 = hsrc[bj * 2 + n]; h15 = hsrc[4 + bj * 2 + n]; }
                        const f32x4 xp = acc[ai][bj][m > 0 ? m - 1 : 0][n];
#pragma unroll
                        for (int e = 0; e < 4; ++e) { const float t0 = tp[bj][0][e], t1 = tp[bj][1][e];
                            float y = tp[bj][2][e] * x[e] + tp[bj][3][e];
                            if (m == 0) { y += t1 * (fr == 0 ? h15[e] : 0.f); y += t0 * (fr == 0 ? h14[e] : (fr == 1 ? h15[e] : 0.f)); }
                            else { PG8_FD(y, xp[e], t1, "row_shl:15"); PG8_FD(y, xp[e], t0, "row_shl:14"); }
                            PG8_FD(y, x[e], t1, "row_shr:1"); PG8_FD(y, x[e], t0, "row_shr:2");
                            if (bj == 0) yg[e] = y; else yg[e] = silu_f(yg[e]) * y; }
                    }
                    *(u32x2*)(ACT + (size_t)(u.pm * BM + ai * HALF + wr * 64 + m * 16 + fr) * FFN1 + gc0 + 4 * n) = (u32x2){cvt_pk_bf16(yg[0], yg[1]), cvt_pk_bf16(yg[2], yg[3])};
                }
            }
        }
#undef PG8_FD
        if (tid_ < 256) *(PG8_LAS u32x2*)(TAPL + ((u.ui + 1) & 1) * 2048 + (tid_ >> 6) * 512 + (tid_ & 63) * 8) = ntap;
        rstd_commit(RSL, (u.ui + 1) & 1, tid0_, nstat);
    }
};
struct EpiDummy {
    static constexpr bool PERM = true, AFTER_DRAIN = false;
    bf16_t* O;
    __device__ __forceinline__ void operator()(const f32x4 (&acc)[2][2][4][2], const Unit& u, int wr, int wc, int fr, int fq) const {
        const int row0 = u.pm * BM + wr * 64 + fr, col0 = u.pn * HALF + wc * 32 + 8 * fq;
#pragma unroll
        for (int ai = 0; ai < 2; ++ai)
#pragma unroll
            for (int m = 0; m < 4; ++m) { const f32x4 v0 = acc[ai][0][m][0] + acc[ai][1][m][0], v1 = acc[ai][0][m][1] + acc[ai][1][m][1];
                u32x4 w; w.x = cvt_pk_bf16(v0[0], v0[1]); w.y = cvt_pk_bf16(v0[2], v0[3]); w.z = cvt_pk_bf16(v1[0], v1[1]); w.w = cvt_pk_bf16(v1[2], v1[3]);
                *(u32x4*)(O + (size_t)(row0 + ai * HALF + m * 16) * FFN1 + col0) = w; }
    }
};
struct EpiHgrn {
    static constexpr bool PERM = true, AFTER_DRAIN = false;
    bf16_t* HB; const float* SSQ; PG8_LAS float* RSL;
    __device__ __forceinline__ void operator()(const f32x4 (&acc)[2][2][4][2], const Unit& u, int wr, int wc, int fr, int fq) const {
        const int part = u.pn >> 2; const int row0 = u.pm * BM + wr * 64 + fr, col0 = (u.pn & 3) * BM + wc * 32 + 8 * fq;
        bf16_t* dst = HB + (size_t)(part == 0 ? 1 : (part == 1 ? 0 : part)) * ((size_t)MTOK * DMODEL); const bool act = (part == 0) || (part == 3);
        const int tid0_ = (wr * 4 + wc) * 64 + fq * 16 + fr; const f32x4 nstat = rstd_issue(SSQ, u.npm, tid0_);
        scale_rows(acc, RSL, u.ui & 1, wr, fr);
#pragma unroll
        for (int ai = 0; ai < 2; ++ai)
#pragma unroll
            for (int m = 0; m < 4; ++m) { bf16_t* rowp = dst + (size_t)(row0 + ai * HALF + m * 16) * DMODEL + col0;
#pragma unroll
                for (int bj = 0; bj < 2; ++bj) { float r[8];
#pragma unroll
                    for (int e = 0; e < 8; ++e) { const float z = acc[ai][bj][m][e >> 2][e & 3]; r[e] = act ? silu_f(z) : z; }
                    u32x4 w;
                    if (part == 1) { w.x = cvt_pk_f16(r[0], r[1]); w.y = cvt_pk_f16(r[2], r[3]); w.z = cvt_pk_f16(r[4], r[5]); w.w = cvt_pk_f16(r[6], r[7]); }
                    else { w.x = cvt_pk_bf16(r[0], r[1]); w.y = cvt_pk_bf16(r[2], r[3]); w.z = cvt_pk_bf16(r[4], r[5]); w.w = cvt_pk_bf16(r[6], r[7]); }
                    *(u32x4*)(rowp + bj * HALF) = w; } }
        rstd_commit(RSL, (u.ui + 1) & 1, tid0_, nstat);
    }
};

template <class Epi, class Sched, bool ALIGN_EPI = false, bool SP2 = false>
__device__ __forceinline__ void gemm_phase(PG8_LAS unsigned char* lds, const Gemm g, const Sched& S, const Epi& E) {
    int tid = threadIdx.x; asm volatile("" : "+v"(tid)); const int wid = __builtin_amdgcn_readfirstlane(tid >> 6), lane = tid & 63, wr = wid >> 2, wc = wid & 3, fr = lane & 15, fq = lane >> 4;
    const int K = g.K, nt = K / BK;
    unsigned voffA[2], voffB[2];
#pragma unroll
    for (int i = 0; i < 2; ++i) { int R, C; stage_rc(tid * 16 + i * 8192, R, C); const int Rb = Epi::PERM ? ((R & ~31) + perm32(R & 31)) : R;
        voffA[i] = (unsigned)(R * g.lda + C) * 2u; voffB[i] = (unsigned)(Rb * K + C) * 2u; }
    const size_t kstep = (size_t)(BK * 2);
    const size_t hstepA = (size_t)HALF * g.lda * 2, hstepB = (size_t)HALF * K * 2;
    const size_t tstepA = 2 * hstepA, tstepB = 2 * hstepB;
    const unsigned ldsw = (unsigned)wid * 1024u;
    const int aoff = lds_byte(wr * 64 + fr, fq * 8), boff = lds_byte(wc * 32 + fr, fq * 8);
#define PG8_SA(b, h) (((b) * 2 + (h)) * HTB)
#define PG8_SB(b, h) ((4 + (b) * 2 + (h)) * HTB)
#define PG8_STAGE(bufoff, gbase, voff) do { _Pragma("unroll") for (int _i = 0; _i < 2; ++_i) \
        __builtin_amdgcn_global_load_lds((const unsigned*)((const char*)(gbase) + (voff)[_i]), (PG8_LAS unsigned*)(lds + (bufoff) + ldsw + _i * 8192), 16, 0, 0); } while (0)
#define PG8_LDA(dst, b, h) do { _Pragma("unroll") for (int m = 0; m < 4; ++m) _Pragma("unroll") for (int k = 0; k < 2; ++k) dst[m][k] = *(const PG8_LAS bf16x8*)(lds + PG8_SA(b, h) + aoff + m * 2048 + k * 1024); } while (0)
#define PG8_LDB(dst, b, h) do { _Pragma("unroll") for (int n = 0; n < 2; ++n) _Pragma("unroll") for (int k = 0; k < 2; ++k) dst[n][k] = *(const PG8_LAS bf16x8*)(lds + PG8_SB(b, h) + boff + n * 2048 + k * 1024); } while (0)
#define PG8_MMA(ai, bj, At, Bt) do { __builtin_amdgcn_s_setprio(1); _Pragma("unroll") for (int m = 0; m < 4; ++m) _Pragma("unroll") for (int n = 0; n < 2; ++n) _Pragma("unroll") for (int k = 0; k < 2; ++k) \
        acc[ai][bj][m][n] = __builtin_amdgcn_mfma_f32_16x16x32_bf16(Bt[n][k], At[m][k], acc[ai][bj][m][n], 0, 0, 0); __builtin_amdgcn_s_setprio(0); } while (0)
#define PG8_WAIT_V(n) asm volatile("s_waitcnt vmcnt(" #n ")" ::: "memory")
#define PG8_WAIT_L(n) asm volatile("s_waitcnt lgkmcnt(" #n ")" ::: "memory")
#define PG8_BAR __builtin_amdgcn_s_barrier()
#define PG8_SCHED __builtin_amdgcn_sched_barrier(0)
    Unit cur, nxt; int ui = 0;
    if (!S.next(0, cur)) return;
    f32x4 acc[2][2][4][2];
#pragma unroll
    for (int a = 0; a < 2; ++a)
#pragma unroll
        for (int b = 0; b < 2; ++b)
#pragma unroll
            for (int m = 0; m < 4; ++m)
#pragma unroll
                for (int n = 0; n < 2; ++n) acc[a][b][m][n] = (f32x4){0.f, 0.f, 0.f, 0.f};
    bf16x8 At[4][2], B0[2][2], B1[2][2];
    const char* cA = (const char*)g.A + (size_t)cur.pm * tstepA; const char* cB = (const char*)g.Bt + (size_t)cur.pn * tstepB;
    S.a_ready(cur);
    if constexpr (SP2) {
        PG8_STAGE(PG8_SB(0, 0), cB, voffB); PG8_STAGE(PG8_SB(0, 1), cB + hstepB, voffB); PG8_STAGE(PG8_SA(0, 0), cA, voffA); PG8_STAGE(PG8_SA(0, 1), cA + hstepA, voffA);
        if (wr == 1) PG8_BAR;
        PG8_WAIT_V(2); PG8_BAR;
        PG8_STAGE(PG8_SB(1, 0), cB + kstep, voffB); PG8_STAGE(PG8_SA(1, 0), cA + kstep, voffA); PG8_STAGE(PG8_SB(1, 1), cB + hstepB + kstep, voffB);
        PG8_WAIT_V(6); PG8_BAR;
    } else {
        PG8_STAGE(PG8_SB(0, 0), cB, voffB); PG8_STAGE(PG8_SA(0, 0), cA, voffA); PG8_STAGE(PG8_SB(0, 1), cB + hstepB, voffB); PG8_STAGE(PG8_SA(0, 1), cA + hstepA, voffA);
        if (wr == 1) PG8_BAR;
        PG8_WAIT_V(4); PG8_BAR;
        PG8_STAGE(PG8_SB(1, 0), cB + kstep, voffB); PG8_STAGE(PG8_SA(1, 0), cA + kstep, voffA); PG8_STAGE(PG8_SB(1, 1), cB + hstepB + kstep, voffB);
        PG8_WAIT_V(6); PG8_BAR;
    }
    for (;;) {
        const bool has_next = S.next(ui + 1, nxt);
        const char* nA = has_next ? (const char*)g.A + (size_t)nxt.pm * tstepA : cA; const char* nB = has_next ? (const char*)g.Bt + (size_t)nxt.pn * tstepB : cB;
        for (int t = 0; t < nt; t += 2) {
            const bool last = (t == nt - 2);
            const char* a1 = cA + (size_t)(t + 1) * kstep;
            const char* a2 = last ? nA : cA + (size_t)(t + 2) * kstep; const char* b2 = last ? nB : cB + (size_t)(t + 2) * kstep;
            const char* a3 = a2 + kstep; const char* b3 = b2 + kstep;
            if (last && has_next) S.a_ready(nxt);
            if constexpr (SP2) {
            PG8_LDB(B0, 0, 0); PG8_LDB(B1, 0, 1); PG8_SCHED; PG8_LDA(At, 0, 0); PG8_STAGE(PG8_SA(1, 1), a1 + hstepA, voffA);
            PG8_WAIT_V(8); PG8_WAIT_L(0); PG8_BAR; PG8_MMA(0, 0, At, B0); PG8_MMA(0, 1, At, B1); PG8_BAR; PG8_SCHED;
            PG8_LDA(At, 0, 1); PG8_STAGE(PG8_SB(0, 0), b2, voffB); PG8_STAGE(PG8_SB(0, 1), b2 + hstepB, voffB); PG8_STAGE(PG8_SA(0, 0), a2, voffA);
            PG8_WAIT_V(8); PG8_WAIT_L(0); PG8_BAR; PG8_MMA(1, 0, At, B0); PG8_MMA(1, 1, At, B1); PG8_BAR; PG8_SCHED;
            PG8_LDB(B0, 1, 0); PG8_LDB(B1, 1, 1); PG8_SCHED; PG8_LDA(At, 1, 0); PG8_STAGE(PG8_SA(0, 1), a2 + hstepA, voffA);
            PG8_WAIT_V(8); PG8_WAIT_L(0); PG8_BAR; PG8_MMA(0, 0, At, B0); PG8_MMA(0, 1, At, B1); PG8_BAR; PG8_SCHED;
            PG8_LDA(At, 1, 1); PG8_STAGE(PG8_SB(1, 0), b3, voffB); PG8_STAGE(PG8_SB(1, 1), b3 + hstepB, voffB); PG8_STAGE(PG8_SA(1, 0), a3, voffA);
            PG8_WAIT_V(8); PG8_WAIT_L(0); PG8_BAR; PG8_MMA(1, 0, At, B0); PG8_MMA(1, 1, At, B1); PG8_BAR; PG8_SCHED;
            } else {
            PG8_LDB(B0, 0, 0); PG8_SCHED; PG8_LDA(At, 0, 0); PG8_STAGE(PG8_SA(1, 1), a1 + hstepA, voffA);
            PG8_WAIT_L(8); PG8_BAR; PG8_WAIT_L(0); PG8_MMA(0, 0, At, B0); PG8_BAR; PG8_SCHED;
            PG8_LDB(B1, 0, 1); PG8_STAGE(PG8_SB(0, 0), b2, voffB);
            PG8_BAR; PG8_WAIT_L(0); PG8_MMA(0, 1, At, B1); PG8_BAR;
            PG8_LDA(At, 0, 1); PG8_STAGE(PG8_SA(0, 0), a2, voffA);
            PG8_BAR; PG8_WAIT_L(0); PG8_MMA(1, 0, At, B0); PG8_BAR; PG8_SCHED;
            PG8_STAGE(PG8_SB(0, 1), b2 + hstepB, voffB);
            PG8_WAIT_V(6); PG8_BAR; PG8_MMA(1, 1, At, B1); PG8_BAR;
            PG8_LDB(B0, 1, 0); PG8_SCHED; PG8_LDA(At, 1, 0); PG8_STAGE(PG8_SA(0, 1), a2 + hstepA, voffA);
            PG8_WAIT_L(8); PG8_BAR; PG8_WAIT_L(0); PG8_MMA(0, 0, At, B0); PG8_BAR; PG8_SCHED;
            PG8_LDB(B1, 1, 1); PG8_STAGE(PG8_SB(1, 0), b3, voffB);
            PG8_BAR; PG8_WAIT_L(0); PG8_MMA(0, 1, At, B1); PG8_BAR;
            PG8_LDA(At, 1, 1); PG8_STAGE(PG8_SA(1, 0), a3, voffA);
            PG8_BAR; PG8_WAIT_L(0); PG8_MMA(1, 0, At, B0); PG8_BAR; PG8_SCHED;
            PG8_STAGE(PG8_SB(1, 1), b3 + hstepB, voffB);
            PG8_WAIT_V(6); PG8_BAR; PG8_MMA(1, 1, At, B1); PG8_BAR;
            }
        }
        if constexpr (ALIGN_EPI) { if (wr == 0) PG8_BAR; }
        if constexpr (!Epi::AFTER_DRAIN) { cur.ui = ui; cur.npn = has_next ? nxt.pn : cur.pn; cur.npm = has_next ? nxt.pm : cur.pm; int l2_ = lane; asm volatile("" : "+v"(l2_)); E(acc, cur, wr, wc, l2_ & 15, l2_ >> 4); S.done(cur); }
        if (!has_next) break;
#pragma unroll
        for (int a = 0; a < 2; ++a)
#pragma unroll
            for (int b = 0; b < 2; ++b)
#pragma unroll
                for (int m = 0; m < 4; ++m)
#pragma unroll
                    for (int n = 0; n < 2; ++n) acc[a][b][m][n] = (f32x4){0.f, 0.f, 0.f, 0.f};
        cur = nxt; cA = nA; cB = nB; ++ui;
        if constexpr (ALIGN_EPI) { if (wr == 1) PG8_BAR; }
    }
    PG8_WAIT_V(0);
    if constexpr (!ALIGN_EPI) { if (wr == 0) PG8_BAR; }
    PG8_BAR;
    if constexpr (Epi::AFTER_DRAIN) { E.fused(acc, cur, wr, wc, fr, fq, lds, wid, lane); S.done(cur); }
#undef PG8_SA
#undef PG8_SB
#undef PG8_STAGE
#undef PG8_LDA
#undef PG8_LDB
#undef PG8_MMA
#undef PG8_WAIT_V
#undef PG8_WAIT_L
#undef PG8_BAR
#undef PG8_SCHED
}
}
namespace attn_body {
using bf16=__hip_bfloat16;
using bf16x8=__attribute__((ext_vector_type(8)))short;
using s16x4=__attribute__((ext_vector_type(4)))short;
using f32x16=__attribute__((ext_vector_type(16)))float;
using u32x4=__attribute__((ext_vector_type(4)))unsigned;
constexpr int BATCH=4,NHEAD=16,SEQ=8192,D=64,DM=NHEAD*D;
constexpr int NW=8,QBLK=32,QB=QBLK*NW,KVBLK=64,NQB=SEQ/QB;
constexpr int ATTN_PITCH=DM, ATTN_UNIT_ROWS=QB;
__device__ __forceinline__ int crow(int r,int hi){return (r&3)+8*(r>>2)+4*hi;}
#define SBAR() __builtin_amdgcn_sched_barrier(0)
__device__ __forceinline__ void cmask(f32x16&p0,f32x16&p1,int jb,int qrel,int hi){
  const float NEG=-INFINITY; int kb=64*jb+4*hi;
  #pragma unroll
  for(int r=0;r<16;++r){int kv=kb+(r&3)+8*(r>>2); if(kv>qrel)p0[r]=NEG; if(kv+32>qrel)p1[r]=NEG;}
}

constexpr int NSLOT=3, SLOTB=8192;
constexpr int LDS_K=0, LDS_V=NSLOT*SLOTB, LDS_WS=2*NSLOT*SLOTB, LDS_OST=LDS_WS+NW*64*4, LDS_BYTES=LDS_OST+NW*4096; constexpr int LDS_KX=LDS_BYTES, LDS_SCAN=LDS_KX+SEQ*8, LDS_TOTAL=LDS_SCAN+64;
constexpr float C2=0.125f*1.4426950408889634f;
__device__ __forceinline__ void glds16(const void*gsrc,unsigned lds_dst){unsigned keep;
  asm volatile("s_mov_b32 %0, m0\n\ts_mov_b32 m0, %2\n\ts_nop 0\n\tglobal_load_lds_dwordx4 %1, off\n\ts_mov_b32 m0, %0":"=&s"(keep):"v"(gsrc),"s"(lds_dst):"memory");}
__device__ __forceinline__ float max3f(float a,float b,float c){float r;asm("v_max3_f32 %0, %1, %2, %3":"=v"(r):"v"(a),"v"(b),"v"(c));return r;}
__device__ __forceinline__ float max2f(float a,float b){float r;asm("v_max_f32_e32 %0, %1, %2":"=v"(r):"v"(a),"v"(b));return r;}
__device__ __forceinline__ float fadd_s(float a,float b){float r;asm("v_add_f32_e32 %0, %1, %2":"=v"(r):"v"(a),"v"(b));return r;}
__device__ __forceinline__ float fsub_s(float a,float b){float r;asm("v_sub_f32_e32 %0, %1, %2":"=v"(r):"v"(a),"v"(b));return r;}
typedef float f32x2_t __attribute__((ext_vector_type(2))); typedef __bf16 bf16x2_t __attribute__((ext_vector_type(2)));
__device__ __forceinline__ unsigned cvtpk_s(float lo,float hi){f32x2_t v={lo,hi};bf16x2_t b=__builtin_convertvector(v,bf16x2_t);return __builtin_bit_cast(unsigned,b);}
#define WAIT_BAR(N) asm volatile("s_waitcnt vmcnt(" #N ") lgkmcnt(0)\n\ts_barrier":::"memory")

typedef unsigned u32x2_t __attribute__((ext_vector_type(2))); typedef float f32x4_t __attribute__((ext_vector_type(4)));
__device__ __forceinline__ u32x2_t split3(float x){ const unsigned p1=cvtpk_s(x,0.f)&0xffffu; const float r1=x-__uint_as_float(p1<<16); const unsigned p2=cvtpk_s(r1,0.f)&0xffffu; const float r2=r1-__uint_as_float(p2<<16);
  const unsigned p3=cvtpk_s(r2,0.f)&0xffffu; return (u32x2_t){p1|(p2<<16),p3|(0x3F80u<<16)}; }
__device__ __forceinline__ bf16x8 mkqx(float x,int hi){ const unsigned p1=cvtpk_s(x,0.f)&0xffffu; const float r1=x-__uint_as_float(p1<<16); const unsigned p2=cvtpk_s(r1,0.f)&0xffffu; const float r2=r1-__uint_as_float(p2<<16);
  const unsigned p3=cvtpk_s(r2,0.f)&0xffffu; u32x4 w=(u32x4){0x3F803F80u,0x3F80u|(p1<<16),p2|(p3<<16),0u}; if(hi)w=(u32x4){0u,0u,0u,0u}; return __builtin_bit_cast(bf16x8,w); }
__device__ __forceinline__ bf16x8 kxa(u32x2_t q){ return __builtin_bit_cast(bf16x8,(u32x4){q.x,q.y,0x3F803F80u,0u}); }
__device__ __forceinline__ void qkt(f32x16&p0,f32x16&p1,const char*Kslot,const bf16x8*qr,bf16x8 kx0,bf16x8 kx1,bf16x8 qx,int r32,int hi){
  const char*kb=Kslot+hi*1024+r32*16;
  p0=__builtin_amdgcn_mfma_f32_32x32x16_bf16(kx0,qx,f32x16{},0,0,0);p1=__builtin_amdgcn_mfma_f32_32x32x16_bf16(kx1,qx,f32x16{},0,0,0);
  #pragma unroll
  for(int d0=0;d0<4;++d0){
    const bf16x8 b0=*reinterpret_cast<const bf16x8*>(kb+d0*2048);
    const bf16x8 b1=*reinterpret_cast<const bf16x8*>(kb+d0*2048+512);
    p0=__builtin_amdgcn_mfma_f32_32x32x16_bf16(b0,qr[d0],p0,0,0,0);p1=__builtin_amdgcn_mfma_f32_32x32x16_bf16(b1,qr[d0],p1,0,0,0);}
}
typedef __attribute__((address_space(3))) const char* lds_cptr;
typedef short v4i16_t __attribute__((ext_vector_type(4)));
__device__ __forceinline__ void kload8(bf16x8*kf,lds_cptr kp){
  kf[0]=*(const __attribute__((address_space(3))) bf16x8*)(kp);      kf[1]=*(const __attribute__((address_space(3))) bf16x8*)(kp+512);
  kf[2]=*(const __attribute__((address_space(3))) bf16x8*)(kp+2048); kf[3]=*(const __attribute__((address_space(3))) bf16x8*)(kp+2560);
  kf[4]=*(const __attribute__((address_space(3))) bf16x8*)(kp+4096); kf[5]=*(const __attribute__((address_space(3))) bf16x8*)(kp+4608);
  kf[6]=*(const __attribute__((address_space(3))) bf16x8*)(kp+6144); kf[7]=*(const __attribute__((address_space(3))) bf16x8*)(kp+6656);
}
__device__ __forceinline__ void kload2(bf16x8*kf,lds_cptr kp,int j){ kf[2*j]=*(const __attribute__((address_space(3))) bf16x8*)(kp+j*2048); kf[2*j+1]=*(const __attribute__((address_space(3))) bf16x8*)(kp+j*2048+512); }
__device__ __forceinline__ s16x4 vtr(lds_cptr p){ return __builtin_bit_cast(s16x4,__builtin_amdgcn_ds_read_tr16_b64_v4i16((__attribute__((address_space(3))) v4i16_t*)p)); }
__device__ __forceinline__ float rowmax(const f32x16&p0,const f32x16&p1){
  float a=max3f(p0[0],p0[1],p1[0]),b=max3f(p0[2],p0[3],p1[1]);a=max3f(a,p1[2],p1[3]);
  #pragma unroll
  for(int r=4;r<16;r+=4){a=max3f(a,p0[r],p0[r+1]);b=max3f(b,p0[r+2],p0[r+3]);a=max3f(a,p1[r],p1[r+1]);b=max3f(b,p1[r+2],p1[r+3]);}
  const float m=max2f(a,b);
  auto rr=__builtin_amdgcn_permlane32_swap(__float_as_uint(m),__float_as_uint(m),false,false);
  return max2f(__uint_as_float(rr[0]),__uint_as_float(rr[1]));
}
__device__ __forceinline__ void pv(f32x16*o,int vb,bf16x8 pa0,bf16x8 pa1,bf16x8 pa2,bf16x8 pa3){
  #pragma unroll
  for(int d0=0;d0<2;++d0){s16x4 lo[4],hi[4];
    #pragma unroll
    for(int ks=0;ks<4;++ks){
      asm volatile("ds_read_b64_tr_b16 %0,%1 offset:%c2":"=&v"(lo[ks]):"v"(vb),"i"(d0*4096+ks*1024):"memory");
      asm volatile("ds_read_b64_tr_b16 %0,%1 offset:%c2":"=&v"(hi[ks]):"v"(vb),"i"(d0*4096+ks*1024+512):"memory");}
    asm volatile("s_waitcnt lgkmcnt(0)":::"memory");SBAR();
    #define PK(k) (bf16x8){lo[k][0],lo[k][1],lo[k][2],lo[k][3],hi[k][0],hi[k][1],hi[k][2],hi[k][3]}
    o[d0]=__builtin_amdgcn_mfma_f32_32x32x16_bf16(pa0,PK(0),o[d0],0,0,0);
    o[d0]=__builtin_amdgcn_mfma_f32_32x32x16_bf16(pa1,PK(1),o[d0],0,0,0);
    o[d0]=__builtin_amdgcn_mfma_f32_32x32x16_bf16(pa2,PK(2),o[d0],0,0,0);
    o[d0]=__builtin_amdgcn_mfma_f32_32x32x16_bf16(pa3,PK(3),o[d0],0,0,0);
    #undef PK
  }
}

#ifndef ATTN_STORE16
#define ATTN_STORE16(p,v) (*(u32x4*)(p)=(v))
#endif
template<int THRL> __device__ __forceinline__ void attn_unit(int b,int h,int qb,const bf16*Q,const bf16*__restrict__ K,const bf16*__restrict__ V,bf16*O,const float*__restrict__ LFt,bool newbh,char*shm){
  int tid=threadIdx.x; asm volatile("":"+v"(tid)); const int lane=tid&63,r32=lane&31,hi=lane>>5; const int wid=__builtin_amdgcn_readfirstlane(tid>>6);
  const long rowbase=(long)b*SEQ; const int q0=qb*QB;
  const bf16*Qw=Q+(rowbase+q0+wid*QBLK)*DM+h*D;
  const bf16*Kh=K+rowbase*DM+h*D,*Vh=V+rowbase*DM+h*D;
  const unsigned lds0=(unsigned)(uintptr_t)shm;
  float*wsf=(float*)(shm+LDS_WS)+wid*64;
  const bf16*ksrc=Kh+(long)lane*DM+wid*8;
  const bf16*vsrc=Vh+(long)(16*(wid&3)+(lane>>2))*DM+(wid>>2)*32+(lane&3)*8;
  const unsigned kdst=lds0+LDS_K+wid*1024, vdst=lds0+LDS_V+wid*1024;
  #define DMA_K(t,slot) glds16(ksrc+(long)(t)*KVBLK*DM,(unsigned)__builtin_amdgcn_readfirstlane(kdst+(slot)))
  #define DMA_V(t,slot) glds16(vsrc+(long)(t)*KVBLK*DM,(unsigned)__builtin_amdgcn_readfirstlane(vdst+(slot)))
  const int vb0=(int)(lds0+LDS_V)+((lane>>4)&1)*32+(lane&3)*8+(4*hi+((lane&15)>>2))*64;
  const char*Kbase=shm+LDS_K; bf16x8 kf[8];
  const lds_cptr shm3=(lds_cptr)shm; const lds_cptr kp0=shm3+LDS_K+hi*1024+r32*16; const lds_cptr vp0=shm3+LDS_V+((lane>>4)&1)*32+(lane&3)*8+(4*hi+((lane&15)>>2))*64;
  const int NT=(q0+QB)/KVBLK;
  if(newbh){
    typedef __attribute__((address_space(3))) char* lds_wptr; const lds_wptr shmw=(lds_wptr)shm;
    const float*lp=LFt+((long)(b*NHEAD+h)*SEQ+16*tid);
    const f32x4_t a0=*(const f32x4_t*)lp,a1=*(const f32x4_t*)(lp+4),a2=*(const f32x4_t*)(lp+8),a3=*(const f32x4_t*)(lp+12);
    const float v_[16]={a0[0],a0[1],a0[2],a0[3],a1[0],a1[1],a1[2],a1[3],a2[0],a2[1],a2[2],a2[3],a3[0],a3[1],a3[2],a3[3]};
    float loc=0.f;
    #pragma unroll
    for(int i=0;i<16;++i)loc+=v_[i];
    float inc=loc;
    #pragma unroll
    for(int o_=1;o_<64;o_<<=1){const float t_=__shfl_up(inc,o_); if(lane>=o_)inc+=t_;}
    __attribute__((address_space(3))) float*wt=(__attribute__((address_space(3))) float*)(shmw+LDS_SCAN);
    if(lane==63)wt[wid]=inc;
    asm volatile("s_waitcnt vmcnt(0) lgkmcnt(0)\n\ts_barrier":::"memory");
    float run=inc-loc;
    #pragma unroll
    for(int w_=0;w_<NW;++w_){const float tw=wt[w_]; if(w_<wid)run+=tw;}
    __attribute__((address_space(3))) u32x4*kxw=(__attribute__((address_space(3))) u32x4*)(shmw+LDS_KX+tid*128);
    #pragma unroll
    for(int i=0;i<16;i+=2){ run+=v_[i]; const u32x2_t e0=split3(run*(-1.4426950408889634f)); run+=v_[i+1]; const u32x2_t e1=split3(run*(-1.4426950408889634f)); kxw[i>>1]=(u32x4){e0.x,e0.y,e1.x,e1.y}; }
    asm volatile("s_waitcnt lgkmcnt(0)\n\ts_barrier":::"memory");
  }
  DMA_K(0,0);DMA_V(0,0);DMA_K(1,SLOTB);
  bf16x8 qr[4];
  #pragma unroll
  for(int d0=0;d0<4;++d0)qr[d0]=*reinterpret_cast<const bf16x8*>(&Qw[(long)r32*DM+d0*16+hi*8]);
  float mhat=0.f,l_reg=0.f;f32x16 o[2];o[0]=f32x16{};o[1]=f32x16{};bf16x8 qx=mkqx(0.f,hi);u32x2_t kq0,kq1;
  const __attribute__((address_space(3))) char*kxp=shm3+LDS_KX+r32*8;
  #define LDKQ(t) do{ kq0=*(const __attribute__((address_space(3))) u32x2_t*)(kxp+(t)*512); kq1=*(const __attribute__((address_space(3))) u32x2_t*)(kxp+(t)*512+256); }while(0)
  const int qrel=wid*QBLK+r32;
  #define CMASK(P0,P1,t) do{int jb_=(t)-(NT-4); if(jb_>=0)cmask(P0,P1,jb_,qrel,hi);}while(0)
  bool resc=false;
  #define START(P0,P1) do{ const float rm=rowmax(P0,P1); resc=false; \
    { const float dl=rm; mhat=fadd_s(mhat,dl); \
      _Pragma("unroll") for(int r=0;r<16;++r){P0[r]=fsub_s(P0[r],dl);P1[r]=fsub_s(P1[r],dl);} \
      qx=mkqx(-mhat,hi); } \
    _Pragma("unroll") for(int r=0;r<16;++r)P0[r]=__builtin_amdgcn_exp2f(P0[r]); }while(0)
  #define RESC() do{ if(resc){ asm volatile("s_waitcnt lgkmcnt(0)":::"memory"); \
      _Pragma("unroll") for(int d_=0;d_<2;++d_) _Pragma("unroll") for(int r=0;r<16;++r)o[d_][r]*=wsf[crow(r,hi)]; } }while(0)
  f32x16 pA0,pA1,pB0,pB1;
  int sl_prev=0,sl_cur=0,sl_next=SLOTB;
  #define ROT() do{sl_prev=sl_cur;sl_cur=sl_next;sl_next=(sl_next==(NSLOT-1)*SLOTB)?0:sl_next+SLOTB;}while(0)
  DMA_K(2,2*SLOTB);
  WAIT_BAR(3);
  LDKQ(0); qkt(pA0,pA1,Kbase,qr,kxa(kq0),kxa(kq1),qx,r32,hi);asm volatile("s_nop 15\n\ts_nop 7":"+v"(pA0),"+v"(pA1));CMASK(pA0,pA1,0); LDKQ(1);
  START(pA0,pA1);
  _Pragma("unroll") for(int r=0;r<16;++r)pA1[r]=__builtin_amdgcn_exp2f(pA1[r]);
  WAIT_BAR(0);
  DMA_K(3,0);DMA_V(1,SLOTB);
  ROT();
  kload8(kf,kp0+sl_cur);
  WAIT_BAR(2);
  s16x4 vlo[8],vhi[8]; u32x4 pw0,pw1,pw2,pw3;
  #define PKW(P,B) cvtpk_s(P[B],P[B+1])
  #define PAF(k) __builtin_bit_cast(bf16x8,pw##k)
  #define VFR(i) (bf16x8){vlo[i][0],vlo[i][1],vlo[i][2],vlo[i][3],vhi[i][0],vhi[i][1],vhi[i][2],vhi[i][3]}
  #define PIN(x) asm volatile("":"+v"(x))
  #define MX3(a,b,c) __builtin_fmaxf(__builtin_fmaxf((a),(b)),(c))
  #define GAPA(MF,A0,A1,A2,A3,W0,W1,PW) do{ MF; sacc+=A0; sacc+=A1; sacc+=A2; sacc+=A3; PIN(sacc); W0; W1; PIN(PW); SBAR(); }while(0)
  #define EX(v) __builtin_amdgcn_exp2f(v)
  #define GAPB(MF,X,B) do{ MF; X[B]=EX(X[B]); X[B+1]=EX(X[B+1]); X[B+2]=EX(X[B+2]); X[B+3]=EX(X[B+3]); PIN(X); SBAR(); }while(0)
  #define VRD(i) do{ vlo[i]=vtr(vp_+(((i)>>2)*4096+((i)&3)*1024)); vhi[i]=vtr(vp_+(((i)>>2)*4096+((i)&3)*1024+512)); }while(0)
  #define KRD(G,j) do{ if(G){ kload2(kf,kp0+sl_next,j); SBAR(); } }while(0)
  #define STEP(C0,C1,P0,P1,t,GK,GV,GL) do{ SBAR(); \
    const lds_cptr vp_=vp0+sl_prev; \
    VRD(0); SBAR(); float sacc=(P0[0]+P0[1]); \
    GAPA(C0=__builtin_amdgcn_mfma_f32_32x32x16_bf16(kf[0],qr[0],C0,0,0,0), P0[2],P0[3],P0[4],P0[5],     pw0[0]=PKW(P0,0), pw0[1]=PKW(P0,2), pw0); \
    VRD(4); SBAR(); GAPA(C1=__builtin_amdgcn_mfma_f32_32x32x16_bf16(kf[1],qr[0],C1,0,0,0), P0[6],P0[7],P0[8],P0[9],     pw0[2]=PKW(P0,4), pw0[3]=PKW(P0,6), pw0); \
    VRD(1); SBAR(); GAPA(C0=__builtin_amdgcn_mfma_f32_32x32x16_bf16(kf[2],qr[1],C0,0,0,0),   P0[10],P0[11],P0[12],P0[13], pw1[0]=PKW(P0,8), pw1[1]=PKW(P0,10), pw1); \
    VRD(5); SBAR(); GAPA(C1=__builtin_amdgcn_mfma_f32_32x32x16_bf16(kf[3],qr[1],C1,0,0,0),   P0[14],P0[15],P1[0],P1[1],   pw1[2]=PKW(P0,12),pw1[3]=PKW(P0,14), pw1); \
    VRD(2); SBAR(); GAPA(C0=__builtin_amdgcn_mfma_f32_32x32x16_bf16(kf[4],qr[2],C0,0,0,0),   P1[2],P1[3],P1[4],P1[5],     pw2[0]=PKW(P1,0), pw2[1]=PKW(P1,2), pw2); \
    VRD(6); SBAR(); GAPA(C1=__builtin_amdgcn_mfma_f32_32x32x16_bf16(kf[5],qr[2],C1,0,0,0),   P1[6],P1[7],P1[8],P1[9],     pw2[2]=PKW(P1,4), pw2[3]=PKW(P1,6), pw2); \
    VRD(3); SBAR(); GAPA(C0=__builtin_amdgcn_mfma_f32_32x32x16_bf16(kf[6],qr[3],C0,0,0,0),   P1[10],P1[11],P1[12],P1[13], pw3[0]=PKW(P1,8), pw3[1]=PKW(P1,10), pw3); \
    VRD(7); SBAR(); GAPA(C1=__builtin_amdgcn_mfma_f32_32x32x16_bf16(kf[7],qr[3],C1,0,0,0),   P1[14],P1[15],0.f,0.f,       pw3[2]=PKW(P1,12),pw3[3]=PKW(P1,14), pw3); \
    l_reg+=sacc; if(GL){LDKQ((t)+1);} \
    if(GK){DMA_K((t)+3,sl_cur);} if(GV){DMA_V((t)+1,sl_next);} \
    CMASK(C0,C1,t); \
    { float a=MX3(C0[0],C0[1],C1[0]),b=MX3(C0[2],C0[3],C1[1]); a=MX3(a,C1[2],C1[3]); \
      _Pragma("unroll") for(int r=4;r<16;r+=4){a=MX3(a,C0[r],C0[r+1]);b=MX3(b,C0[r+2],C0[r+3]);a=MX3(a,C1[r],C1[r+1]);b=MX3(b,C1[r+2],C1[r+3]);} \
      float rm=__builtin_fmaxf(a,b); { auto rr=__builtin_amdgcn_permlane32_swap(__float_as_uint(rm),__float_as_uint(rm),false,false); rm=__builtin_fmaxf(__uint_as_float(rr[0]),__uint_as_float(rr[1])); } \
      resc=false; \
      if(__builtin_expect(__any(rm>(float)THRL),0)){ const float dl=__builtin_fmaxf(rm,0.f); mhat+=dl; \
        _Pragma("unroll") for(int r=0;r<16;++r){C0[r]-=dl;C1[r]-=dl;} \
        qx=mkqx(-mhat,hi); \
        const float f=__builtin_amdgcn_exp2f(-dl); l_reg*=f; if(hi==0)wsf[r32]=f; resc=true; } } \
    SBAR(); \
    GAPB(o[0]=__builtin_amdgcn_mfma_f32_32x32x16_bf16(PAF(0),VFR(0),o[0],0,0,0), C0,0); \
    GAPB(o[1]=__builtin_amdgcn_mfma_f32_32x32x16_bf16(PAF(0),VFR(4),o[1],0,0,0), C0,4); \
    KRD(GL,0); GAPB(o[0]=__builtin_amdgcn_mfma_f32_32x32x16_bf16(PAF(1),VFR(1),o[0],0,0,0), C0,8); \
    KRD(GL,1); GAPB(o[1]=__builtin_amdgcn_mfma_f32_32x32x16_bf16(PAF(1),VFR(5),o[1],0,0,0), C0,12); \
    KRD(GL,2); GAPB(o[0]=__builtin_amdgcn_mfma_f32_32x32x16_bf16(PAF(2),VFR(2),o[0],0,0,0), C1,0); \
    KRD(GL,3); GAPB(o[1]=__builtin_amdgcn_mfma_f32_32x32x16_bf16(PAF(2),VFR(6),o[1],0,0,0), C1,4); \
    GAPB(o[0]=__builtin_amdgcn_mfma_f32_32x32x16_bf16(PAF(3),VFR(3),o[0],0,0,0), C1,8); \
    GAPB(o[1]=__builtin_amdgcn_mfma_f32_32x32x16_bf16(PAF(3),VFR(7),o[1],0,0,0), C1,12); \
    if(GL){ P0=__builtin_amdgcn_mfma_f32_32x32x16_bf16(kxa(kq0),qx,f32x16{},0,0,0); P1=__builtin_amdgcn_mfma_f32_32x32x16_bf16(kxa(kq1),qx,f32x16{},0,0,0); } \
    }while(0)
  pB0=__builtin_amdgcn_mfma_f32_32x32x16_bf16(kxa(kq0),qx,f32x16{},0,0,0); pB1=__builtin_amdgcn_mfma_f32_32x32x16_bf16(kxa(kq1),qx,f32x16{},0,0,0);
  int t=1;
  #undef CMASK
  #define CMASK(P0,P1,t) do{}while(0)
  for(;t+5<NT;t+=2){
    STEP(pB0,pB1,pA0,pA1,t,true,true,true);     WAIT_BAR(2); RESC(); ROT();
    STEP(pA0,pA1,pB0,pB1,t+1,true,true,true);   WAIT_BAR(2); RESC(); ROT();
  }
  #undef CMASK
  #define CMASK(P0,P1,t) do{int jb_=(t)-(NT-4); if(jb_>=0)cmask(P0,P1,jb_,qrel,hi);}while(0)
  #define ENDW(tt) do{ if((tt)+3<NT){WAIT_BAR(2);} else if((tt)+2<NT){WAIT_BAR(1);} else {WAIT_BAR(0);} }while(0)
  for(;t+1<NT;t+=2){
    STEP(pB0,pB1,pA0,pA1,t,(t+3<NT),(t+1<NT),(t+1<NT));       ENDW(t);   RESC(); ROT();
    STEP(pA0,pA1,pB0,pB1,t+1,(t+4<NT),(t+2<NT),(t+2<NT));     ENDW(t+1); RESC(); ROT();
  }
  STEP(pB0,pB1,pA0,pA1,NT-1,false,false,false); RESC();
  { float sacc=pB0[0]+pB0[1]; _Pragma("unroll") for(int r=2;r<16;++r)sacc+=pB0[r]; _Pragma("unroll") for(int r=0;r<16;++r)sacc+=pB1[r]; l_reg+=sacc;
    pw0=(u32x4){PKW(pB0,0),PKW(pB0,2),PKW(pB0,4),PKW(pB0,6)};pw1=(u32x4){PKW(pB0,8),PKW(pB0,10),PKW(pB0,12),PKW(pB0,14)};pw2=(u32x4){PKW(pB1,0),PKW(pB1,2),PKW(pB1,4),PKW(pB1,6)};pw3=(u32x4){PKW(pB1,8),PKW(pB1,10),PKW(pB1,12),PKW(pB1,14)};
    SBAR(); pv(o,vb0+sl_cur,PAF(0),PAF(1),PAF(2),PAF(3)); }
  #undef PKW
  #undef PAF
  #undef VFR
  #undef PIN
  #undef MX3
  #undef GAPA
  #undef GAPB
  #undef EX
  #undef VRD
  #undef KRD
  #undef STEP
  #undef ENDW
  {auto rr=__builtin_amdgcn_permlane32_swap(__float_as_uint(l_reg),__float_as_uint(l_reg),false,false);l_reg=__uint_as_float(rr[0])+__uint_as_float(rr[1]);}
  if(hi==0)wsf[32+r32]=l_reg;asm volatile("s_waitcnt lgkmcnt(0)":::"memory");
  float rli[16];
  #pragma unroll
  for(int r=0;r<16;++r)rli[r]=__builtin_amdgcn_rcpf(wsf[32+crow(r,hi)]);
  bf16*Ow=O+(rowbase+q0+wid*QBLK)*DM+h*D;
  { bf16*stg=(bf16*)(shm+LDS_OST)+wid*2048;
    #pragma unroll
    for(int r=0;r<16;++r){const int orow=crow(r,hi);
      #pragma unroll
      for(int d0=0;d0<2;++d0)stg[orow*64+d0*32+r32]=__float2bfloat16(o[d0][r]*rli[r]);}
    asm volatile("s_waitcnt lgkmcnt(0)":::"memory");
    #pragma unroll
    for(int i=0;i<4;++i){const int row=i*8+(lane>>3),ch=lane&7; const u32x4 v=*(const u32x4*)(stg+row*64+ch*8); ATTN_STORE16(Ow+(long)row*DM+ch*8,v);} }
  asm volatile("s_waitcnt lgkmcnt(0)\n\ts_barrier":::"memory");
  #undef DMA_K
  #undef DMA_V
  #undef CMASK
  #undef START
  #undef RESC
  #undef ROT
}
constexpr int ATTN_LDS_BYTES=LDS_TOTAL;
struct AttnTensors { const bf16* Q; const bf16* K; const bf16* V; bf16* O; const float* LFt; };
struct AttnUnit { int bh; int qb; };
struct StaticOrder {
  int vcu,G;
  __device__ __forceinline__ explicit StaticOrder(int grid,int v):vcu(v),G(grid){}
  __device__ __forceinline__ bool next(int i,AttnUnit&u)const{ const int v=vcu+(i>>3)*G; if(v>=256)return false; const int s=v&15,r=(i>>1)&3; u.bh=(v>>5)*8+2*r+((v>>4)&1); u.qb=(i&1)?s:31-s; return true; }
  __device__ __forceinline__ void a_ready(const AttnUnit&)const{}
  __device__ __forceinline__ void done(const AttnUnit&)const{}
};
template<class Sched,int THRL=64> __device__ __forceinline__ void attn_phase(char*lds,const AttnTensors&T,const Sched&S){
  AttnUnit u; int pbh=-1;
  for(int i=0;S.next(i,u);++i){ S.a_ready(u); attn_unit<THRL>(u.bh/NHEAD,u.bh%NHEAD,u.qb,T.Q,T.K,T.V,T.O,T.LFt,u.bh!=pbh,lds); pbh=u.bh; S.done(u); }
}
#undef SBAR
#undef WAIT_BAR
}
namespace hg {
#define HLAS __attribute__((address_space(3)))
#define HG_BAR() asm volatile("s_waitcnt lgkmcnt(0)\n\ts_barrier" ::: "memory")
typedef short bf16x8 __attribute__((ext_vector_type(8)));
typedef float f32x4 __attribute__((ext_vector_type(4)));
typedef unsigned u32x4 __attribute__((ext_vector_type(4)));
typedef unsigned u32x2 __attribute__((ext_vector_type(2)));
typedef unsigned short u16;
constexpr int L_QD = 0, L_KI = 17408, L_IVT = 34816, L_KST = 53248, L_AM = 71680, L_TOT = 80896, L_SSQ = 82944, L_DECL = 83456, L_CIN = 83968, L_END = L_CIN + 128 * 272;
constexpr int P_QD = 272, P_T = 144;
constexpr int NUNITS = 4096;
typedef float pk_f32x2 __attribute__((ext_vector_type(2))); typedef __bf16 pk_bf16x2 __attribute__((ext_vector_type(2)));
__device__ __forceinline__ unsigned pk2(float lo, float hi) { const pk_f32x2 v = {lo, hi}; return __builtin_bit_cast(unsigned, __builtin_convertvector(v, pk_bf16x2)); }
__device__ __forceinline__ unsigned f2bf(float f) { return pk2(f, f) & 0xffffu; }
__device__ __forceinline__ float bf2f(unsigned h) { return __builtin_bit_cast(float, h << 16); }
__device__ __forceinline__ float h2f(u16 h) { return (float)__builtin_bit_cast(_Float16, h); }

struct Tensors { const u16* HLF; const u16* HQ; const u16* HI; const u16* HG; u16* US; float* DEC; const float* onorm_g; const float* LB; u16* OG; u16* SFC; float* PB; };

template <bool PA> struct Raw { u16 fl[16]; u16 q[16]; u32x4 iv[2]; u32x2 hg[4]; };
template <bool PA> __device__ __forceinline__ void load_raw(const Tensors& T, int unit, int tid, Raw<PA>& r) {
    const int bh = unit >> 7, n = unit & 127, b = bh >> 3, h = bh & 7; const size_t rowbase = (size_t)b * 8192 + (size_t)n * 64;
    const int d = tid & 127, qt = tid >> 7;
    const u16* lfp = T.HLF + (rowbase + 16 * qt) * 1024 + 128 * h + d;
#pragma unroll
    for (int i = 0; i < 16; ++i) r.fl[i] = lfp[(size_t)i * 1024];
    if (!PA) { const u16* qp = T.HQ + (rowbase + 16 * qt) * 1024 + 128 * h + d;
#pragma unroll
        for (int i = 0; i < 16; ++i) r.q[i] = qp[(size_t)i * 1024]; }
#pragma unroll
    for (int it = 0; it < 2; ++it) { const int idx = tid + it * 512; const int s = idx >> 4, vg = idx & 15;
        r.iv[it] = *(const u32x4*)(T.HI + (rowbase + s) * 1024 + 128 * h + 8 * vg); }    if (!PA) { const int lane = tid & 63, w = tid >> 6, lr = lane & 15, kq = lane >> 4, ct = w & 3, wh = w >> 2;
#pragma unroll
        for (int vi = 0; vi < 4; ++vi) r.hg[vi] = *(const u32x2*)(T.HG + (rowbase + 16 * ct + lr) * 1024 + 128 * h + 64 * wh + 16 * vi + 4 * kq); }
}
template <bool PA> __device__ __forceinline__ float prep(HLAS unsigned char* L, const Tensors& T, int unit, int h, int tid, const Raw<PA>& r, float Bacc) {
    const int d = tid & 127, qt = tid >> 7;
    float kk[16], cs[16]; float run = 0.f;
    const float lb = T.LB[128 * h + d];
#pragma unroll
    for (int i = 0; i < 16; ++i) kk[i] = h2f(r.fl[i]);
#pragma unroll
    for (int i = 0; i < 16; ++i) { const float sg = __builtin_amdgcn_rcpf(1.0f + __expf(-kk[i])); const float f = lb + (1.0f - lb) * sg;
        kk[i] = (1.0f - lb) * (1.0f - sg); run += __logf(f); cs[i] = run; }
    HLAS float* TOT = (HLAS float*)(L + L_TOT);
    TOT[qt * 128 + d] = run;
    HG_BAR();
    const float t0 = TOT[d], t1 = TOT[128 + d], t2 = TOT[256 + d], t3 = TOT[384 + d];
    const float pre = (qt > 0 ? t0 : 0.f) + (qt > 1 ? t1 : 0.f) + (qt > 2 ? t2 : 0.f);
    const float blast = ((t0 + t1) + t2) + t3;
    const float dec = __expf(blast);
    if (qt == 0) ((HLAS float*)(L + L_DECL))[d] = dec;
    float q[16]; unsigned w[8];
    if (!PA) {
#pragma unroll
        for (int i = 0; i < 16; ++i) q[i] = bf2f(r.q[i]);
    }
#pragma unroll
    for (int i = 0; i < 16; i += 2) { float ksv[2];
#pragma unroll
        for (int jj = 0; jj < 2; ++jj) { const int ii = i + jj; const float bb = pre + cs[ii]; const float ieb = __expf(-bb); const float ki = kk[ii] * ieb; ksv[jj] = ki * dec;
            if (!PA) { *(HLAS u16*)(L + L_QD + (16 * qt + ii) * P_QD + d * 2) = (u16)f2bf(q[ii] * __expf(bb));
                       *(HLAS u16*)(L + L_KI + (16 * qt + ii) * P_QD + d * 2) = (u16)f2bf(ki); } }
        w[i >> 1] = pk2(ksv[0], ksv[1]); }
    { HLAS u32x4* dst = (HLAS u32x4*)(L + L_KST + d * P_T + qt * 32);
      dst[0] = (u32x4){w[0], w[1], w[2], w[3]}; dst[1] = (u32x4){w[4], w[5], w[6], w[7]}; }
    return blast;
}
__device__ __forceinline__ int ivt_off(int row, int chunk) { return row * P_T + ((chunk ^ ((row >> 3) & 7)) << 4); }
__device__ __forceinline__ void stage_ivt(HLAS unsigned char* L, const u32x4 (&iv)[2], int tid) {
#pragma unroll
    for (int it = 0; it < 2; ++it) { const int idx = tid + it * 512; const int s = idx >> 4, vg = idx & 15;
        const u32x4 w = iv[it];
#pragma unroll
        for (int j = 0; j < 8; ++j) { const unsigned dw = w[j >> 1]; *(HLAS u16*)(L + L_IVT + ivt_off(8 * vg + j, s >> 3) + (s & 7) * 2) = (u16)((j & 1) ? (dw >> 16) : (dw & 0xffffu)); } }
}
#define HG_MFMA(X, Y, C) __builtin_amdgcn_mfma_f32_16x16x32_bf16((X), (Y), (C), 0, 0, 0)

__device__ __forceinline__ void phaseB(const Tensors& T, int vb, int tid) {
    const int g = vb * 512 + tid, d4 = g & 31, v = (g >> 5) & 127, bh = g >> 12;
    u32x2* p = (u32x2*)T.SFC + ((size_t)(bh * 8) * 128 + v) * 32 + d4;
    const f32x4* dp = (const f32x4*)T.PB + (size_t)(bh * 8) * 32 + d4;
    f32x4 S = (f32x4){0.f, 0.f, 0.f, 0.f};
    u32x2 u[8]; f32x4 dc[8];
#pragma unroll
    for (int j = 0; j < 8; ++j) { u[j] = p[(size_t)j * 4096]; dc[j] = dp[(size_t)j * 32]; }
#pragma unroll
    for (int j = 0; j < 8; ++j) {
        p[(size_t)j * 4096] = (u32x2){pk2(S[0], S[1]), pk2(S[2], S[3])};
        const f32x4 uu = (f32x4){bf2f(u[j].x & 0xffffu), bf2f(u[j].x >> 16), bf2f(u[j].y & 0xffffu), bf2f(u[j].y >> 16)};
        S = dc[j] * S + uu;
    }
}
__device__ __forceinline__ void phaseC_unit(HLAS unsigned char* L, const Tensors& T, int unit, int tid, const Raw<false>& raw, f32x4 (&S)[8]) {
    const int bh = unit >> 7, n = unit & 127, b = bh >> 3, h = bh & 7; const size_t rowbase = (size_t)b * 8192 + (size_t)n * 64;
    const int lane = tid & 63, w = tid >> 6, lr = lane & 15, kq = lane >> 4;
    const int ct = w & 3, wh = w >> 2;
    prep<false>(L, T, unit, h, tid, raw, 0.f);
    stage_ivt(L, raw.iv, tid);
    {
        HLAS unsigned char* sx = L + L_CIN + (16 * w + lr) * 272 + 8 * kq;
#pragma unroll
        for (int dt = 0; dt < 8; ++dt) *(HLAS u32x2*)(sx + 32 * dt) = (u32x2){pk2(S[dt][0], S[dt][1]), pk2(S[dt][2], S[dt][3])};
    }
    HG_BAR();
    {
        f32x4 ua[8];
#pragma unroll
        for (int dt = 0; dt < 8; ++dt) ua[dt] = (f32x4){0.f, 0.f, 0.f, 0.f};
#pragma unroll
        for (int ks = 0; ks < 2; ++ks) {
            const bf16x8 Y = *(const HLAS bf16x8*)(L + L_IVT + ivt_off(16 * w + lr, 4 * ks + kq));
#pragma unroll
            for (int dt = 0; dt < 8; ++dt) { const bf16x8 X = *(const HLAS bf16x8*)(L + L_KST + (16 * dt + lr) * P_T + (32 * ks + 8 * kq) * 2); ua[dt] = HG_MFMA(X, Y, ua[dt]); }
        }
        const HLAS f32x4* dl = (const HLAS f32x4*)(L + L_DECL);
#pragma unroll
        for (int dt = 0; dt < 8; ++dt) S[dt] = dl[4 * dt + kq] * S[dt] + ua[dt];
    }
#pragma unroll
    for (int sp = 0; sp < 2; ++sp) { const int st = 2 * wh + sp;
        f32x4 a = (f32x4){0.f, 0.f, 0.f, 0.f};
        if (st <= ct) {
#pragma unroll
            for (int ks = 0; ks < 4; ++ks) { const bf16x8 X = *(const HLAS bf16x8*)(L + L_KI + (16 * st + lr) * P_QD + (32 * ks + 8 * kq) * 2);
                const bf16x8 Y = *(const HLAS bf16x8*)(L + L_QD + (16 * ct + lr) * P_QD + (32 * ks + 8 * kq) * 2); a = HG_MFMA(X, Y, a); }
        }
        const int c = 16 * ct + lr, s0 = 16 * st + 4 * kq;
        float m[4];
#pragma unroll
        for (int e = 0; e < 4; ++e) m[e] = (st <= ct && s0 + e <= c) ? a[e] : 0.f;
        *(HLAS u32x2*)(L + L_AM + c * P_T + s0 * 2) = (u32x2){pk2(m[0], m[1]), pk2(m[2], m[3])};
    }
    HG_BAR();
    f32x4 acc[4];
#pragma unroll
    for (int vi = 0; vi < 4; ++vi) acc[vi] = (f32x4){0.f, 0.f, 0.f, 0.f};
#pragma unroll
    for (int vi = 0; vi < 4; ++vi) {
#pragma unroll
        for (int ks = 0; ks < 2; ++ks) { const bf16x8 X = *(const HLAS bf16x8*)(L + L_IVT + ivt_off(64 * wh + 16 * vi + lr, 4 * ks + kq));
            const bf16x8 Y = *(const HLAS bf16x8*)(L + L_AM + (16 * ct + lr) * P_T + (32 * ks + 8 * kq) * 2); acc[vi] = HG_MFMA(X, Y, acc[vi]); }
#pragma unroll
        for (int ks = 0; ks < 4; ++ks) { const bf16x8 Y = *(const HLAS bf16x8*)(L + L_QD + (16 * ct + lr) * P_QD + (32 * ks + 8 * kq) * 2); const bf16x8 X = *(const HLAS bf16x8*)(L + L_CIN + (64 * wh + 16 * vi + lr) * 272 + (32 * ks + 8 * kq) * 2); acc[vi] = HG_MFMA(X, Y, acc[vi]); }
    }
    float ss = 0.f;
#pragma unroll
    for (int vi = 0; vi < 4; ++vi) ss += (acc[vi][0] * acc[vi][0] + acc[vi][1] * acc[vi][1]) + (acc[vi][2] * acc[vi][2] + acc[vi][3] * acc[vi][3]);
    ss += __shfl_xor(ss, 16); ss += __shfl_xor(ss, 32);
    HLAS float* SSQ = (HLAS float*)(L + L_SSQ);
    if (kq == 0) SSQ[wh * 64 + 16 * ct + lr] = ss;
    HG_BAR();
    const float tot = SSQ[16 * ct + lr] + SSQ[64 + 16 * ct + lr];
    const float rstd = 1.0f / sqrtf(tot * (1.0f / 128.0f) + 1e-6f);
    const size_t orow = (rowbase + 16 * ct + lr) * 1024 + 128 * h;
#pragma unroll
    for (int vi = 0; vi < 4; ++vi) { const int v0 = 64 * wh + 16 * vi + 4 * kq;
        const f32x4 gn = *(const f32x4*)(T.onorm_g + 128 * h + v0);
        const u32x2 gg = raw.hg[vi];
        const float o0 = acc[vi][0] * rstd * gn[0] * bf2f(gg.x & 0xffffu), o1 = acc[vi][1] * rstd * gn[1] * bf2f(gg.x >> 16);
        const float o2 = acc[vi][2] * rstd * gn[2] * bf2f(gg.y & 0xffffu), o3 = acc[vi][3] * rstd * gn[3] * bf2f(gg.y >> 16);
        *(u32x2*)(T.OG + orow + v0) = (u32x2){pk2(o0, o1), pk2(o2, o3)}; }
    HG_BAR();
}
constexpr int A_KST = 0, A_IVT = 34816, A_TOT = 69632, A_DECL = 71680, A_END = 72192;
struct RawA { u16 fl[32]; u32x4 iv[4]; };
__device__ __forceinline__ void load_rawA(const Tensors& T, size_t rowbase, int h, int tid, RawA& r) {
    const int d = tid & 127, qt = tid >> 7;
    const u16* lfp = T.HLF + (rowbase + 32 * qt) * 1024 + 128 * h + d;
#pragma unroll
    for (int i = 0; i < 32; ++i) r.fl[i] = lfp[(size_t)i * 1024];
#pragma unroll
    for (int it = 0; it < 4; ++it) { const int idx = tid + it * 512; const int s = idx >> 4, vg = idx & 15;
        r.iv[it] = *(const u32x4*)(T.HI + (rowbase + s) * 1024 + 128 * h + 8 * vg); }
}
__device__ __forceinline__ int ivtA_off(int row, int chunk) { return row * 272 + ((chunk ^ ((row >> 3) & 7)) << 4); }
__device__ __forceinline__ void phaseA_unit128(HLAS unsigned char* L, const Tensors& T, int h, int tid, const RawA& r, f32x4 (&S)[8], float& Bsum) {
    const int lane = tid & 63, w = tid >> 6, lr = lane & 15, kq = lane >> 4, d = tid & 127, qt = tid >> 7;
    {
        float kk[32], cs[32]; float run = 0.f;
        const float lb = T.LB[128 * h + d];
#pragma unroll
        for (int i = 0; i < 32; ++i) { const float fl = h2f(r.fl[i]); const float sg = __builtin_amdgcn_rcpf(1.0f + __expf(-fl)); const float f = lb + (1.0f - lb) * sg;
            kk[i] = (1.0f - lb) * (1.0f - sg); run += __logf(f); cs[i] = run; }
        HLAS float* TOT = (HLAS float*)(L + A_TOT);
        TOT[qt * 128 + d] = run;
        HG_BAR();
        const float t0 = TOT[d], t1 = TOT[128 + d], t2 = TOT[256 + d], t3 = TOT[384 + d];
        const float pre = (qt > 0 ? t0 : 0.f) + (qt > 1 ? t1 : 0.f) + (qt > 2 ? t2 : 0.f);
        const float blast = ((t0 + t1) + t2) + t3;
        unsigned wv[16];
#pragma unroll
        for (int i = 0; i < 32; i += 2) wv[i >> 1] = pk2(kk[i] * __expf(blast - (pre + cs[i])), kk[i + 1] * __expf(blast - (pre + cs[i + 1])));
        HLAS u32x4* dst = (HLAS u32x4*)(L + A_KST + d * 272 + qt * 64);
#pragma unroll
        for (int j = 0; j < 4; ++j) dst[j] = (u32x4){wv[4 * j], wv[4 * j + 1], wv[4 * j + 2], wv[4 * j + 3]};
        if (qt == 0) ((HLAS float*)(L + A_DECL))[d] = __expf(blast);
        Bsum += blast;
    }
#pragma unroll
    for (int it = 0; it < 4; ++it) { const int idx = tid + it * 512; const int s = idx >> 4, vg = idx & 15; const u32x4 wd = r.iv[it];
#pragma unroll
        for (int j = 0; j < 8; ++j) { const unsigned dw = wd[j >> 1]; *(HLAS u16*)(L + A_IVT + ivtA_off(8 * vg + j, s >> 3) + (s & 7) * 2) = (u16)((j & 1) ? (dw >> 16) : (dw & 0xffffu)); } }
    HG_BAR();
    f32x4 acc[8];
#pragma unroll
    for (int dt = 0; dt < 8; ++dt) acc[dt] = (f32x4){0.f, 0.f, 0.f, 0.f};
#pragma unroll
    for (int ks = 0; ks < 4; ++ks) {
        const bf16x8 Y = *(const HLAS bf16x8*)(L + A_IVT + ivtA_off(16 * w + lr, 4 * ks + kq));
#pragma unroll
        for (int dt = 0; dt < 8; ++dt) { const bf16x8 X = *(const HLAS bf16x8*)(L + A_KST + (16 * dt + lr) * 272 + (32 * ks + 8 * kq) * 2); acc[dt] = HG_MFMA(X, Y, acc[dt]); }
    }
    const HLAS f32x4* dl = (const HLAS f32x4*)(L + A_DECL);
#pragma unroll
    for (int dt = 0; dt < 8; ++dt) S[dt] = dl[4 * dt + kq] * S[dt] + acc[dt];
    HG_BAR();
}
__device__ __forceinline__ void phaseA_all(HLAS unsigned char* L, const Tensors& T, int u0, int cnt, int tid) {
    const int lane = tid & 63, w = tid >> 6, lr = lane & 15, kq = lane >> 4, blk = u0 >> 4, bh = blk >> 3, b = bh >> 3, h = bh & 7;
    const size_t row0 = (size_t)b * 8192 + (size_t)(blk & 7) * 1024;
    const int nu = cnt >> 1;
    f32x4 S[8]; float Bsum = 0.f;
#pragma unroll
    for (int dt = 0; dt < 8; ++dt) S[dt] = (f32x4){0.f, 0.f, 0.f, 0.f};
    RawA cur; load_rawA(T, row0, h, tid, cur);
    for (int i = 0; i < nu; ++i) { RawA nxt; load_rawA(T, row0 + (size_t)128 * (i + 1 < nu ? i + 1 : i), h, tid, nxt); phaseA_unit128(L, T, h, tid, cur, S, Bsum); cur = nxt; }
    u16* sp = T.SFC + ((size_t)blk * 128 + 16 * w + lr) * 128 + 4 * kq;
#pragma unroll
    for (int dt = 0; dt < 8; ++dt) *(u32x2*)(sp + 16 * dt) = (u32x2){pk2(S[dt][0], S[dt][1]), pk2(S[dt][2], S[dt][3])};
    if ((tid >> 7) == 0) T.PB[(size_t)blk * 128 + (tid & 127)] = __expf(Bsum);
}
__device__ __forceinline__ void phaseC_all(HLAS unsigned char* L, const Tensors& T, int u0, int cnt, int tid) {
    const int lane = tid & 63, w = tid >> 6, lr = lane & 15, kq = lane >> 4, blk = u0 >> 4;
    const int kb = blk & 7, blk0 = blk - kb;
    f32x4 S[8];
#pragma unroll
    for (int dt = 0; dt < 8; ++dt) S[dt] = (f32x4){0.f, 0.f, 0.f, 0.f};
    for (int j = 0; j < kb; ++j) {
        const u16* sf = T.SFC + ((size_t)(blk0 + j) * 128 + 16 * w + lr) * 128 + 4 * kq; const float* pb = T.PB + (size_t)(blk0 + j) * 128 + 4 * kq;
#pragma unroll
        for (int dt = 0; dt < 8; ++dt) { const u32x2 s2 = *(const u32x2*)(sf + 16 * dt); const f32x4 p = *(const f32x4*)(pb + 16 * dt);
            S[dt] = p * S[dt] + (f32x4){bf2f(s2.x & 0xffffu), bf2f(s2.x >> 16), bf2f(s2.y & 0xffffu), bf2f(s2.y >> 16)}; }
    }
    Raw<false> cur; load_raw<false>(T, u0, tid, cur);
    for (int i = 0; i < cnt; ++i) { Raw<false> nxt; load_raw<false>(T, u0 + (i + 1 < cnt ? i + 1 : i), tid, nxt); phaseC_unit(L, T, u0 + i, tid, cur, S); cur = nxt; }
}
}

namespace cg = cooperative_groups;
constexpr int NWAVES = 8;
constexpr int BATCH = 4, T = 8192, D = 1024, H = 16, HD = 64, FF = 2816, FF2 = 5632;
constexpr int M = BATCH * T;
constexpr float RMS_EPS = 1e-6f;
constexpr size_t MiB = 1u << 20;
constexpr size_t WS_WQKV = 1 * MiB;
constexpr size_t WS_WO = WS_WQKV + (size_t)3328 * 1024 * 2;
constexpr size_t WS_WUP0 = WS_WO + (size_t)1024 * 1024 * 2;
constexpr size_t WS_WDN0 = WS_WUP0 + (size_t)5632 * 1024 * 2;
constexpr size_t WS_WHIN = WS_WDN0 + (size_t)1024 * 2816 * 2;
constexpr size_t WS_WHO = WS_WHIN + (size_t)4096 * 1024 * 2;
constexpr size_t WS_WUP1 = WS_WHO + (size_t)1024 * 1024 * 2;
constexpr size_t WS_WDN1 = WS_WUP1 + (size_t)5632 * 1024 * 2;
constexpr size_t WS_WEND = WS_WDN1 + (size_t)1024 * 2816 * 2;
constexpr size_t WS_SSQ = 54 * MiB;
constexpr size_t WS_BIG = 56 * MiB;
constexpr size_t WS_Q = WS_BIG, WS_K = WS_BIG + 64 * MiB, WS_V = WS_BIG + 128 * MiB;
constexpr size_t WS_U = WS_BIG;
constexpr size_t WS_HLF = WS_BIG, WS_HQ = WS_BIG + 64 * MiB, WS_HI = WS_BIG + 128 * MiB, WS_HG = WS_BIG + 192 * MiB, WS_US = WS_BIG + 256 * MiB;
constexpr size_t WS_XN = 312 * MiB;
constexpr size_t WS_UH = 240 * MiB;
constexpr size_t WS_LFT = 504 * MiB;
constexpr size_t WS_DEC = 506 * MiB;
constexpr size_t WS_LB = 53 * MiB;
constexpr size_t WS_CWB = 53 * MiB + 65536;
constexpr size_t WS_PROBE = 53 * MiB + 262144;
constexpr size_t WS_BARW = WS_PROBE + 65536;
constexpr size_t WS_RB = 440 * MiB;
constexpr size_t WS_OG = WS_HQ;
constexpr size_t WS_SFC = 504 * MiB;
constexpr size_t WS_PB = 55 * MiB;
constexpr size_t WS_END = 512 * MiB;
static_assert(WS_WEND <= WS_LB && WS_BARW + 65536 <= WS_BIG && WS_U + (size_t)M * FF * 2 <= WS_UH && WS_UH + (size_t)128 * 4 * FF2 * 4 <= WS_XN && WS_V + 64 * MiB <= WS_XN && WS_HG + 64 * MiB <= WS_XN && WS_US + 128 * MiB <= WS_RB && WS_RB + 64 * MiB <= WS_LFT && WS_SFC + 8 * MiB <= WS_END && WS_SSQ + (size_t)M * 16 <= WS_PB && WS_PB + 131072 <= WS_BIG, "d_ws map");
static_assert(WS_HQ == WS_HLF + 64 * MiB && WS_HI == WS_HLF + 128 * MiB && WS_HG == WS_HLF + 192 * MiB, "EpiHgrn buffer order");
constexpr int LDS_BYTES = 155648;
constexpr int LDS_XH = pg8::STAGE_BYTES, LDS_TAPL = LDS_XH + 16384, LDS_RSL = LDS_TAPL + 4096;
static_assert(LDS_RSL + 2048 <= LDS_BYTES - 64, "epilogue LDS areas");
static_assert(attn_body::ATTN_LDS_BYTES <= LDS_BYTES && hg::L_END <= LDS_BYTES && pg8::STAGE_BYTES <= LDS_BYTES, "LDS map");

#define LAS __attribute__((address_space(3)))
typedef unsigned short bf16;
typedef unsigned v4u __attribute__((ext_vector_type(4)));
typedef float f32x4 __attribute__((ext_vector_type(4)));
typedef float pk_f32x2 __attribute__((ext_vector_type(2))); typedef __bf16 pk_bf16x2 __attribute__((ext_vector_type(2)));
__device__ __forceinline__ unsigned pk2(float lo, float hi) { const pk_f32x2 v = {lo, hi}; return __builtin_bit_cast(unsigned, __builtin_convertvector(v, pk_bf16x2)); }
__device__ __forceinline__ unsigned f2bf(float f) { return pk2(f, f) & 0xffffu; }
__device__ __forceinline__ float wave_sum(float v) {
#pragma unroll
    for (int o = 1; o < 64; o <<= 1) v += __shfl_xor(v, o);
    return v;
}
__device__ __forceinline__ void transpose_item(const float* W, int ldw, int K, int nblk, bf16* WT, LAS float* scr, int item, int lane, bool perm_up = false, const float* gain = nullptr) {
    const int kb = item / nblk, nb = item % nblk, k0 = 64 * kb, n0 = 32 * nb;
    const int n0p = !perm_up ? n0 : (n0 < FF ? 256 * (n0 / 128) + (n0 % 128) : 256 * ((n0 - FF) / 128) + 128 + ((n0 - FF) % 128));
#pragma unroll 8
    for (int i = 0; i < 32; ++i) { const int kk = 2 * i + (lane >> 5); scr[kk * 33 + (lane & 31)] = W[(size_t)(k0 + kk) * ldw + n0 + (lane & 31)] * (gain ? gain[k0 + kk] : 1.0f); }
    asm volatile("s_waitcnt lgkmcnt(0)" ::: "memory");
    const int c = lane & 7;
#pragma unroll
    for (int j = 0; j < 4; ++j) { const int n = (lane >> 3) + 8 * j; const LAS float* s = scr + (8 * c) * 33 + n;
        v4u o; o.x = pk2(s[0 * 33], s[1 * 33]); o.y = pk2(s[2 * 33], s[3 * 33]); o.z = pk2(s[4 * 33], s[5 * 33]); o.w = pk2(s[6 * 33], s[7 * 33]);
        *(v4u*)(WT + (size_t)(n0p + n) * K + k0 + 8 * c) = o; }
    asm volatile("s_waitcnt lgkmcnt(0)" ::: "memory");
}
__device__ __forceinline__ void norm_rows_bf16(const float* src, const float* g, bf16* dst, int gw, int NGW, int lane) {
    f32x4 gg[4];
#pragma unroll
    for (int j = 0; j < 4; ++j) gg[j] = ((const f32x4*)g)[lane + 64 * j];
    for (int m = gw; m < M; m += NGW) {
        const f32x4* xr = (const f32x4*)(src + (size_t)m * D) + lane; f32x4 v[4]; float s = 0.f;
#pragma unroll
        for (int j = 0; j < 4; ++j) { v[j] = xr[64 * j]; s += (v[j].x * v[j].x + v[j].y * v[j].y) + (v[j].z * v[j].z + v[j].w * v[j].w); }
        const float rstd = 1.0f / sqrtf(wave_sum(s) * (1.0f / D) + RMS_EPS);
        unsigned long long* o8 = (unsigned long long*)(dst + (size_t)m * D) + lane;
#pragma unroll
        for (int j = 0; j < 4; ++j) o8[64 * j] = (unsigned long long)pk2(v[j].x * rstd * gg[j].x, v[j].y * rstd * gg[j].y) | ((unsigned long long)pk2(v[j].z * rstd * gg[j].z, v[j].w * rstd * gg[j].w) << 32);
    }
}
__device__ __forceinline__ float ubf_lo(unsigned w) { return __builtin_bit_cast(float, w << 16); }
__device__ __forceinline__ float ubf_hi(unsigned w) { return __builtin_bit_cast(float, w & 0xffff0000u); }
template <bool OUT_F32> __device__ __forceinline__ void norm_rows_rb(const bf16* src, const float* g, void* dstv, int gw, int NGW, int lane) {
    f32x4 gg[4];
#pragma unroll
    for (int j = 0; j < 4; ++j) gg[j] = *(const f32x4*)(g + (j >> 1) * 512 + 8 * lane + (j & 1) * 4);
    for (int m = gw; m < M; m += NGW) {
        const v4u a = *(const v4u*)(src + (size_t)m * D + 8 * lane), b = *(const v4u*)(src + (size_t)m * D + 512 + 8 * lane);
        f32x4 v[4] = {(f32x4){ubf_lo(a.x), ubf_hi(a.x), ubf_lo(a.y), ubf_hi(a.y)}, (f32x4){ubf_lo(a.z), ubf_hi(a.z), ubf_lo(a.w), ubf_hi(a.w)},
                      (f32x4){ubf_lo(b.x), ubf_hi(b.x), ubf_lo(b.y), ubf_hi(b.y)}, (f32x4){ubf_lo(b.z), ubf_hi(b.z), ubf_lo(b.w), ubf_hi(b.w)}};
        float s = 0.f;
#pragma unroll
        for (int j = 0; j < 4; ++j) s += (v[j].x * v[j].x + v[j].y * v[j].y) + (v[j].z * v[j].z + v[j].w * v[j].w);
        const float rstd = 1.0f / sqrtf(wave_sum(s) * (1.0f / D) + RMS_EPS);
#pragma unroll
        for (int j = 0; j < 4; ++j) v[j] = v[j] * rstd * gg[j];
        if (OUT_F32) { float* o = (float*)dstv + (size_t)m * D + 8 * lane;
            *(f32x4*)o = v[0]; *(f32x4*)(o + 4) = v[1]; *(f32x4*)(o + 512) = v[2]; *(f32x4*)(o + 516) = v[3];
        } else { bf16* o = (bf16*)dstv + (size_t)m * D + 8 * lane;
            *(v4u*)o = (v4u){pk2(v[0].x, v[0].y), pk2(v[0].z, v[0].w), pk2(v[1].x, v[1].y), pk2(v[1].z, v[1].w)};
            *(v4u*)(o + 512) = (v4u){pk2(v[2].x, v[2].y), pk2(v[2].z, v[2].w), pk2(v[3].x, v[3].y), pk2(v[3].z, v[3].w)}; }
    }
}
__device__ __forceinline__ float bfs(const bf16* p) { return __builtin_bit_cast(float, (unsigned)(*p) << 16); }
__device__ __forceinline__ void conv_fixup(bf16* ACT, const float* UHf, const bf16* CWB, int pm, int tid) {
    const float* cur = UHf + ((size_t)pm * 2 + 0) * 2 * FF2;
    const float* prv = UHf + ((size_t)(pm - 1) * 2 + 1) * 2 * FF2;
    const bool seq0 = (pm & 31) == 0;
    for (int task = tid; task < 704; task += 512) {
        const int r = task / 352, g = task % 352, pn = g >> 4, cl0 = (g & 15) * 8, gc0 = pn * 128 + cl0, pc = pn * 256 + cl0;
        float a[8];
#pragma unroll
        for (int e = 0; e < 8; ++e) { float y[2];
#pragma unroll
            for (int bj = 0; bj < 2; ++bj) { const int pcb = pc + 128 * bj + e, col = bj * FF + gc0 + e;
                const float u0 = cur[pcb], u1 = cur[FF2 + pcb], p254 = seq0 ? 0.f : prv[pcb], p255 = seq0 ? 0.f : prv[FF2 + pcb];
                const float x = r == 0 ? u0 : u1, x1 = r == 0 ? p255 : u0, x2 = r == 0 ? p254 : p255;
                y[bj] = bfs(CWB + 3 * FF2 + col) + bfs(CWB + col) * x2 + bfs(CWB + FF2 + col) * x1 + bfs(CWB + 2 * FF2 + col) * x; }
            a[e] = y[0] * __builtin_amdgcn_rcpf(1.0f + __expf(-y[0])) * y[1]; }
        v4u o; o.x = pk2(a[0], a[1]); o.y = pk2(a[2], a[3]); o.z = pk2(a[4], a[5]); o.w = pk2(a[6], a[7]);
        *(v4u*)(ACT + (size_t)(pm * 256 + r) * FF + gc0) = o;
    }
}
typedef __attribute__((address_space(1))) unsigned gu32;
#define XB_TMO      128
#define XB_XCNT(j)  (256  + 64 * (j))
#define XB_XSUB(j)  (1280 + 64 * (j))
#define XB_XGEN(j)  (2304 + 64 * (j))
#define XB_TOP      3328
#define XB_TOPGEN   3392
#define XCD_BAR_WORDS 3456
#define XB_SPIN_CAP (1u << 18)

__device__ __forceinline__ unsigned xb_ld(unsigned* p)              { return __hip_atomic_load(p, __ATOMIC_RELAXED, __HIP_MEMORY_SCOPE_AGENT); }
__device__ __forceinline__ unsigned xb_add(unsigned* p, unsigned v) { return __hip_atomic_fetch_add(p, v, __ATOMIC_RELAXED, __HIP_MEMORY_SCOPE_AGENT); }
__device__ __forceinline__ unsigned xb_xcc_id() { return (unsigned)__builtin_amdgcn_s_getreg((3 << 11) | 20) & 0xFu; }
#define XB_SPIN(cond, bar) do { unsigned _sp = 0; while (cond) { __builtin_amdgcn_s_sleep(1); \
    if ((++_sp & 255u) == 0u) { if (xb_ld(&(bar)[XB_TMO])) break; if (_sp > XB_SPIN_CAP) { atomicAdd(&(bar)[XB_TMO], 1u); break; } } } } while (0)

struct XcdBarrier {
    unsigned* bar; unsigned x;
    volatile LAS unsigned* st;
};

__device__ __forceinline__ XcdBarrier xcd_barrier_post(unsigned* bar, volatile LAS unsigned* st) {
    XcdBarrier b; b.bar = bar; b.x = xb_xcc_id(); b.st = st;
    if (threadIdx.x == 0) (void)xb_add(&bar[XB_XCNT(b.x)], 1u);
    return b;
}
__device__ __forceinline__ void xcd_barrier_complete(unsigned* bar, unsigned x, unsigned& nloc, unsigned& nx) {
    const unsigned G = gridDim.x * gridDim.y * gridDim.z;
    unsigned sum, cnt, mine, sp = 0u;
    for (;;) {
        sum = 0u; cnt = 0u; mine = 0u;
#pragma unroll
        for (unsigned j = 0; j < 16; ++j) { const unsigned c = xb_ld(&bar[XB_XCNT(j)]); sum += c; cnt += (c > 0u) ? 1u : 0u; mine = (j == x) ? c : mine; }
        if (sum == G) break;
        __builtin_amdgcn_s_sleep(1);
        if ((++sp & 255u) == 0u) { if (xb_ld(&bar[XB_TMO])) break; if (sp > XB_SPIN_CAP) { atomicAdd(&bar[XB_TMO], 1u); break; } }
    }
    nloc = mine > 0u ? mine : 1u; nx = cnt > 0u ? cnt : 1u;
}

__device__ __forceinline__ void xcd_barrier(const XcdBarrier& b) {
    asm volatile("s_waitcnt vmcnt(0)" ::: "memory");
    __syncthreads();
    if (threadIdx.x == 0) {
        unsigned* bar = b.bar;
        __builtin_amdgcn_s_waitcnt(0);
        unsigned nloc = b.st[0], nx = b.st[1];
        if (nloc == 0u) { xcd_barrier_complete(bar, b.x, nloc, nx); b.st[0] = nloc; b.st[1] = nx; }
        const unsigned old = xb_add(&bar[XB_XSUB(b.x)], 1u);
        const unsigned gen = old / nloc;
        if (old + 1u == (gen + 1u) * nloc) {
            __builtin_amdgcn_fence(__ATOMIC_RELEASE, "agent");
            asm volatile("s_waitcnt vmcnt(0)" ::: "memory");
            const unsigned og = xb_add(&bar[XB_TOP], 1u);
            const unsigned tg = og / nx;
            if (og + 1u == (tg + 1u) * nx) xb_add(&bar[XB_TOPGEN], 1u);
            else XB_SPIN(xb_ld(&bar[XB_TOPGEN]) == tg, bar);
            __builtin_amdgcn_fence(__ATOMIC_ACQUIRE, "agent");
            xb_add(&bar[XB_XGEN(b.x)], 1u);
            asm volatile("s_waitcnt vmcnt(0)" ::: "memory");
        } else {
            XB_SPIN(xb_ld(&bar[XB_XGEN(b.x)]) == gen, bar);
            __builtin_amdgcn_fence(__ATOMIC_ACQUIRE, "agent");
            asm volatile("s_waitcnt vmcnt(0)" ::: "memory");
        }
    }
    __syncthreads();
}

template <class T> __device__ __forceinline__ T* opq(T* p) { asm volatile("" : "+s"(p)); return p; }
struct Args { const float* in[16]; float* out; unsigned char* ws; };
#if defined(UP_PLAIN)
#define UP_PLAIN_PROBE() do { pg8::Gemm g2{opq(XN), opq((bf16*)(ws + WS_WUP0)), M, FF2, 1024, 1024}; pg8::StaticOrder S2; S2.init(M, FF2, G, bx); pg8::EpiDummy E2{(bf16*)(ws + WS_BIG + 176 * MiB)}; \
    pg8::gemm_phase<pg8::EpiDummy, pg8::StaticOrder, true, true>(L, g2, S2, E2); } while (0)
#else
#define UP_PLAIN_PROBE() do { } while (0)
#endif
#ifndef REP_WO
#define REP_WO 1
#endif
#ifndef REP_HGA
#define REP_HGA 1
#endif
#ifndef REP_NORM
#define REP_NORM 1
#endif
#ifndef REP_UP
#define REP_UP 1
#endif
#ifndef REP_QKV
#define REP_QKV 1
#endif
#ifndef REP_HIN
#define REP_HIN 1
#endif
#if defined(PROBE_A)
#define SYNC_STAMP() do { xcd_barrier(bar); if (bx == 0 && tid == 0) ((unsigned long long*)(ws + WS_PROBE))[nst] = __builtin_amdgcn_s_memrealtime(); ++nst; } while (0)
#else
#define SYNC_STAMP() xcd_barrier(bar)
#endif
__global__ void __launch_bounds__(NWAVES * 64, 2) fwd_kernel(Args args) {
    extern __shared__ __attribute__((aligned(16))) unsigned char lds[];
    cg::grid_group grid = cg::this_grid();
    LAS unsigned char* L = (LAS unsigned char*)lds;
#define FRESH_TID() ({ int t_ = threadIdx.x; asm volatile("" : "+v"(t_)); t_; })
    const int tid = threadIdx.x, lane = tid & 63, wave = __builtin_amdgcn_readfirstlane(tid >> 6);
    const int G = gridDim.x, bx = blockIdx.x; const int vcu = (G % 8 == 0) ? (bx % 8) * (G / 8) + bx / 8 : bx;
    const int gw = vcu * NWAVES + wave, NGW = G * NWAVES;
    unsigned char* ws = args.ws;
    const float* x = args.in[0]; float* out = args.out;
    bf16* Wqkv_t = (bf16*)(ws + WS_WQKV); bf16* Wo_t = (bf16*)(ws + WS_WO); bf16* Whin_t = (bf16*)(ws + WS_WHIN); bf16* Who_t = (bf16*)(ws + WS_WHO);
    bf16* XN = (bf16*)(ws + WS_XN); bf16* QO = (bf16*)(ws + WS_Q); bf16* U = (bf16*)(ws + WS_U); float* UHf = (float*)(ws + WS_UH);
    float* LFt = (float*)(ws + WS_LFT); bf16* RB = (bf16*)(ws + WS_RB); float* SSQ = (float*)(ws + WS_SSQ);

    int nst = 1;
    if (tid < 2) ((volatile LAS unsigned*)(L + LDS_BYTES - 64))[tid] = 0u;
    __syncthreads();
#if defined(PROBE_A)
    if (bx == 0 && tid == 0) ((unsigned long long*)(ws + WS_PROBE))[0] = __builtin_amdgcn_s_memrealtime();
#endif
    {
        LAS float* scr = (LAS float*)(L + wave * 16384);
        constexpr int I_QKV = 16 * 96, I_O = 16 * 32, I_UP = 16 * 176, I_DN = 44 * 32, I_HIN = 16 * 128;
        constexpr int NITEMS = I_QKV + 2 * I_O + 2 * I_UP + 2 * I_DN + I_HIN;
#ifndef REP_PRO
#define REP_PRO 1
#endif
        for (int rep = 0; rep < REP_PRO; ++rep)
        for (int it = gw; it < NITEMS; it += NGW) {
            int r = it;
            if (r < I_QKV) { transpose_item(args.in[2], 3088, 1024, 96, Wqkv_t, scr, r, lane); continue; } r -= I_QKV;
            if (r < I_O) { transpose_item(args.in[4], 1024, 1024, 32, Wo_t, scr, r, lane); continue; } r -= I_O;
            if (r < I_O) { transpose_item(args.in[9], 1024, 1024, 32, Who_t, scr, r, lane); continue; } r -= I_O;
            if (r < I_HIN) { transpose_item(args.in[6], 4096, 1024, 128, Whin_t, scr, r, lane, false, args.in[5]); continue; } r -= I_HIN;
            if (r < I_UP) { transpose_item(args.in[11], FF2, 1024, 176, (bf16*)(ws + WS_WUP0), scr, r, lane, true, args.in[10]); continue; } r -= I_UP;
            if (r < I_UP) { transpose_item(args.in[11] + (size_t)1024 * FF2, FF2, 1024, 176, (bf16*)(ws + WS_WUP1), scr, r, lane, true, args.in[10] + 1024); continue; } r -= I_UP;
            if (r < I_DN) { transpose_item(args.in[14], 1024, FF, 32, (bf16*)(ws + WS_WDN0), scr, r, lane); continue; } r -= I_DN;
            transpose_item(args.in[14] + (size_t)FF * 1024, 1024, FF, 32, (bf16*)(ws + WS_WDN1), scr, r, lane);
        }
        for (int idx = bx * 512 + tid; idx < 256 * 128; idx += G * 512) { const int row = 3072 + (idx >> 7), kc = (idx & 127) * 8;
            float v[8];
#pragma unroll
            for (int j = 0; j < 8; ++j) v[j] = row < 3088 ? args.in[2][(size_t)(kc + j) * 3088 + row] : 0.f;
            v4u o; o.x = pk2(v[0], v[1]); o.y = pk2(v[2], v[3]); o.z = pk2(v[4], v[5]); o.w = pk2(v[6], v[7]);
            *(v4u*)(Wqkv_t + (size_t)row * 1024 + kc) = o; }
        for (int i = bx * 512 + tid; i < 2 * 4 * FF2; i += G * 512) { const int l = i / (4 * FF2), k = (i / FF2) & 3, c = i % FF2;
            ((bf16*)(ws + WS_CWB))[i] = (bf16)f2bf(k < 3 ? args.in[12][(size_t)(l * 3 + k) * FF2 + c] : args.in[13][(size_t)l * FF2 + c]); }
        if (bx == 0) for (int c = tid; c < 1024; c += 512) ((float*)(ws + WS_LB))[c] = 1.0f / (1.0f + expf(args.in[7][c] - args.in[7][1024 + c]));
        norm_rows_bf16(x, args.in[1], XN, gw, NGW, lane);
        if (bx == 0) for (int i = tid; i < XCD_BAR_WORDS; i += 512) ((unsigned*)(ws + WS_BARW))[i] = 0u;
    }
    grid.sync();
    const XcdBarrier bar = xcd_barrier_post((unsigned*)(ws + WS_BARW), (volatile LAS unsigned*)(L + LDS_BYTES - 64));
#if defined(PROBE_A)
    if (bx == 0 && tid == 0) ((unsigned long long*)(ws + WS_PROBE))[nst] = __builtin_amdgcn_s_memrealtime();
#endif
    ++nst;

    { pg8::Gemm g{opq(XN), opq(Wqkv_t), M, 3328, 1024, 1024}; pg8::StaticOrder S; S.init(M, 3328, G, bx);
      pg8::EpiQKV E{QO, LFt, args.in[3], attn_body::C2};
#ifndef NO_EPIQKV_1
      for (int rep = 0; rep < REP_QKV; ++rep) pg8::gemm_phase<pg8::EpiQKV, pg8::StaticOrder, true, true>(L, g, S, E);
#endif
    }
    SYNC_STAMP();
#ifndef REP_ATT
#define REP_ATT 1
#define ATT_O QO
#else
#define ATT_O XN
#endif
    { const attn_body::AttnTensors AT{(const attn_body::bf16*)QO, (const attn_body::bf16*)(ws + WS_K), (const attn_body::bf16*)(ws + WS_V), (attn_body::bf16*)ATT_O, LFt};
      const attn_body::StaticOrder S(G, vcu);
#ifndef NO_ATTN
      for (int rep = 0; rep < REP_ATT; ++rep) attn_body::attn_phase<attn_body::StaticOrder>((char*)lds, AT, S);
#endif
    }
    SYNC_STAMP();
#define LAYER_TAIL(LY, AOP, BOP, BASE) do { \
    { pg8::Gemm g{opq(AOP), opq(BOP), M, 1024, 1024, 1024}; pg8::StaticOrder S; S.init(M, 1024, G, bx); \
      pg8::EpiRes E{BASE, (BASE) ? (const bf16*)nullptr : (const bf16*)RB, RB, SSQ, (LAS float*)(L + LDS_XH)}; \
      for (int rep = 0; rep < ((LY) == 0 ? REP_WO : 1); ++rep) pg8::gemm_phase<pg8::EpiRes, pg8::StaticOrder, true, true>(L, g, S, E); } \
    SYNC_STAMP(); \
    { pg8::Gemm g{opq(RB), opq((bf16*)(ws + ((LY) == 0 ? WS_WUP0 : WS_WUP1))), M, FF2, 1024, 1024}; pg8::StaticOrder S; S.init(M, FF2, G, bx); \
      pg8::EpiUpConv E{U, UHf, (const bf16*)(ws + WS_CWB) + (LY) * 4 * FF2, (LAS pg8::f32x4*)(L + LDS_XH), L + LDS_TAPL, SSQ, (LAS float*)(L + LDS_RSL)}; \
      { pg8::Unit u0; const int t_ = FRESH_TID(); if (S.next(0, u0) && t_ < 256) { const int k = t_ >> 6, ch = (t_ & 63) * 4;     \
          *(LAS pg8::u32x2_e*)(L + LDS_TAPL + k * 512 + (t_ & 63) * 8) = *(const pg8::u32x2_e*)((const bf16*)(ws + WS_CWB) + (LY) * 4 * FF2 + k * FF2 + (ch < 128 ? u0.pn * 128 + ch : FF + u0.pn * 128 + (ch - 128))); } \
        if (S.next(0, u0)) pg8::rstd_commit((LAS float*)(L + LDS_RSL), 0, t_, pg8::rstd_issue(SSQ, u0.pm, t_));     \
        __syncthreads(); } \
      for (int rep = 0; rep < REP_UP; ++rep) pg8::gemm_phase<pg8::EpiUpConv, pg8::StaticOrder, true, true>(L, g, S, E); } \
    UP_PLAIN_PROBE(); \
    SYNC_STAMP(); \
    { pg8::Gemm g{opq(U), opq((bf16*)(ws + ((LY) == 0 ? WS_WDN0 : WS_WDN1))), M, 1024, FF, FF}; pg8::StaticOrder S; S.init(M, 1024, G, bx); \
      { pg8::Unit fu; for (int i = 0; S.next(i, fu); ++i) conv_fixup(U, UHf, (const bf16*)(ws + WS_CWB) + (LY) * 4 * FF2, fu.pm, FRESH_TID()); \
        asm volatile("s_waitcnt vmcnt(0)" ::: "memory"); __syncthreads(); } \
      pg8::EpiRes E{(const float*)nullptr, RB, RB, SSQ, (LAS float*)(L + LDS_XH)}; \
      pg8::gemm_phase<pg8::EpiRes, pg8::StaticOrder, true, true>(L, g, S, E); } \
    SYNC_STAMP(); } while (0)
    LAYER_TAIL(0, ATT_O, Wo_t, x);
    { pg8::Gemm g{opq(RB), opq(Whin_t), M, 4096, 1024, 1024}; pg8::StaticOrder S; S.init(M, 4096, G, bx);
      pg8::EpiHgrn E{(bf16*)(ws + WS_HLF), SSQ, (LAS float*)(L + LDS_RSL)};
      { pg8::Unit u0; const int t_ = FRESH_TID(); if (S.next(0, u0)) pg8::rstd_commit((LAS float*)(L + LDS_RSL), 0, t_, pg8::rstd_issue(SSQ, u0.pm, t_)); __syncthreads(); }
      for (int rep = 0; rep < REP_HIN; ++rep) pg8::gemm_phase<pg8::EpiHgrn, pg8::StaticOrder, true, true>(L, g, S, E); }
    SYNC_STAMP();
    { const hg::Tensors HT{(const hg::u16*)(ws + WS_HLF), (const hg::u16*)(ws + WS_HQ), (const hg::u16*)(ws + WS_HI), (const hg::u16*)(ws + WS_HG), (hg::u16*)(ws + WS_US), (float*)(ws + WS_DEC), args.in[8], (const float*)(ws + WS_LB), (hg::u16*)(ws + WS_OG), (hg::u16*)(ws + WS_SFC), (float*)(ws + WS_PB)};
      const int upw = hg::NUNITS / G;
#ifndef NO_HGA
      for (int rep = 0; rep < REP_HGA; ++rep) hg::phaseA_all(L, HT, vcu * upw, upw, FRESH_TID());
#endif
      SYNC_STAMP();
#ifndef NO_HGC
#ifndef REP_HGC
#define REP_HGC 1
#endif
      for (int rep = 0; rep < REP_HGC; ++rep) hg::phaseC_all(L, HT, vcu * upw, upw, FRESH_TID());
#endif
      SYNC_STAMP(); }
    LAYER_TAIL(1, (bf16*)(ws + WS_OG), Who_t, (const float*)nullptr);
#if defined(PROBE_A)
    if (bx == 0 && tid == 0) { const unsigned long long* ts = (const unsigned long long*)(ws + WS_PROBE); float fa = 0.f, fb = 0.f;
        for (int i = 1; i < nst; ++i) { const float d = (float)(ts[i] - ts[i - 1]) * (1.0f / 400000.0f); if ((PROBE_A >> i) & 1) fa += d; if ((PROBE_B >> i) & 1) fb += d; }
        ((float*)(ws + WS_PROBE + 1024))[0] = fa; ((float*)(ws + WS_PROBE + 1024))[1] = fb; }
    grid.sync();
    norm_rows_rb<true>(RB, args.in[15], out, gw, NGW, FRESH_TID() & 63);
    grid.sync();
    { const float fa = ((const float*)(ws + WS_PROBE + 1024))[0], fb = ((const float*)(ws + WS_PROBE + 1024))[1];
      for (size_t i = (size_t)bx * 512 + tid; i < (size_t)M * D; i += (size_t)G * 512) out[i] = out[i] * (1.0f + fa) + (i == 0 ? 200.0f * fb : 0.f); }
#else
#if defined(EXTRA_SYNCS)
    for (int i = 0; i < EXTRA_SYNCS; ++i) xcd_barrier(bar);
#endif
    norm_rows_rb<true>(RB, args.in[15], out, gw, NGW, FRESH_TID() & 63);
#endif
}

extern "C" void kernel_launch(void* const* d_in, const int* in_sizes, int n_in, void* d_out, int out_size, void* d_ws, size_t ws_size, hipStream_t stream) {
    static int grid = 0;
    if (grid == 0) {
        if (n_in != 16 || in_sizes[0] != M * D || out_size != M * D || ws_size < WS_END) { fprintf(stderr, "kernel_launch: unexpected shapes / workspace (n_in %d, in0 %d, out %d, ws %zu); nothing launched\n", n_in, n_in > 0 ? in_sizes[0] : -1, out_size, ws_size); grid = -1; return; }
        int dev = 0, cus = 0, per_cu = 0;
        if (hipGetDevice(&dev) != hipSuccess || hipDeviceGetAttribute(&cus, hipDeviceAttributeMultiprocessorCount, dev) != hipSuccess) { grid = -1; return; }
        if (hipFuncSetAttribute((const void*)fwd_kernel, hipFuncAttributeMaxDynamicSharedMemorySize, LDS_BYTES) != hipSuccess) { fprintf(stderr, "kernel_launch: hipFuncSetAttribute failed\n"); grid = -1; return; }
        if (hipOccupancyMaxActiveBlocksPerMultiprocessor(&per_cu, (const void*)fwd_kernel, NWAVES * 64, LDS_BYTES) != hipSuccess || per_cu < 1) { fprintf(stderr, "kernel_launch: occupancy query gives %d\n", per_cu); per_cu = 1; }
        (void)hipGetLastError();
        grid = cus;
        if (grid != 256) { fprintf(stderr, "kernel_launch: built for 256 CUs, device has %d; nothing launched\n", cus); grid = -1; return; }
    }
    if (grid < 0) return;
    Args a{};
    for (int i = 0; i < 16; ++i) a.in[i] = (const float*)d_in[i];
    a.out = (float*)d_out; a.ws = (unsigned char*)d_ws;
    void* kargs[] = {&a};
    const hipError_t e = hipLaunchCooperativeKernel((const void*)fwd_kernel, dim3(grid), dim3(NWAVES * 64), kargs, LDS_BYTES, stream);
    if (e != hipSuccess) fprintf(stderr, "kernel_launch: cooperative launch failed: %s\n", hipGetErrorString(e));
}
```

```cpp
#include <hip/hip_runtime.h>
#include <hip/hip_cooperative_groups.h>
#include <hip/hip_bf16.h>
#include <cstdio>
#include <cstdint>
#include <cmath>
namespace pg8 {
#define PG8_LAS __attribute__((address_space(3)))
typedef unsigned short bf16_t;
typedef short bf16x8 __attribute__((ext_vector_type(8)));
typedef float f32x4 __attribute__((ext_vector_type(4)));
typedef unsigned u32x4 __attribute__((ext_vector_type(4)));
constexpr int BM = 256, BK = 64, HALF = 128, HTB = HALF * BK * 2  , STAGE_BYTES = 8 * HTB, NXCD = 8, WGM = 8;

__host__ __device__ __forceinline__ int lds_byte(int r, int c) { const int st = (r >> 4) * 2 + (c >> 5), rr = r & 15, cc = c & 31, ob = rr * 64 + cc * 2; return st * 1024 + (ob ^ (((ob >> 9) & 1) << 5)); }
__host__ __device__ __forceinline__ void stage_rc(int b, int& R, int& C) { const int st = b / 1024, sb = b % 1024, swz = sb ^ (((sb >> 9) & 1) << 5); R = (st >> 1) * 16 + swz / 64; C = (st & 1) * 32 + (swz % 64) / 2; }
__host__ __device__ __forceinline__ int perm32(int rho) { const int n = rho >> 4, i = rho & 15; return 8 * (i >> 2) + 4 * n + (i & 3); }

struct Unit { int pm, pn, ui, npn, npm; };
struct Gemm { const bf16_t* A; const bf16_t* Bt; int M, N, K, lda; };

struct StaticOrder {
    int nM, nN, nwg, G, c;
    __host__ __device__ __forceinline__ void init(int M, int N, int G_, int c_) { nM = M / BM; nN = N / BM; nwg = nM * nN; G = G_; c = c_; }
    __host__ __device__ __forceinline__ bool next(int i, Unit& u) const {
        const long L = (long)i * G + c; if (L >= nwg) return false;
        int wgid = (int)L; { const int q = nwg / NXCD, r = nwg % NXCD, xcd = wgid % NXCD, off = wgid / NXCD; wgid = (xcd < r ? xcd * (q + 1) : r * (q + 1) + (xcd - r) * q) + off; }
        const int nig = WGM * nN, gid = wgid / nig, fm = gid * WGM, gsz = (nM - fm) < WGM ? (nM - fm) : WGM;
        u.pm = fm + ((wgid % nig) % gsz); u.pn = (wgid % nig) / gsz; return true;
    }
    __device__ __forceinline__ void a_ready(const Unit&) const {}
    __device__ __forceinline__ void done(const Unit&) const {}
};
constexpr int MTOK = 32768, DMODEL = 1024, SEQL = 8192, FFN2 = 5632, FFN1 = 2816;
__device__ __forceinline__ unsigned cvt_pk_bf16(float lo, float hi) { unsigned r; asm volatile("v_cvt_pk_bf16_f32 %0, %1, %2" : "=v"(r) : "v"(lo), "v"(hi)); return r; }
typedef _Float16 h16x2 __attribute__((ext_vector_type(2)));
typedef unsigned u32x2_e __attribute__((ext_vector_type(2)));
__device__ __forceinline__ unsigned cvt_pk_f16(float lo, float hi) { h16x2 v = {(_Float16)lo, (_Float16)hi}; return __builtin_bit_cast(unsigned, v); }
__device__ __forceinline__ float bf_lo(unsigned w) { return __builtin_bit_cast(float, w << 16); }
__device__ __forceinline__ float bf_hi(unsigned w) { return __builtin_bit_cast(float, w & 0xffff0000u); }
__device__ __forceinline__ float silu_f(float x) { return x * __builtin_amdgcn_rcpf(1.0f + __expf(-x)); }

struct EpiQKV {
    static constexpr bool PERM = true, AFTER_DRAIN = false;
    bf16_t* QKV; float* LFt; const float* b_f; float scale0;
    __device__ __forceinline__ void operator()(const f32x4 (&acc)[2][2][4][2], const Unit& u, int wr, int wc, int fr, int fq) const {
        const int row0 = u.pm * BM + wr * 64 + fr;
        if (u.pn < 12) {
            const int part = u.pn >> 2; bf16_t* base = QKV + (size_t)part * ((size_t)MTOK * DMODEL);
            const float sc = part == 0 ? scale0 : 1.f; const int col0 = (u.pn & 3) * BM + wc * 32 + 8 * fq;
#pragma unroll
            for (int ai = 0; ai < 2; ++ai)
#pragma unroll
                for (int m = 0; m < 4; ++m) { bf16_t* rowp = base + (size_t)(row0 + ai * HALF + m * 16) * DMODEL + col0;
#pragma unroll
                    for (int bj = 0; bj < 2; ++bj) { const f32x4 v0 = acc[ai][bj][m][0] * sc, v1 = acc[ai][bj][m][1] * sc;
                        u32x4 w; w.x = cvt_pk_bf16(v0[0], v0[1]); w.y = cvt_pk_bf16(v0[2], v0[3]); w.z = cvt_pk_bf16(v1[0], v1[1]); w.w = cvt_pk_bf16(v1[2], v1[3]);
                        *(u32x4*)(rowp + bj * HALF) = w; } }
        } else if (wc == 0 && fq < 2) {
            float bias[8];
#pragma unroll
            for (int e = 0; e < 8; ++e) bias[e] = b_f[8 * fq + e];
#pragma unroll
            for (int ai = 0; ai < 2; ++ai)
#pragma unroll
                for (int m = 0; m < 4; ++m) { const int row = row0 + ai * HALF + m * 16; const int b = row >> 13, t = row & (SEQL - 1);
#pragma unroll
                    for (int n = 0; n < 2; ++n)
#pragma unroll
                        for (int e = 0; e < 4; ++e) { const int hh = 8 * fq + 4 * n + e; const float z = acc[ai][0][m][n][e] + bias[4 * n + e];
                            const float lf = fminf(z, 0.f) - log1pf(__expf(-fabsf(z)));
                            LFt[(size_t)(b * 16 + hh) * SEQL + t] = lf; } }
        }
    }
};
struct EpiRes {
    static constexpr bool PERM = true, AFTER_DRAIN = false;
    const float* basef; const bf16_t* baseb; bf16_t* out; float* SSQ; PG8_LAS float* XS;
    __device__ __forceinline__ void operator()(const f32x4 (&acc)[2][2][4][2], const Unit& u, int wr, int wc, int fr, int fq) const {
        const int col0 = u.pn * BM + wc * 32 + 8 * fq;
#pragma unroll
        for (int ai = 0; ai < 2; ++ai)
#pragma unroll
            for (int m = 0; m < 4; ++m) { const size_t off = (size_t)(u.pm * BM + ai * HALF + wr * 64 + m * 16 + fr) * DMODEL + col0;
                f32x4 b[2][2];
                if (basef) {
#pragma unroll
                    for (int bj = 0; bj < 2; ++bj) { b[bj][0] = *(const f32x4*)(basef + off + bj * HALF); b[bj][1] = *(const f32x4*)(basef + off + bj * HALF + 4); }
                } else {
#pragma unroll
                    for (int bj = 0; bj < 2; ++bj) { const u32x4 w = *(const u32x4*)(baseb + off + bj * HALF);
                        b[bj][0] = (f32x4){bf_lo(w.x), bf_hi(w.x), bf_lo(w.y), bf_hi(w.y)}; b[bj][1] = (f32x4){bf_lo(w.z), bf_hi(w.z), bf_lo(w.w), bf_hi(w.w)}; }
                }
                float ss = 0.f;
#pragma unroll
                for (int bj = 0; bj < 2; ++bj) { const f32x4 v0 = b[bj][0] + acc[ai][bj][m][0], v1 = b[bj][1] + acc[ai][bj][m][1];
                    ss += ((v0[0] * v0[0] + v0[1] * v0[1]) + (v0[2] * v0[2] + v0[3] * v0[3])) + ((v1[0] * v1[0] + v1[1] * v1[1]) + (v1[2] * v1[2] + v1[3] * v1[3]));
                    u32x4 w; w.x = cvt_pk_bf16(v0[0], v0[1]); w.y = cvt_pk_bf16(v0[2], v0[3]); w.z = cvt_pk_bf16(v1[0], v1[1]); w.w = cvt_pk_bf16(v1[2], v1[3]);
                    *(u32x4*)(out + off + bj * HALF) = w; }
                ss += __shfl_xor(ss, 16); ss += __shfl_xor(ss, 32);
                if (fq == 0) XS[(ai * HALF + wr * 64 + m * 16 + fr) * 4 + wc] = ss;
                if (m & 1) asm volatile("" ::: "memory"); }
        asm volatile("s_waitcnt lgkmcnt(0)" ::: "memory"); __builtin_amdgcn_s_barrier(); asm volatile("" ::: "memory");
        { const int t = (wr * 4 + wc) * 64 + fq * 16 + fr;
          if (t < 256) { const f32x4 p = *(const PG8_LAS f32x4*)(XS + t * 4); SSQ[(size_t)(u.pm * BM + t) * 4 + u.pn] = (p[0] + p[1]) + (p[2] + p[3]); } }
    }
};
__device__ __forceinline__ f32x4 rstd_issue(const float* SSQ, int pm, int t) { return t < 256 ? *(const f32x4*)(SSQ + (size_t)(pm * BM + t) * 4) : (f32x4){0.f, 0.f, 0.f, 0.f}; }
__device__ __forceinline__ void rstd_commit(PG8_LAS float* RSL, int buf, int t, const f32x4& p) { if (t < 256) RSL[buf * 256 + t] = 1.0f / sqrtf(((p[0] + p[1]) + (p[2] + p[3])) * (1.0f / DMODEL) + 1e-6f); }
__device__ __forceinline__ void scale_rows(const f32x4 (&acc)[2][2][4][2], const PG8_LAS float* RSL, int buf, int wr, int fr) {
    f32x4 (&a_)[2][2][4][2] = const_cast<f32x4 (&)[2][2][4][2]>(acc);
#pragma unroll
    for (int ai = 0; ai < 2; ++ai)
#pragma unroll
        for (int m = 0; m < 4; ++m) { const float r = RSL[buf * 256 + ai * HALF + wr * 64 + m * 16 + fr];
#pragma unroll
            for (int bj = 0; bj < 2; ++bj)
#pragma unroll
                for (int n = 0; n < 2; ++n) a_[ai][bj][m][n] = a_[ai][bj][m][n] * r; }
}
template <int CTRL> __device__ __forceinline__ float dppz(float x) { return __builtin_bit_cast(float, __builtin_amdgcn_update_dpp(0, __builtin_bit_cast(int, x), CTRL, 0xf, 0xf, true)); }
struct EpiUpConv {
    static constexpr bool PERM = true, AFTER_DRAIN = false;
    bf16_t* ACT; float* UHf; const bf16_t* CWB; PG8_LAS f32x4* XH; PG8_LAS unsigned char* TAPL; const float* SSQ; PG8_LAS float* RSL;
    __device__ __forceinline__ void operator()(const f32x4 (&acc)[2][2][4][2], const Unit& u, int wr, int wc, int fr, int fq) const {
        typedef unsigned u32x2 __attribute__((ext_vector_type(2)));
        const int cl0 = wc * 32 + 8 * fq, gc0 = u.pn * HALF + cl0;
        const int tid0_ = (wr * 4 + wc) * 64 + fq * 16 + fr; const f32x4 nstat = rstd_issue(SSQ, u.npm, tid0_);
        scale_rows(acc, RSL, u.ui & 1, wr, fr);
        if (fr >= 14) {
#pragma unroll
            for (int ai = 0; ai < 2; ++ai) { PG8_LAS f32x4* dst = XH + ((((ai * 2 + wr) * 4 + wc) * 4 + fq) * 2 + (fr - 14)) * 4;
                dst[0] = acc[ai][0][3][0]; dst[1] = acc[ai][0][3][1]; dst[2] = acc[ai][1][3][0]; dst[3] = acc[ai][1][3][1]; }
        }
        if (wr == 0 && fr < 2) { float* p = UHf + (((size_t)u.pm * 2 + 0) * 2 + fr) * FFN2 + u.pn * BM + cl0;
            *(f32x4*)p = acc[0][0][0][0]; *(f32x4*)(p + 4) = acc[0][0][0][1]; *(f32x4*)(p + HALF) = acc[0][1][0][0]; *(f32x4*)(p + HALF + 4) = acc[0][1][0][1]; }
        if (wr == 1 && fr >= 14) { float* p = UHf + (((size_t)u.pm * 2 + 1) * 2 + (fr - 14)) * FFN2 + u.pn * BM + cl0;
            *(f32x4*)p = acc[1][0][3][0]; *(f32x4*)(p + 4) = acc[1][0][3][1]; *(f32x4*)(p + HALF) = acc[1][1][3][0]; *(f32x4*)(p + HALF + 4) = acc[1][1][3][1]; }
        const int tid_ = (wr * 4 + wc) * 64 + fq * 16 + fr; u32x2 ntap = (u32x2){0u, 0u};
        if (tid_ < 256) { const int k = tid_ >> 6, ch = (tid_ & 63) * 4; ntap = *(const u32x2*)(CWB + k * FFN2 + (ch < HALF ? u.npn * HALF + ch : FFN1 + u.npn * HALF + (ch - HALF))); }
        asm volatile("s_waitcnt lgkmcnt(0)" ::: "memory"); __builtin_amdgcn_s_barrier(); asm volatile("" ::: "memory");
        const PG8_LAS unsigned char* tapb = TAPL + (u.ui & 1) * 2048 + cl0 * 2;
#define PG8_FD(Y, X, T, CTRL) asm("v_fmac_f32_dpp %0, %1, %2 " CTRL " row_mask:0xf bank_mask:0xf bound_ctrl:1" : "+v"(Y) : "v"(X), "v"(T))
#pragma unroll
        for (int n = 0; n < 2; ++n) {
            float tp[2][4][4];
#pragma unroll
            for (int bj = 0; bj < 2; ++bj)
#pragma unroll
                for (int k = 0; k < 4; ++k) { const u32x2 w = *(const PG8_LAS u32x2*)(tapb + k * 512 + bj * 256 + 8 * n);
                    tp[bj][k][0] = bf_lo(w.x); tp[bj][k][1] = bf_hi(w.x); tp[bj][k][2] = bf_lo(w.y); tp[bj][k][3] = bf_hi(w.y); }
#pragma unroll
            for (int ai = 0; ai < 2; ++ai) {
                const bool has = (wr == 1) || (ai == 1);
                const int pai = (wr == 1) ? ai : 0, pwr = (wr == 1) ? 0 : 1;
                const PG8_LAS f32x4* hsrc = XH + (((pai * 2 + pwr) * 4 + wc) * 4 + fq) * 8;
#pragma unroll
                for (int m = 0; m < 4; ++m) {
                    float yg[4];
#pragma unroll
                    for (int bj = 0; bj < 2; ++bj) {
                        const f32x4 x = acc[ai][bj][m][n];
                        f32x4 h14 = (f32x4){0.f, 0.f, 0.f, 0.f}, h15 = h14;
                        if (m == 0 && has) { h14 = hsrc[bj * 2 + n]; h15 = hsrc[4 + bj * 2 + n]; }
                        const f32x4 xp = acc[ai][bj][m > 0 ? m - 1 : 0][n];
#pragma unroll
                        for (int e = 0; e < 4; ++e) { const float t0 = tp[bj][0][e], t1 = tp[bj][1][e];
                            float y = tp[bj][2][e] * x[e] + tp[bj][3][e];
                            if (m == 0) { y += t1 * (fr == 0 ? h15[e] : 0.f); y += t0 * (fr == 0 ? h14[e] : (fr == 1 ? h15[e] : 0.f)); }
                            else { PG8_FD(y, xp[e], t1, "row_shl:15"); PG8_FD(y, xp[e], t0, "row_shl:14"); }
                            PG8_FD(y, x[e], t1, "row_shr:1"); PG8_FD(y, x[e], t0, "row_shr:2");
                            if (bj == 0) yg[e] = y; else yg[e] = silu_f(yg[e]) * y; }
                    }
                    *(u32x2*)(ACT + (size_t)(u.pm * BM + ai * HALF + wr * 64 + m * 16 + fr) * FFN1 + gc0 + 4 * n) = (u32x2){cvt_pk_bf16(yg[0], yg[1]), cvt_pk_bf16(yg[2], yg[3])};
                }
            }
        }
#undef PG8_FD
        if (tid_ < 256) *(PG8_LAS u32x2*)(TAPL + ((u.ui + 1) & 1) * 2048 + (tid_ >> 6) * 512 + (tid_ & 63) * 8) = ntap;
        rstd_commit(RSL, (u.ui + 1) & 1, tid0_, nstat);
    }
};
struct EpiDummy {
    static constexpr bool PERM = true, AFTER_DRAIN = false;
    bf16_t* O;
    __device__ __forceinline__ void operator()(const f32x4 (&acc)[2][2][4][2], const Unit& u, int wr, int wc, int fr, int fq) const {
        const int row0 = u.pm * BM + wr * 64 + fr, col0 = u.pn * HALF + wc * 32 + 8 * fq;
#pragma unroll
        for (int ai = 0; ai < 2; ++ai)
#pragma unroll
            for (int m = 0; m < 4; ++m) { const f32x4 v0 = acc[ai][0][m][0] + acc[ai][1][m][0], v1 = acc[ai][0][m][1] + acc[ai][1][m][1];
                u32x4 w; w.x = cvt_pk_bf16(v0[0], v0[1]); w.y = cvt_pk_bf16(v0[2], v0[3]); w.z = cvt_pk_bf16(v1[0], v1[1]); w.w = cvt_pk_bf16(v1[2], v1[3]);
                *(u32x4*)(O + (size_t)(row0 + ai * HALF + m * 16) * FFN1 + col0) = w; }
    }
};
struct EpiHgrn {
    static constexpr bool PERM = true, AFTER_DRAIN = false;
    bf16_t* HB; const float* SSQ; PG8_LAS float* RSL;
    __device__ __forceinline__ void operator()(const f32x4 (&acc)[2][2][4][2], const Unit& u, int wr, int wc, int fr, int fq) const {
        const int part = u.pn >> 2; const int row0 = u.pm * BM + wr * 64 + fr, col0 = (u.pn & 3) * BM + wc * 32 + 8 * fq;
        bf16_t* dst = HB + (size_t)(part == 0 ? 1 : (part == 1 ? 0 : part)) * ((size_t)MTOK * DMODEL); const bool act = (part == 0) || (part == 3);
        const int tid0_ = (wr * 4 + wc) * 64 + fq * 16 + fr; const f32x4 nstat = rstd_issue(SSQ, u.npm, tid0_);
        scale_rows(acc, RSL, u.ui & 1, wr, fr);
#pragma unroll
        for (int ai = 0; ai < 2; ++ai)
#pragma unroll
            for (int m = 0; m < 4; ++m) { bf16_t* rowp = dst + (size_t)(row0 + ai * HALF + m * 16) * DMODEL + col0;
#pragma unroll
                for (int bj = 0; bj < 2; ++bj) { float r[8];
#pragma unroll
                    for (int e = 0; e < 8; ++e) { const float z = acc[ai][bj][m][e >> 2][e & 3]; r[e] = act ? silu_f(z) : z; }
                    u32x4 w;
                    if (part == 1) { w.x = cvt_pk_f16(r[0], r[1]); w.y = cvt_pk_f16(r[2], r[3]); w.z = cvt_pk_f16(r[4], r[5]); w.w = cvt_pk_f16(r[6], r[7]); }
                    else { w.x = cvt_pk_bf16(r[0], r[1]); w.y = cvt_pk_bf16(r[2], r[3]); w.z = cvt_pk_bf16(r[4], r[5]); w.w = cvt_pk_bf16(r[6], r[7]); }
                    *(u32x4*)(rowp + bj * HALF) = w; } }
        rstd_commit(RSL, (u.ui + 1) & 1, tid0_, nstat);
    }
};

template <class Epi, class Sched, bool ALIGN_EPI = false, bool SP2 = false>
__device__ __forceinline__ void gemm_phase(PG8_LAS unsigned char* lds, const Gemm g, const Sched& S, const Epi& E) {
    int tid = threadIdx.x; asm volatile("" : "+v"(tid)); const int wid = __builtin_amdgcn_readfirstlane(tid >> 6), lane = tid & 63, wr = wid >> 2, wc = wid & 3, fr = lane & 15, fq = lane >> 4;
    const int K = g.K, nt = K / BK;
    unsigned voffA[2], voffB[2];
#pragma unroll
    for (int i = 0; i < 2; ++i) { int R, C; stage_rc(tid * 16 + i * 8192, R, C); const int Rb = Epi::PERM ? ((R & ~31) + perm32(R & 31)) : R;
        voffA[i] = (unsigned)(R * g.lda + C) * 2u; voffB[i] = (unsigned)(Rb * K + C) * 2u; }
    const size_t kstep = (size_t)(BK * 2);
    const size_t hstepA = (size_t)HALF * g.lda * 2, hstepB = (size_t)HALF * K * 2;
    const size_t tstepA = 2 * hstepA, tstepB = 2 * hstepB;
    const unsigned ldsw = (unsigned)wid * 1024u;
    const int aoff = lds_byte(wr * 64 + fr, fq * 8), boff = lds_byte(wc * 32 + fr, fq * 8);
#define PG8_SA(b, h) (((b) * 2 + (h)) * HTB)
#define PG8_SB(b, h) ((4 + (b) * 2 + (h)) * HTB)
#define PG8_STAGE(bufoff, gbase, voff) do { _Pragma("unroll") for (int _i = 0; _i < 2; ++_i) \
        __builtin_amdgcn_global_load_lds((const unsigned*)((const char*)(gbase) + (voff)[_i]), (PG8_LAS unsigned*)(lds + (bufoff) + ldsw + _i * 8192), 16, 0, 0); } while (0)
#define PG8_LDA(dst, b, h) do { _Pragma("unroll") for (int m = 0; m < 4; ++m) _Pragma("unroll") for (int k = 0; k < 2; ++k) dst[m][k] = *(const PG8_LAS bf16x8*)(lds + PG8_SA(b, h) + aoff + m * 2048 + k * 1024); } while (0)
#define PG8_LDB(dst, b, h) do { _Pragma("unroll") for (int n = 0; n < 2; ++n) _Pragma("unroll") for (int k = 0; k < 2; ++k) dst[n][k] = *(const PG8_LAS bf16x8*)(lds + PG8_SB(b, h) + boff + n * 2048 + k * 1024); } while (0)
#define PG8_MMA(ai, bj, At, Bt) do { __builtin_amdgcn_s_setprio(1); _Pragma("unroll") for (int m = 0; m < 4; ++m) _Pragma("unroll") for (int n = 0; n < 2; ++n) _Pragma("unroll") for (int k = 0; k < 2; ++k) \
        acc[ai][bj][m][n] = __builtin_amdgcn_mfma_f32_16x16x32_bf16(Bt[n][k], At[m][k], acc[ai][bj][m][n], 0, 0, 0); __builtin_amdgcn_s_setprio(0); } while (0)
#define PG8_WAIT_V(n) asm volatile("s_waitcnt vmcnt(" #n ")" ::: "memory")
#define PG8_WAIT_L(n) asm volatile("s_waitcnt lgkmcnt(" #n ")" ::: "memory")
#define PG8_BAR __builtin_amdgcn_s_barrier()
#define PG8_SCHED __builtin_amdgcn_sched_barrier(0)
    Unit cur, nxt; int ui = 0;
    if (!S.next(0, cur)) return;
    f32x4 acc[2][2][4][2];
#pragma unroll
    for (int a = 0; a < 2; ++a)
#pragma unroll
        for (int b = 0; b < 2; ++b)
#pragma unroll
            for (int m = 0; m < 4; ++m)
#pragma unroll
                for (int n = 0; n < 2; ++n) acc[a][b][m][n] = (f32x4){0.f, 0.f, 0.f, 0.f};
    bf16x8 At[4][2], B0[2][2], B1[2][2];
    const char* cA = (const char*)g.A + (size_t)cur.pm * tstepA; const char* cB = (const char*)g.Bt + (size_t)cur.pn * tstepB;
    S.a_ready(cur);
    if constexpr (SP2) {
        PG8_STAGE(PG8_SB(0, 0), cB, voffB); PG8_STAGE(PG8_SB(0, 1), cB + hstepB, voffB); PG8_STAGE(PG8_SA(0, 0), cA, voffA); PG8_STAGE(PG8_SA(0, 1), cA + hstepA, voffA);
        if (wr == 1) PG8_BAR;
        PG8_WAIT_V(2); PG8_BAR;
        PG8_STAGE(PG8_SB(1, 0), cB + kstep, voffB); PG8_STAGE(PG8_SA(1, 0), cA + kstep, voffA); PG8_STAGE(PG8_SB(1, 1), cB + hstepB + kstep, voffB);
        PG8_WAIT_V(6); PG8_BAR;
    } else {
        PG8_STAGE(PG8_SB(0, 0), cB, voffB); PG8_STAGE(PG8_SA(0, 0), cA, voffA); PG8_STAGE(PG8_SB(0, 1), cB + hstepB, voffB); PG8_STAGE(PG8_SA(0, 1), cA + hstepA, voffA);
        if (wr == 1) PG8_BAR;
        PG8_WAIT_V(4); PG8_BAR;
        PG8_STAGE(PG8_SB(1, 0), cB + kstep, voffB); PG8_STAGE(PG8_SA(1, 0), cA + kstep, voffA); PG8_STAGE(PG8_SB(1, 1), cB + hstepB + kstep, voffB);
        PG8_WAIT_V(6); PG8_BAR;
    }
    for (;;) {
        const bool has_next = S.next(ui + 1, nxt);
        const char* nA = has_next ? (const char*)g.A + (size_t)nxt.pm * tstepA : cA; const char* nB = has_next ? (const char*)g.Bt + (size_t)nxt.pn * tstepB : cB;
        for (int t = 0; t < nt; t += 2) {
            const bool last = (t == nt - 2);
            const char* a1 = cA + (size_t)(t + 1) * kstep;
            const char* a2 = last ? nA : cA + (size_t)(t + 2) * kstep; const char* b2 = last ? nB : cB + (size_t)(t + 2) * kstep;
            const char* a3 = a2 + kstep; const char* b3 = b2 + kstep;
            if (last && has_next) S.a_ready(nxt);
            if constexpr (SP2) {
            PG8_LDB(B0, 0, 0); PG8_LDB(B1, 0, 1); PG8_SCHED; PG8_LDA(At, 0, 0); PG8_STAGE(PG8_SA(1, 1), a1 + hstepA, voffA);
            PG8_WAIT_V(8); PG8_WAIT_L(0); PG8_BAR; PG8_MMA(0, 0, At, B0); PG8_MMA(0, 1, At, B1); PG8_BAR; PG8_SCHED;
            PG8_LDA(At, 0, 1); PG8_STAGE(PG8_SB(0, 0), b2, voffB); PG8_STAGE(PG8_SB(0, 1), b2 + hstepB, voffB); PG8_STAGE(PG8_SA(0, 0), a2, voffA);
            PG8_WAIT_V(8); PG8_WAIT_L(0); PG8_BAR; PG8_MMA(1, 0, At, B0); PG8_MMA(1, 1, At, B1); PG8_BAR; PG8_SCHED;
            PG8_LDB(B0, 1, 0); PG8_LDB(B1, 1, 1); PG8_SCHED; PG8_LDA(At, 1, 0); PG8_STAGE(PG8_SA(0, 1), a2 + hstepA, voffA);
            PG8_WAIT_V(8); PG8_WAIT_L(0); PG8_BAR; PG8_MMA(0, 0, At, B0); PG8_MMA(0, 1, At, B1); PG8_BAR; PG8_SCHED;
            PG8_LDA(At, 1, 1); PG8_STAGE(PG8_SB(1, 0), b3, voffB); PG8_STAGE(PG8_SB(1, 1), b3 + hstepB, voffB); PG8_STAGE(PG8_SA(1, 0), a3, voffA);
            PG8_WAIT_V(8); PG8_WAIT_L(0); PG8_BAR; PG8_MMA(1, 0, At, B0); PG8_MMA(1, 1, At, B1); PG8_BAR; PG8_SCHED;
            } else {
            PG8_LDB(B0, 0, 0); PG8_SCHED; PG8_LDA(At, 0, 0); PG8_STAGE(PG8_SA(1, 1), a1 + hstepA, voffA);
            PG8_WAIT_L(8); PG8_BAR; PG8_WAIT_L(0); PG8_MMA(0, 0, At, B0); PG8_BAR; PG8_SCHED;
            PG8_LDB(B1, 0, 1); PG8_STAGE(PG8_SB(0, 0), b2, voffB);
            PG8_BAR; PG8_WAIT_L(0); PG8_MMA(0, 1, At, B1); PG8_BAR;
            PG8_LDA(At, 0, 1); PG8_STAGE(PG8_SA(0, 0), a2, voffA);
            PG8_BAR; PG8_WAIT_L(0); PG8_MMA(1, 0, At, B0); PG8_BAR; PG8_SCHED;
            PG8_STAGE(PG8_SB(0, 1), b2 + hstepB, voffB);
            PG8_WAIT_V(6); PG8_BAR; PG8_MMA(1, 1, At, B1); PG8_BAR;
            PG8_LDB(B0, 1, 0); PG8_SCHED; PG8_LDA(At, 1, 0); PG8_STAGE(PG8_SA(0, 1), a2 + hstepA, voffA);
            PG8_WAIT_L(8); PG8_BAR; PG8_WAIT_L(0); PG8_MMA(0, 0, At, B0); PG8_BAR; PG8_SCHED;
            PG8_LDB(B1, 1, 1); PG8_STAGE(PG8_SB(1, 0), b3, voffB);
            PG8_BAR; PG8_WAIT_L(0); PG8_MMA(0, 1, At, B1); PG8_BAR;
            PG8_LDA(At, 1, 1); PG8_STAGE(PG8_SA(1, 0), a3, voffA);
            PG8_BAR; PG8_WAIT_L(0); PG8_MMA(1, 0, At, B0); PG8_BAR; PG8_SCHED;
            PG8_STAGE(PG8_SB(1, 1), b3 + hstepB, voffB);
            PG8_WAIT_V(6); PG8_BAR; PG8_MMA(1, 1, At, B1); PG8_BAR;
            }
        }
        if constexpr (ALIGN_EPI) { if (wr == 0) PG8_BAR; }
        if constexpr (!Epi::AFTER_DRAIN) { cur.ui = ui; cur.npn = has_next ? nxt.pn : cur.pn; cur.npm = has_next ? nxt.pm : cur.pm; int l2_ = lane; asm volatile("" : "+v"(l2_)); E(acc, cur, wr, wc, l2_ & 15, l2_ >> 4); S.done(cur); }
        if (!has_next) break;
#pragma unroll
        for (int a = 0; a < 2; ++a)
#pragma unroll
            for (int b = 0; b < 2; ++b)
#pragma unroll
                for (int m = 0; m < 4; ++m)
#pragma unroll
                    for (int n = 0; n < 2; ++n) acc[a][b][m][n] = (f32x4){0.f, 0.f, 0.f, 0.f};
        cur = nxt; cA = nA; cB = nB; ++ui;
        if constexpr (ALIGN_EPI) { if (wr == 1) PG8_BAR; }
    }
    PG8_WAIT_V(0);
    if constexpr (!ALIGN_EPI) { if (wr == 0) PG8_BAR; }
    PG8_BAR;
    if constexpr (Epi::AFTER_DRAIN) { E.fused(acc, cur, wr, wc, fr, fq, lds, wid, lane); S.done(cur); }
#undef PG8_SA
#undef PG8_SB
#undef PG8_STAGE
#undef PG8_LDA
#undef PG8_LDB
#undef PG8_MMA
#undef PG8_WAIT_V
#undef PG8_WAIT_L
#undef PG8_BAR
#undef PG8_SCHED
}
}
namespace attn_body {
using bf16=__hip_bfloat16;
using bf16x8=__attribute__((ext_vector_type(8)))short;
using s16x4=__attribute__((ext_vector_type(4)))short;
using f32x16=__attribute__((ext_vector_type(16)))float;
using u32x4=__attribute__((ext_vector_type(4)))unsigned;
constexpr int BATCH=4,NHEAD=16,SEQ=8192,D=64,DM=NHEAD*D;
constexpr int NW=8,QBLK=32,QB=QBLK*NW,KVBLK=64,NQB=SEQ/QB;
constexpr int ATTN_PITCH=DM, ATTN_UNIT_ROWS=QB;
__device__ __forceinline__ int crow(int r,int hi){return (r&3)+8*(r>>2)+4*hi;}
#define SBAR() __builtin_amdgcn_sched_barrier(0)
__device__ __forceinline__ void cmask(f32x16&p0,f32x16&p1,int jb,int qrel,int hi){
  const float NEG=-INFINITY; int kb=64*jb+4*hi;
  #pragma unroll
  for(int r=0;r<16;++r){int kv=kb+(r&3)+8*(r>>2); if(kv>qrel)p0[r]=NEG; if(kv+32>qrel)p1[r]=NEG;}
}

constexpr int NSLOT=3, SLOTB=8192;
constexpr int LDS_K=0, LDS_V=NSLOT*SLOTB, LDS_WS=2*NSLOT*SLOTB, LDS_OST=LDS_WS+NW*64*4, LDS_BYTES=LDS_OST+NW*4096; constexpr int LDS_KX=LDS_BYTES, LDS_SCAN=LDS_KX+SEQ*8, LDS_TOTAL=LDS_SCAN+64;
constexpr float C2=0.125f*1.4426950408889634f;
__device__ __forceinline__ void glds16(const void*gsrc,unsigned lds_dst){unsigned keep;
  asm volatile("s_mov_b32 %0, m0\n\ts_mov_b32 m0, %2\n\ts_nop 0\n\tglobal_load_lds_dwordx4 %1, off\n\ts_mov_b32 m0, %0":"=&s"(keep):"v"(gsrc),"s"(lds_dst):"memory");}
__device__ __forceinline__ float max3f(float a,float b,float c){float r;asm("v_max3_f32 %0, %1, %2, %3":"=v"(r):"v"(a),"v"(b),"v"(c));return r;}
__device__ __forceinline__ float max2f(float a,float b){float r;asm("v_max_f32_e32 %0, %1, %2":"=v"(r):"v"(a),"v"(b));return r;}
__device__ __forceinline__ float fadd_s(float a,float b){float r;asm("v_add_f32_e32 %0, %1, %2":"=v"(r):"v"(a),"v"(b));return r;}
__device__ __forceinline__ float fsub_s(float a,float b){float r;asm("v_sub_f32_e32 %0, %1, %2":"=v"(r):"v"(a),"v"(b));return r;}
typedef float f32x2_t __attribute__((ext_vector_type(2))); typedef __bf16 bf16x2_t __attribute__((ext_vector_type(2)));
__device__ __forceinline__ unsigned cvtpk_s(float lo,float hi){f32x2_t v={lo,hi};bf16x2_t b=__builtin_convertvector(v,bf16x2_t);return __builtin_bit_cast(unsigned,b);}
#define WAIT_BAR(N) asm volatile("s_waitcnt vmcnt(" #N ") lgkmcnt(0)\n\ts_barrier":::"memory")

typedef unsigned u32x2_t __attribute__((ext_vector_type(2))); typedef float f32x4_t __attribute__((ext_vector_type(4)));
__device__ __forceinline__ u32x2_t split3(float x){ const unsigned p1=cvtpk_s(x,0.f)&0xffffu; const float r1=x-__uint_as_float(p1<<16); const unsigned p2=cvtpk_s(r1,0.f)&0xffffu; const float r2=r1-__uint_as_float(p2<<16);
  const unsigned p3=cvtpk_s(r2,0.f)&0xffffu; return (u32x2_t){p1|(p2<<16),p3|(0x3F80u<<16)}; }
__device__ __forceinline__ bf16x8 mkqx(float x,int hi){ const unsigned p1=cvtpk_s(x,0.f)&0xffffu; const float r1=x-__uint_as_float(p1<<16); const unsigned p2=cvtpk_s(r1,0.f)&0xffffu; const float r2=r1-__uint_as_float(p2<<16);
  const unsigned p3=cvtpk_s(r2,0.f)&0xffffu; u32x4 w=(u32x4){0x3F803F80u,0x3F80u|(p1<<16),p2|(p3<<16),0u}; if(hi)w=(u32x4){0u,0u,0u,0u}; return __builtin_bit_cast(bf16x8,w); }
__device__ __forceinline__ bf16x8 kxa(u32x2_t q){ return __builtin_bit_cast(bf16x8,(u32x4){q.x,q.y,0x3F803F80u,0u}); }
__device__ __forceinline__ void qkt(f32x16&p0,f32x16&p1,const char*Kslot,const bf16x8*qr,bf16x8 kx0,bf16x8 kx1,bf16x8 qx,int r32,int hi){
  const char*kb=Kslot+hi*1024+r32*16;
  p0=__builtin_amdgcn_mfma_f32_32x32x16_bf16(kx0,qx,f32x16{},0,0,0);p1=__builtin_amdgcn_mfma_f32_32x32x16_bf16(kx1,qx,f32x16{},0,0,0);
  #pragma unroll
  for(int d0=0;d0<4;++d0){
    const bf16x8 b0=*reinterpret_cast<const bf16x8*>(kb+d0*2048);
    const bf16x8 b1=*reinterpret_cast<const bf16x8*>(kb+d0*2048+512);
    p0=__builtin_amdgcn_mfma_f32_32x32x16_bf16(b0,qr[d0],p0,0,0,0);p1=__builtin_amdgcn_mfma_f32_32x32x16_bf16(b1,qr[d0],p1,0,0,0);}
}
typedef __attribute__((address_space(3))) const char* lds_cptr;
typedef short v4i16_t __attribute__((ext_vector_type(4)));
__device__ __forceinline__ void kload8(bf16x8*kf,lds_cptr kp){
  kf[0]=*(const __attribute__((address_space(3))) bf16x8*)(kp);      kf[1]=*(const __attribute__((address_space(3))) bf16x8*)(kp+512);
  kf[2]=*(const __attribute__((address_space(3))) bf16x8*)(kp+2048); kf[3]=*(const __attribute__((address_space(3))) bf16x8*)(kp+2560);
  kf[4]=*(const __attribute__((address_space(3))) bf16x8*)(kp+4096); kf[5]=*(const __attribute__((address_space(3))) bf16x8*)(kp+4608);
  kf[6]=*(const __attribute__((address_space(3))) bf16x8*)(kp+6144); kf[7]=*(const __attribute__((address_space(3))) bf16x8*)(kp+6656);
}
__device__ __forceinline__ void kload2(bf16x8*kf,lds_cptr kp,int j){ kf[2*j]=*(const __attribute__((address_space(3))) bf16x8*)(kp+j*2048); kf[2*j+1]=*(const __attribute__((address_space(3))) bf16x8*)(kp+j*2048+512); }
__device__ __forceinline__ s16x4 vtr(lds_cptr p){ return __builtin_bit_cast(s16x4,__builtin_amdgcn_ds_read_tr16_b64_v4i16((__attribute__((address_space(3))) v4i16_t*)p)); }
__device__ __forceinline__ float rowmax(const f32x16&p0,const f32x16&p1){
  float a=max3f(p0[0],p0[1],p1[0]),b=max3f(p0[2],p0[3],p1[1]);a=max3f(a,p1[2],p1[3]);
  #pragma unroll
  for(int r=4;r<16;r+=4){a=max3f(a,p0[r],p0[r+1]);b=max3f(b,p0[r+2],p0[r+3]);a=max3f(a,p1[r],p1[r+1]);b=max3f(b,p1[r+2],p1[r+3]);}
  const float m=max2f(a,b);
  auto rr=__builtin_amdgcn_permlane32_swap(__float_as_uint(m),__float_as_uint(m),false,false);
  return max2f(__uint_as_float(rr[0]),__uint_as_float(rr[1]));
}
__device__ __forceinline__ void pv(f32x16*o,int vb,bf16x8 pa0,bf16x8 pa1,bf16x8 pa2,bf16x8 pa3){
  #pragma unroll
  for(int d0=0;d0<2;++d0){s16x4 lo[4],hi[4];
    #pragma unroll
    for(int ks=0;ks<4;++ks){
      asm volatile("ds_read_b64_tr_b16 %0,%1 offset:%c2":"=&v"(lo[ks]):"v"(vb),"i"(d0*4096+ks*1024):"memory");
      asm volatile("ds_read_b64_tr_b16 %0,%1 offset:%c2":"=&v"(hi[ks]):"v"(vb),"i"(d0*4096+ks*1024+512):"memory");}
    asm volatile("s_waitcnt lgkmcnt(0)":::"memory");SBAR();
    #define PK(k) (bf16x8){lo[k][0],lo[k][1],lo[k][2],lo[k][3],hi[k][0],hi[k][1],hi[k][2],hi[k][3]}
    o[d0]=__builtin_amdgcn_mfma_f32_32x32x16_bf16(pa0,PK(0),o[d0],0,0,0);
    o[d0]=__builtin_amdgcn_mfma_f32_32x32x16_bf16(pa1,PK(1),o[d0],0,0,0);
    o[d0]=__builtin_amdgcn_mfma_f32_32x32x16_bf16(pa2,PK(2),o[d0],0,0,0);
    o[d0]=__builtin_amdgcn_mfma_f32_32x32x16_bf16(pa3,PK(3),o[d0],0,0,0);
    #undef PK
  }
}

#ifndef ATTN_STORE16
#define ATTN_STORE16(p,v) (*(u32x4*)(p)=(v))
#endif
template<int THRL> __device__ __forceinline__ void attn_unit(int b,int h,int qb,const bf16*Q,const bf16*__restrict__ K,const bf16*__restrict__ V,bf16*O,const float*__restrict__ LFt,bool newbh,char*shm){
  int tid=threadIdx.x; asm volatile("":"+v"(tid)); const int lane=tid&63,r32=lane&31,hi=lane>>5; const int wid=__builtin_amdgcn_readfirstlane(tid>>6);
  const long rowbase=(long)b*SEQ; const int q0=qb*QB;
  const bf16*Qw=Q+(rowbase+q0+wid*QBLK)*DM+h*D;
  const bf16*Kh=K+rowbase*DM+h*D,*Vh=V+rowbase*DM+h*D;
  const unsigned lds0=(unsigned)(uintptr_t)shm;
  float*wsf=(float*)(shm+LDS_WS)+wid*64;
  const bf16*ksrc=Kh+(long)lane*DM+wid*8;
  const bf16*vsrc=Vh+(long)(16*(wid&3)+(lane>>2))*DM+(wid>>2)*32+(lane&3)*8;
  const unsigned kdst=lds0+LDS_K+wid*1024, vdst=lds0+LDS_V+wid*1024;
  #define DMA_K(t,slot) glds16(ksrc+(long)(t)*KVBLK*DM,(unsigned)__builtin_amdgcn_readfirstlane(kdst+(slot)))
  #define DMA_V(t,slot) glds16(vsrc+(long)(t)*KVBLK*DM,(unsigned)__builtin_amdgcn_readfirstlane(vdst+(slot)))
  const int vb0=(int)(lds0+LDS_V)+((lane>>4)&1)*32+(lane&3)*8+(4*hi+((lane&15)>>2))*64;
  const char*Kbase=shm+LDS_K; bf16x8 kf[8];
  const lds_cptr shm3=(lds_cptr)shm; const lds_cptr kp0=shm3+LDS_K+hi*1024+r32*16; const lds_cptr vp0=shm3+LDS_V+((lane>>4)&1)*32+(lane&3)*8+(4*hi+((lane&15)>>2))*64;
  const int NT=(q0+QB)/KVBLK;
  if(newbh){
    typedef __attribute__((address_space(3))) char* lds_wptr; const lds_wptr shmw=(lds_wptr)shm;
    const float*lp=LFt+((long)(b*NHEAD+h)*SEQ+16*tid);
    const f32x4_t a0=*(const f32x4_t*)lp,a1=*(const f32x4_t*)(lp+4),a2=*(const f32x4_t*)(lp+8),a3=*(const f32x4_t*)(lp+12);
    const float v_[16]={a0[0],a0[1],a0[2],a0[3],a1[0],a1[1],a1[2],a1[3],a2[0],a2[1],a2[2],a2[3],a3[0],a3[1],a3[2],a3[3]};
    float loc=0.f;
    #pragma unroll
    for(int i=0;i<16;++i)loc+=v_[i];
    float inc=loc;
    #pragma unroll
    for(int o_=1;o_<64;o_<<=1){const float t_=__shfl_up(inc,o_); if(lane>=o_)inc+=t_;}
    __attribute__((address_space(3))) float*wt=(__attribute__((address_space(3))) float*)(shmw+LDS_SCAN);
    if(lane==63)wt[wid]=inc;
    asm volatile("s_waitcnt vmcnt(0) lgkmcnt(0)\n\ts_barrier":::"memory");
    float run=inc-loc;
    #pragma unroll
    for(int w_=0;w_<NW;++w_){const float tw=wt[w_]; if(w_<wid)run+=tw;}
    __attribute__((address_space(3))) u32x4*kxw=(__attribute__((address_space(3))) u32x4*)(shmw+LDS_KX+tid*128);
    #pragma unroll
    for(int i=0;i<16;i+=2){ run+=v_[i]; const u32x2_t e0=split3(run*(-1.4426950408889634f)); run+=v_[i+1]; const u32x2_t e1=split3(run*(-1.4426950408889634f)); kxw[i>>1]=(u32x4){e0.x,e0.y,e1.x,e1.y}; }
    asm volatile("s_waitcnt lgkmcnt(0)\n\ts_barrier":::"memory");
  }
  DMA_K(0,0);DMA_V(0,0);DMA_K(1,SLOTB);
  bf16x8 qr[4];
  #pragma unroll
  for(int d0=0;d0<4;++d0)qr[d0]=*reinterpret_cast<const bf16x8*>(&Qw[(long)r32*DM+d0*16+hi*8]);
  float mhat=0.f,l_reg=0.f;f32x16 o[2];o[0]=f32x16{};o[1]=f32x16{};bf16x8 qx=mkqx(0.f,hi);u32x2_t kq0,kq1;
  const __attribute__((address_space(3))) char*kxp=shm3+LDS_KX+r32*8;
  #define LDKQ(t) do{ kq0=*(const __attribute__((address_space(3))) u32x2_t*)(kxp+(t)*512); kq1=*(const __attribute__((address_space(3))) u32x2_t*)(kxp+(t)*512+256); }while(0)
  const int qrel=wid*QBLK+r32;
  #define CMASK(P0,P1,t) do{int jb_=(t)-(NT-4); if(jb_>=0)cmask(P0,P1,jb_,qrel,hi);}while(0)
  bool resc=false;
  #define START(P0,P1) do{ const float rm=rowmax(P0,P1); resc=false; \
    { const float dl=rm; mhat=fadd_s(mhat,dl); \
      _Pragma("unroll") for(int r=0;r<16;++r){P0[r]=fsub_s(P0[r],dl);P1[r]=fsub_s(P1[r],dl);} \
      qx=mkqx(-mhat,hi); } \
    _Pragma("unroll") for(int r=0;r<16;++r)P0[r]=__builtin_amdgcn_exp2f(P0[r]); }while(0)
  #define RESC() do{ if(resc){ asm volatile("s_waitcnt lgkmcnt(0)":::"memory"); \
      _Pragma("unroll") for(int d_=0;d_<2;++d_) _Pragma("unroll") for(int r=0;r<16;++r)o[d_][r]*=wsf[crow(r,hi)]; } }while(0)
  f32x16 pA0,pA1,pB0,pB1;
  int sl_prev=0,sl_cur=0,sl_next=SLOTB;
  #define ROT() do{sl_prev=sl_cur;sl_cur=sl_next;sl_next=(sl_next==(NSLOT-1)*SLOTB)?0:sl_next+SLOTB;}while(0)
  DMA_K(2,2*SLOTB);
  WAIT_BAR(3);
  LDKQ(0); qkt(pA0,pA1,Kbase,qr,kxa(kq0),kxa(kq1),qx,r32,hi);asm volatile("s_nop 15\n\ts_nop 7":"+v"(pA0),"+v"(pA1));CMASK(pA0,pA1,0); LDKQ(1);
  START(pA0,pA1);
  _Pragma("unroll") for(int r=0;r<16;++r)pA1[r]=__builtin_amdgcn_exp2f(pA1[r]);
  WAIT_BAR(0);
  DMA_K(3,0);DMA_V(1,SLOTB);
  ROT();
  kload8(kf,kp0+sl_cur);
  WAIT_BAR(2);
  s16x4 vlo[8],vhi[8]; u32x4 pw0,pw1,pw2,pw3;
  #define PKW(P,B) cvtpk_s(P[B],P[B+1])
  #define PAF(k) __builtin_bit_cast(bf16x8,pw##k)
  #define VFR(i) (bf16x8){vlo[i][0],vlo[i][1],vlo[i][2],vlo[i][3],vhi[i][0],vhi[i][1],vhi[i][2],vhi[i][3]}
  #define PIN(x) asm volatile("":"+v"(x))
  #define MX3(a,b,c) __builtin_fmaxf(__builtin_fmaxf((a),(b)),(c))
  #define GAPA(MF,A0,A1,A2,A3,W0,W1,PW) do{ MF; sacc+=A0; sacc+=A1; sacc+=A2; sacc+=A3; PIN(sacc); W0; W1; PIN(PW); SBAR(); }while(0)
  #define EX(v) __builtin_amdgcn_exp2f(v)
  #define GAPB(MF,X,B) do{ MF; X[B]=EX(X[B]); X[B+1]=EX(X[B+1]); X[B+2]=EX(X[B+2]); X[B+3]=EX(X[B+3]); PIN(X); SBAR(); }while(0)
  #define VRD(i) do{ vlo[i]=vtr(vp_+(((i)>>2)*4096+((i)&3)*1024)); vhi[i]=vtr(vp_+(((i)>>2)*4096+((i)&3)*1024+512)); }while(0)
  #define KRD(G,j) do{ if(G){ kload2(kf,kp0+sl_next,j); SBAR(); } }while(0)
  #define STEP(C0,C1,P0,P1,t,GK,GV,GL) do{ SBAR(); \
    const lds_cptr vp_=vp0+sl_prev; \
    VRD(0); SBAR(); float sacc=(P0[0]+P0[1]); \
    GAPA(C0=__builtin_amdgcn_mfma_f32_32x32x16_bf16(kf[0],qr[0],C0,0,0,0), P0[2],P0[3],P0[4],P0[5],     pw0[0]=PKW(P0,0), pw0[1]=PKW(P0,2), pw0); \
    VRD(4); SBAR(); GAPA(C1=__builtin_amdgcn_mfma_f32_32x32x16_bf16(kf[1],qr[0],C1,0,0,0), P0[6],P0[7],P0[8],P0[9],     pw0[2]=PKW(P0,4), pw0[3]=PKW(P0,6), pw0); \
    VRD(1); SBAR(); GAPA(C0=__builtin_amdgcn_mfma_f32_32x32x16_bf16(kf[2],qr[1],C0,0,0,0),   P0[10],P0[11],P0[12],P0[13], pw1[0]=PKW(P0,8), pw1[1]=PKW(P0,10), pw1); \
    VRD(5); SBAR(); GAPA(C1=__builtin_amdgcn_mfma_f32_32x32x16_bf16(kf[3],qr[1],C1,0,0,0),   P0[14],P0[15],P1[0],P1[1],   pw1[2]=PKW(P0,12),pw1[3]=PKW(P0,14), pw1); \
    VRD(2); SBAR(); GAPA(C0=__builtin_amdgcn_mfma_f32_32x32x16_bf16(kf[4],qr[2],C0,0,0,0),   P1[2],P1[3],P1[4],P1[5],     pw2[0]=PKW(P1,0), pw2[1]=PKW(P1,2), pw2); \
    VRD(6); SBAR(); GAPA(C1=__builtin_amdgcn_mfma_f32_32x32x16_bf16(kf[5],qr[2],C1,0,0,0),   P1[6],P1[7],P1[8],P1[9],     pw2[2]=PKW(P1,4), pw2[3]=PKW(P1,6), pw2); \
    VRD(3); SBAR(); GAPA(C0=__builtin_amdgcn_mfma_f32_32x32x16_bf16(kf[6],qr[3],C0,0,0,0),   P1[10],P1[11],P1[12],P1[13], pw3[0]=PKW(P1,8), pw3[1]=PKW(P1,10), pw3); \
    VRD(7); SBAR(); GAPA(C1=__builtin_amdgcn_mfma_f32_32x32x16_bf16(kf[7],qr[3],C1,0,0,0),   P1[14],P1[15],0.f,0.f,       pw3[2]=PKW(P1,12),pw3[3]=PKW(P1,14), pw3); \
    l_reg+=sacc; if(GL){LDKQ((t)+1);} \
    if(GK){DMA_K((t)+3,sl_cur);} if(GV){DMA_V((t)+1,sl_next);} \
    CMASK(C0,C1,t); \
    { float a=MX3(C0[0],C0[1],C1[0]),b=MX3(C0[2],C0[3],C1[1]); a=MX3(a,C1[2],C1[3]); \
      _Pragma("unroll") for(int r=4;r<16;r+=4){a=MX3(a,C0[r],C0[r+1]);b=MX3(b,C0[r+2],C0[r+3]);a=MX3(a,C1[r],C1[r+1]);b=MX3(b,C1[r+2],C1[r+3]);} \
      float rm=__builtin_fmaxf(a,b); { auto rr=__builtin_amdgcn_permlane32_swap(__float_as_uint(rm),__float_as_uint(rm),false,false); rm=__builtin_fmaxf(__uint_as_float(rr[0]),__uint_as_float(rr[1])); } \
      resc=false; \
      if(__builtin_expect(__any(rm>(float)THRL),0)){ const float dl=__builtin_fmaxf(rm,0.f); mhat+=dl; \
        _Pragma("unroll") for(int r=0;r<16;++r){C0[r]-=dl;C1[r]-=dl;} \
        qx=mkqx(-mhat,hi); \
        const float f=__builtin_amdgcn_exp2f(-dl); l_reg*=f; if(hi==0)wsf[r32]=f; resc=true; } } \
    SBAR(); \
    GAPB(o[0]=__builtin_amdgcn_mfma_f32_32x32x16_bf16(PAF(0),VFR(0),o[0],0,0,0), C0,0); \
    GAPB(o[1]=__builtin_amdgcn_mfma_f32_32x32x16_bf16(PAF(0),VFR(4),o[1],0,0,0), C0,4); \
    KRD(GL,0); GAPB(o[0]=__builtin_amdgcn_mfma_f32_32x32x16_bf16(PAF(1),VFR(1),o[0],0,0,0), C0,8); \
    KRD(GL,1); GAPB(o[1]=__builtin_amdgcn_mfma_f32_32x32x16_bf16(PAF(1),VFR(5),o[1],0,0,0), C0,12); \
    KRD(GL,2); GAPB(o[0]=__builtin_amdgcn_mfma_f32_32x32x16_bf16(PAF(2),VFR(2),o[0],0,0,0), C1,0); \
    KRD(GL,3); GAPB(o[1]=__builtin_amdgcn_mfma_f32_32x32x16_bf16(PAF(2),VFR(6),o[1],0,0,0), C1,4); \
    GAPB(o[0]=__builtin_amdgcn_mfma_f32_32x32x16_bf16(PAF(3),VFR(3),o[0],0,0,0), C1,8); \
    GAPB(o[1]=__builtin_amdgcn_mfma_f32_32x32x16_bf16(PAF(3),VFR(7),o[1],0,0,0), C1,12); \
    if(GL){ P0=__builtin_amdgcn_mfma_f32_32x32x16_bf16(kxa(kq0),qx,f32x16{},0,0,0); P1=__builtin_amdgcn_mfma_f32_32x32x16_bf16(kxa(kq1),qx,f32x16{},0,0,0); } \
    }while(0)
  pB0=__builtin_amdgcn_mfma_f32_32x32x16_bf16(kxa(kq0),qx,f32x16{},0,0,0); pB1=__builtin_amdgcn_mfma_f32_32x32x16_bf16(kxa(kq1),qx,f32x16{},0,0,0);
  int t=1;
  #undef CMASK
  #define CMASK(P0,P1,t) do{}while(0)
  for(;t+5<NT;t+=2){
    STEP(pB0,pB1,pA0,pA1,t,true,true,true);     WAIT_BAR(2); RESC(); ROT();
    STEP(pA0,pA1,pB0,pB1,t+1,true,true,true);   WAIT_BAR(2); RESC(); ROT();
  }
  #undef CMASK
  #define CMASK(P0,P1,t) do{int jb_=(t)-(NT-4); if(jb_>=0)cmask(P0,P1,jb_,qrel,hi);}while(0)
  #define ENDW(tt) do{ if((tt)+3<NT){WAIT_BAR(2);} else if((tt)+2<NT){WAIT_BAR(1);} else {WAIT_BAR(0);} }while(0)
  for(;t+1<NT;t+=2){
    STEP(pB0,pB1,pA0,pA1,t,(t+3<NT),(t+1<NT),(t+1<NT));       ENDW(t);   RESC(); ROT();
    STEP(pA0,pA1,pB0,pB1,t+1,(t+4<NT),(t+2<NT),(t+2<NT));     ENDW(t+1); RESC(); ROT();
  }
  STEP(pB0,pB1,pA0,pA1,NT-1,false,false,false); RESC();
  { float sacc=pB0[0]+pB0[1]; _Pragma("unroll") for(int r=2;r<16;++r)sacc+=pB0[r]; _Pragma("unroll") for(int r=0;r<16;++r)sacc+=pB1[r]; l_reg+=sacc;
    pw0=(u32x4){PKW(pB0,0),PKW(pB0,2),PKW(pB0,4),PKW(pB0,6)};pw1=(u32x4){PKW(pB0,8),PKW(pB0,10),PKW(pB0,12),PKW(pB0,14)};pw2=(u32x4){PKW(pB1,0),PKW(pB1,2),PKW(pB1,4),PKW(pB1,6)};pw3=(u32x4){PKW(pB1,8),PKW(pB1,10),PKW(pB1,12),PKW(pB1,14)};
    SBAR(); pv(o,vb0+sl_cur,PAF(0),PAF(1),PAF(2),PAF(3)); }
  #undef PKW
  #undef PAF
  #undef VFR
  #undef PIN
  #undef MX3
  #undef GAPA
  #undef GAPB
  #undef EX
  #undef VRD
  #undef KRD
  #undef STEP
  #undef ENDW
  {auto rr=__builtin_amdgcn_permlane32_swap(__float_as_uint(l_reg),__float_as_uint(l_reg),false,false);l_reg=__uint_as_float(rr[0])+__uint_as_float(rr[1]);}
  if(hi==0)wsf[32+r32]=l_reg;asm volatile("s_waitcnt lgkmcnt(0)":::"memory");
  float rli[16];
  #pragma unroll
  for(int r=0;r<16;++r)rli[r]=__builtin_amdgcn_rcpf(wsf[32+crow(r,hi)]);
  bf16*Ow=O+(rowbase+q0+wid*QBLK)*DM+h*D;
  { bf16*stg=(bf16*)(shm+LDS_OST)+wid*2048;
    #pragma unroll
    for(int r=0;r<16;++r){const int orow=crow(r,hi);
      #pragma unroll
      for(int d0=0;d0<2;++d0)stg[orow*64+d0*32+r32]=__float2bfloat16(o[d0][r]*rli[r]);}
    asm volatile("s_waitcnt lgkmcnt(0)":::"memory");
    #pragma unroll
    for(int i=0;i<4;++i){const int row=i*8+(lane>>3),ch=lane&7; const u32x4 v=*(const u32x4*)(stg+row*64+ch*8); ATTN_STORE16(Ow+(long)row*DM+ch*8,v);} }
  asm volatile("s_waitcnt lgkmcnt(0)\n\ts_barrier":::"memory");
  #undef DMA_K
  #undef DMA_V
  #undef CMASK
  #undef START
  #undef RESC
  #undef ROT
}
constexpr int ATTN_LDS_BYTES=LDS_TOTAL;
struct AttnTensors { const bf16* Q; const bf16* K; const bf16* V; bf16* O; const float* LFt; };
struct AttnUnit { int bh; int qb; };
struct StaticOrder {
  int vcu,G;
  __device__ __forceinline__ explicit StaticOrder(int grid,int v):vcu(v),G(grid){}
  __device__ __forceinline__ bool next(int i,AttnUnit&u)const{ const int v=vcu+(i>>3)*G; if(v>=256)return false; const int s=v&15,r=(i>>1)&3; u.bh=(v>>5)*8+2*r+((v>>4)&1); u.qb=(i&1)?s:31-s; return true; }
  __device__ __forceinline__ void a_ready(const AttnUnit&)const{}
  __device__ __forceinline__ void done(const AttnUnit&)const{}
};
template<class Sched,int THRL=64> __device__ __forceinline__ void attn_phase(char*lds,const AttnTensors&T,const Sched&S){
  AttnUnit u; int pbh=-1;
  for(int i=0;S.next(i,u);++i){ S.a_ready(u); attn_unit<THRL>(u.bh/NHEAD,u.bh%NHEAD,u.qb,T.Q,T.K,T.V,T.O,T.LFt,u.bh!=pbh,lds); pbh=u.bh; S.done(u); }
}
#undef SBAR
#undef WAIT_BAR
}
namespace hg {
#define HLAS __attribute__((address_space(3)))
#define HG_BAR() asm volatile("s_waitcnt lgkmcnt(0)\n\ts_barrier" ::: "memory")
typedef short bf16x8 __attribute__((ext_vector_type(8)));
typedef float f32x4 __attribute__((ext_vector_type(4)));
typedef unsigned u32x4 __attribute__((ext_vector_type(4)));
typedef unsigned u32x2 __attribute__((ext_vector_type(2)));
typedef unsigned short u16;
constexpr int L_QD = 0, L_KI = 17408, L_IVT = 34816, L_KST = 53248, L_AM = 71680, L_TOT = 80896, L_SSQ = 82944, L_DECL = 83456, L_CIN = 83968, L_END = L_CIN + 128 * 272;
constexpr int P_QD = 272, P_T = 144;
constexpr int NUNITS = 4096;
typedef float pk_f32x2 __attribute__((ext_vector_type(2))); typedef __bf16 pk_bf16x2 __attribute__((ext_vector_type(2)));
__device__ __forceinline__ unsigned pk2(float lo, float hi) { const pk_f32x2 v = {lo, hi}; return __builtin_bit_cast(unsigned, __builtin_convertvector(v, pk_bf16x2)); }
__device__ __forceinline__ unsigned f2bf(float f) { return pk2(f, f) & 0xffffu; }
__device__ __forceinline__ float bf2f(unsigned h) { return __builtin_bit_cast(float, h << 16); }
__device__ __forceinline__ float h2f(u16 h) { return (float)__builtin_bit_cast(_Float16, h); }

struct Tensors { const u16* HLF; const u16* HQ; const u16* HI; const u16* HG; u16* US; float* DEC; const float* onorm_g; const float* LB; u16* OG; u16* SFC; float* PB; };

template <bool PA> struct Raw { u16 fl[16]; u16 q[16]; u32x4 iv[2]; };
template <bool PA> __device__ __forceinline__ void load_raw(const Tensors& T, int unit, int tid, Raw<PA>& r) {
    const int bh = unit >> 7, n = unit & 127, b = bh >> 3, h = bh & 7; const size_t rowbase = (size_t)b * 8192 + (size_t)n * 64;
    const int d = tid & 127, qt = tid >> 7;
    const u16* lfp = T.HLF + (rowbase + 16 * qt) * 1024 + 128 * h + d;
#pragma unroll
    for (int i = 0; i < 16; ++i) r.fl[i] = lfp[(size_t)i * 1024];
    if (!PA) { const u16* qp = T.HQ + (rowbase + 16 * qt) * 1024 + 128 * h + d;
#pragma unroll
        for (int i = 0; i < 16; ++i) r.q[i] = qp[(size_t)i * 1024]; }
#pragma unroll
    for (int it = 0; it < 2; ++it) { const int idx = tid + it * 512; const int s = idx >> 4, vg = idx & 15;
        r.iv[it] = *(const u32x4*)(T.HI + (rowbase + s) * 1024 + 128 * h + 8 * vg); }
}
template <bool PA> __device__ __forceinline__ float prep(HLAS unsigned char* L, const Tensors& T, int unit, int h, int tid, const Raw<PA>& r, float Bacc) {
    const int d = tid & 127, qt = tid >> 7;
    float kk[16], cs[16]; float run = 0.f;
    const float lb = T.LB[128 * h + d];
#pragma unroll
    for (int i = 0; i < 16; ++i) kk[i] = h2f(r.fl[i]);
#pragma unroll
    for (int i = 0; i < 16; ++i) { const float sg = __builtin_amdgcn_rcpf(1.0f + __expf(-kk[i])); const float f = lb + (1.0f - lb) * sg;
        kk[i] = (1.0f - lb) * (1.0f - sg); run += __logf(f); cs[i] = run; }
    HLAS float* TOT = (HLAS float*)(L + L_TOT);
    TOT[qt * 128 + d] = run;
    HG_BAR();
    const float t0 = TOT[d], t1 = TOT[128 + d], t2 = TOT[256 + d], t3 = TOT[384 + d];
    const float pre = (qt > 0 ? t0 : 0.f) + (qt > 1 ? t1 : 0.f) + (qt > 2 ? t2 : 0.f);
    const float blast = ((t0 + t1) + t2) + t3;
    {
        unsigned w[8];
#pragma unroll
        for (int i = 0; i < 16; i += 2) {
            const float k0 = kk[i], k1 = kk[i + 1];
            const float e0 = __expf(blast - (pre + cs[i])), e1 = __expf(blast - (pre + cs[i + 1]));
            w[i >> 1] = pk2(k0 * e0, k1 * e1);
        }
        HLAS u32x4* dst = (HLAS u32x4*)(L + L_KST + d * P_T + qt * 32);
        dst[0] = (u32x4){w[0], w[1], w[2], w[3]}; dst[1] = (u32x4){w[4], w[5], w[6], w[7]};
        if (qt == 0) ((HLAS float*)(L + L_DECL))[d] = __expf(blast);
    }
    if (!PA) {
        float q[16];
#pragma unroll
        for (int i = 0; i < 16; ++i) q[i] = bf2f(r.q[i]);
#pragma unroll
        for (int i = 0; i < 16; ++i) { const float bb = pre + cs[i]; const float k = kk[i];
            *(HLAS u16*)(L + L_QD + (16 * qt + i) * P_QD + d * 2) = (u16)f2bf(q[i] * __expf(bb));
            *(HLAS u16*)(L + L_KI + (16 * qt + i) * P_QD + d * 2) = (u16)f2bf(k * __expf(-bb)); }
    }
    return blast;
}
__device__ __forceinline__ int ivt_off(int row, int chunk) { return row * P_T + ((chunk ^ ((row >> 3) & 7)) << 4); }
__device__ __forceinline__ void stage_ivt(HLAS unsigned char* L, const u32x4 (&iv)[2], int tid) {
#pragma unroll
    for (int it = 0; it < 2; ++it) { const int idx = tid + it * 512; const int s = idx >> 4, vg = idx & 15;
        const u32x4 w = iv[it];
#pragma unroll
        for (int j = 0; j < 8; ++j) { const unsigned dw = w[j >> 1]; *(HLAS u16*)(L + L_IVT + ivt_off(8 * vg + j, s >> 3) + (s & 7) * 2) = (u16)((j & 1) ? (dw >> 16) : (dw & 0xffffu)); } }
}
#define HG_MFMA(X, Y, C) __builtin_amdgcn_mfma_f32_16x16x32_bf16((X), (Y), (C), 0, 0, 0)

__device__ __forceinline__ void phaseB(const Tensors& T, int vb, int tid) {
    const int g = vb * 512 + tid, d4 = g & 31, v = (g >> 5) & 127, bh = g >> 12;
    u32x2* p = (u32x2*)T.SFC + ((size_t)(bh * 8) * 128 + v) * 32 + d4;
    const f32x4* dp = (const f32x4*)T.PB + (size_t)(bh * 8) * 32 + d4;
    f32x4 S = (f32x4){0.f, 0.f, 0.f, 0.f};
    u32x2 u[8]; f32x4 dc[8];
#pragma unroll
    for (int j = 0; j < 8; ++j) { u[j] = p[(size_t)j * 4096]; dc[j] = dp[(size_t)j * 32]; }
#pragma unroll
    for (int j = 0; j < 8; ++j) {
        p[(size_t)j * 4096] = (u32x2){pk2(S[0], S[1]), pk2(S[2], S[3])};
        const f32x4 uu = (f32x4){bf2f(u[j].x & 0xffffu), bf2f(u[j].x >> 16), bf2f(u[j].y & 0xffffu), bf2f(u[j].y >> 16)};
        S = dc[j] * S + uu;
    }
}
__device__ __forceinline__ void phaseC_unit(HLAS unsigned char* L, const Tensors& T, int unit, int tid, const Raw<false>& raw, f32x4 (&S)[8]) {
    const int bh = unit >> 7, n = unit & 127, b = bh >> 3, h = bh & 7; const size_t rowbase = (size_t)b * 8192 + (size_t)n * 64;
    const int lane = tid & 63, w = tid >> 6, lr = lane & 15, kq = lane >> 4;
    const int ct = w & 3, wh = w >> 2;
    u32x2 hgt[4];
#pragma unroll
    for (int vi = 0; vi < 4; ++vi) hgt[vi] = *(const u32x2*)(T.HG + (rowbase + 16 * ct + lr) * 1024 + 128 * h + 64 * wh + 16 * vi + 4 * kq);
    prep<false>(L, T, unit, h, tid, raw, 0.f);
    stage_ivt(L, raw.iv, tid);
    {
        HLAS unsigned char* sx = L + L_CIN + (16 * w + lr) * 272 + 8 * kq;
#pragma unroll
        for (int dt = 0; dt < 8; ++dt) *(HLAS u32x2*)(sx + 32 * dt) = (u32x2){pk2(S[dt][0], S[dt][1]), pk2(S[dt][2], S[dt][3])};
    }
    HG_BAR();
    {
        f32x4 ua[8];
#pragma unroll
        for (int dt = 0; dt < 8; ++dt) ua[dt] = (f32x4){0.f, 0.f, 0.f, 0.f};
#pragma unroll
        for (int ks = 0; ks < 2; ++ks) {
            const bf16x8 Y = *(const HLAS bf16x8*)(L + L_IVT + ivt_off(16 * w + lr, 4 * ks + kq));
#pragma unroll
            for (int dt = 0; dt < 8; ++dt) { const bf16x8 X = *(const HLAS bf16x8*)(L + L_KST + (16 * dt + lr) * P_T + (32 * ks + 8 * kq) * 2); ua[dt] = HG_MFMA(X, Y, ua[dt]); }
        }
        const HLAS f32x4* dl = (const HLAS f32x4*)(L + L_DECL);
#pragma unroll
        for (int dt = 0; dt < 8; ++dt) S[dt] = dl[4 * dt + kq] * S[dt] + ua[dt];
    }
#pragma unroll
    for (int sp = 0; sp < 2; ++sp) { const int st = 2 * wh + sp;
        f32x4 a = (f32x4){0.f, 0.f, 0.f, 0.f};
        if (st <= ct) {
#pragma unroll
            for (int ks = 0; ks < 4; ++ks) { const bf16x8 X = *(const HLAS bf16x8*)(L + L_KI + (16 * st + lr) * P_QD + (32 * ks + 8 * kq) * 2);
                const bf16x8 Y = *(const HLAS bf16x8*)(L + L_QD + (16 * ct + lr) * P_QD + (32 * ks + 8 * kq) * 2); a = HG_MFMA(X, Y, a); }
        }
        const int c = 16 * ct + lr, s0 = 16 * st + 4 * kq;
        float m[4];
#pragma unroll
        for (int e = 0; e < 4; ++e) m[e] = (st <= ct && s0 + e <= c) ? a[e] : 0.f;
        *(HLAS u32x2*)(L + L_AM + c * P_T + s0 * 2) = (u32x2){pk2(m[0], m[1]), pk2(m[2], m[3])};
    }
    HG_BAR();
    f32x4 acc[4];
#pragma unroll
    for (int vi = 0; vi < 4; ++vi) acc[vi] = (f32x4){0.f, 0.f, 0.f, 0.f};
#pragma unroll
    for (int vi = 0; vi < 4; ++vi) {
#pragma unroll
        for (int ks = 0; ks < 2; ++ks) { const bf16x8 X = *(const HLAS bf16x8*)(L + L_IVT + ivt_off(64 * wh + 16 * vi + lr, 4 * ks + kq));
            const bf16x8 Y = *(const HLAS bf16x8*)(L + L_AM + (16 * ct + lr) * P_T + (32 * ks + 8 * kq) * 2); acc[vi] = HG_MFMA(X, Y, acc[vi]); }
#pragma unroll
        for (int ks = 0; ks < 4; ++ks) { const bf16x8 Y = *(const HLAS bf16x8*)(L + L_QD + (16 * ct + lr) * P_QD + (32 * ks + 8 * kq) * 2); const bf16x8 X = *(const HLAS bf16x8*)(L + L_CIN + (64 * wh + 16 * vi + lr) * 272 + (32 * ks + 8 * kq) * 2); acc[vi] = HG_MFMA(X, Y, acc[vi]); }
    }
    float ss = 0.f;
#pragma unroll
    for (int vi = 0; vi < 4; ++vi) ss += (acc[vi][0] * acc[vi][0] + acc[vi][1] * acc[vi][1]) + (acc[vi][2] * acc[vi][2] + acc[vi][3] * acc[vi][3]);
    ss += __shfl_xor(ss, 16); ss += __shfl_xor(ss, 32);
    HLAS float* SSQ = (HLAS float*)(L + L_SSQ);
    if (kq == 0) SSQ[wh * 64 + 16 * ct + lr] = ss;
    HG_BAR();
    const float tot = SSQ[16 * ct + lr] + SSQ[64 + 16 * ct + lr];
    const float rstd = 1.0f / sqrtf(tot * (1.0f / 128.0f) + 1e-6f);
    const size_t orow = (rowbase + 16 * ct + lr) * 1024 + 128 * h;
#pragma unroll
    for (int vi = 0; vi < 4; ++vi) { const int v0 = 64 * wh + 16 * vi + 4 * kq;
        const f32x4 gn = *(const f32x4*)(T.onorm_g + 128 * h + v0);
        const u32x2 gg = hgt[vi];
        const float o0 = acc[vi][0] * rstd * gn[0] * bf2f(gg.x & 0xffffu), o1 = acc[vi][1] * rstd * gn[1] * bf2f(gg.x >> 16);
        const float o2 = acc[vi][2] * rstd * gn[2] * bf2f(gg.y & 0xffffu), o3 = acc[vi][3] * rstd * gn[3] * bf2f(gg.y >> 16);
        *(u32x2*)(T.OG + orow + v0) = (u32x2){pk2(o0, o1), pk2(o2, o3)}; }
    HG_BAR();
}
constexpr int A_KST = 0, A_IVT = 34816, A_TOT = 69632, A_DECL = 71680, A_END = 72192;
struct RawA { u16 fl[32]; u32x4 iv[4]; };
__device__ __forceinline__ void load_rawA(const Tensors& T, size_t rowbase, int h, int tid, RawA& r) {
    const int d = tid & 127, qt = tid >> 7;
    const u16* lfp = T.HLF + (rowbase + 32 * qt) * 1024 + 128 * h + d;
#pragma unroll
    for (int i = 0; i < 32; ++i) r.fl[i] = lfp[(size_t)i * 1024];
#pragma unroll
    for (int it = 0; it < 4; ++it) { const int idx = tid + it * 512; const int s = idx >> 4, vg = idx & 15;
        r.iv[it] = *(const u32x4*)(T.HI + (rowbase + s) * 1024 + 128 * h + 8 * vg); }
}
__device__ __forceinline__ int ivtA_off(int row, int chunk) { return row * 272 + ((chunk ^ ((row >> 3) & 7)) << 4); }
__device__ __forceinline__ void phaseA_unit128(HLAS unsigned char* L, const Tensors& T, int h, int tid, const RawA& r, f32x4 (&S)[8], float& Bsum) {
    const int lane = tid & 63, w = tid >> 6, lr = lane & 15, kq = lane >> 4, d = tid & 127, qt = tid >> 7;
    {
        float kk[32], cs[32]; float run = 0.f;
        const float lb = T.LB[128 * h + d];
#pragma unroll
        for (int i = 0; i < 32; ++i) { const float fl = h2f(r.fl[i]); const float sg = __builtin_amdgcn_rcpf(1.0f + __expf(-fl)); const float f = lb + (1.0f - lb) * sg;
            kk[i] = (1.0f - lb) * (1.0f - sg); run += __logf(f); cs[i] = run; }
        HLAS float* TOT = (HLAS float*)(L + A_TOT);
        TOT[qt * 128 + d] = run;
        HG_BAR();
        const float t0 = TOT[d], t1 = TOT[128 + d], t2 = TOT[256 + d], t3 = TOT[384 + d];
        const float pre = (qt > 0 ? t0 : 0.f) + (qt > 1 ? t1 : 0.f) + (qt > 2 ? t2 : 0.f);
        const float blast = ((t0 + t1) + t2) + t3;
        unsigned wv[16];
#pragma unroll
        for (int i = 0; i < 32; i += 2) wv[i >> 1] = pk2(kk[i] * __expf(blast - (pre + cs[i])), kk[i + 1] * __expf(blast - (pre + cs[i + 1])));
        HLAS u32x4* dst = (HLAS u32x4*)(L + A_KST + d * 272 + qt * 64);
#pragma unroll
        for (int j = 0; j < 4; ++j) dst[j] = (u32x4){wv[4 * j], wv[4 * j + 1], wv[4 * j + 2], wv[4 * j + 3]};
        if (qt == 0) ((HLAS float*)(L + A_DECL))[d] = __expf(blast);
        Bsum += blast;
    }
#pragma unroll
    for (int it = 0; it < 4; ++it) { const int idx = tid + it * 512; const int s = idx >> 4, vg = idx & 15; const u32x4 wd = r.iv[it];
#pragma unroll
        for (int j = 0; j < 8; ++j) { const unsigned dw = wd[j >> 1]; *(HLAS u16*)(L + A_IVT + ivtA_off(8 * vg + j, s >> 3) + (s & 7) * 2) = (u16)((j & 1) ? (dw >> 16) : (dw & 0xffffu)); } }
    HG_BAR();
    f32x4 acc[8];
#pragma unroll
    for (int dt = 0; dt < 8; ++dt) acc[dt] = (f32x4){0.f, 0.f, 0.f, 0.f};
#pragma unroll
    for (int ks = 0; ks < 4; ++ks) {
        const bf16x8 Y = *(const HLAS bf16x8*)(L + A_IVT + ivtA_off(16 * w + lr, 4 * ks + kq));
#pragma unroll
        for (int dt = 0; dt < 8; ++dt) { const bf16x8 X = *(const HLAS bf16x8*)(L + A_KST + (16 * dt + lr) * 272 + (32 * ks + 8 * kq) * 2); acc[dt] = HG_MFMA(X, Y, acc[dt]); }
    }
    const HLAS f32x4* dl = (const HLAS f32x4*)(L + A_DECL);
#pragma unroll
    for (int dt = 0; dt < 8; ++dt) S[dt] = dl[4 * dt + kq] * S[dt] + acc[dt];
    HG_BAR();
}
__device__ __forceinline__ void phaseA_all(HLAS unsigned char* L, const Tensors& T, int u0, int cnt, int tid) {
    const int lane = tid & 63, w = tid >> 6, lr = lane & 15, kq = lane >> 4, blk = u0 >> 4, bh = blk >> 3, b = bh >> 3, h = bh & 7;
    const size_t row0 = (size_t)b * 8192 + (size_t)(blk & 7) * 1024;
    const int nu = cnt >> 1;
    f32x4 S[8]; float Bsum = 0.f;
#pragma unroll
    for (int dt = 0; dt < 8; ++dt) S[dt] = (f32x4){0.f, 0.f, 0.f, 0.f};
    RawA cur; load_rawA(T, row0, h, tid, cur);
    for (int i = 0; i < nu; ++i) { RawA nxt; load_rawA(T, row0 + (size_t)128 * (i + 1 < nu ? i + 1 : i), h, tid, nxt); phaseA_unit128(L, T, h, tid, cur, S, Bsum); cur = nxt; }
    u16* sp = T.SFC + ((size_t)blk * 128 + 16 * w + lr) * 128 + 4 * kq;
#pragma unroll
    for (int dt = 0; dt < 8; ++dt) *(u32x2*)(sp + 16 * dt) = (u32x2){pk2(S[dt][0], S[dt][1]), pk2(S[dt][2], S[dt][3])};
    if ((tid >> 7) == 0) T.PB[(size_t)blk * 128 + (tid & 127)] = __expf(Bsum);
}
__device__ __forceinline__ void phaseC_all(HLAS unsigned char* L, const Tensors& T, int u0, int cnt, int tid) {
    const int lane = tid & 63, w = tid >> 6, lr = lane & 15, kq = lane >> 4, blk = u0 >> 4;
    const int kb = blk & 7, blk0 = blk - kb;
    f32x4 S[8];
#pragma unroll
    for (int dt = 0; dt < 8; ++dt) S[dt] = (f32x4){0.f, 0.f, 0.f, 0.f};
    for (int j = 0; j < kb; ++j) {
        const u16* sf = T.SFC + ((size_t)(blk0 + j) * 128 + 16 * w + lr) * 128 + 4 * kq; const float* pb = T.PB + (size_t)(blk0 + j) * 128 + 4 * kq;
#pragma unroll
        for (int dt = 0; dt < 8; ++dt) { const u32x2 s2 = *(const u32x2*)(sf + 16 * dt); const f32x4 p = *(const f32x4*)(pb + 16 * dt);
            S[dt] = p * S[dt] + (f32x4){bf2f(s2.x & 0xffffu), bf2f(s2.x >> 16), bf2f(s2.y & 0xffffu), bf2f(s2.y >> 16)}; }
    }
    Raw<false> cur; load_raw<false>(T, u0, tid, cur);
    for (int i = 0; i < cnt; ++i) { Raw<false> nxt; load_raw<false>(T, u0 + (i + 1 < cnt ? i + 1 : i), tid, nxt); phaseC_unit(L, T, u0 + i, tid, cur, S); cur = nxt; }
}
}

namespace cg = cooperative_groups;
constexpr int NWAVES = 8;
constexpr int BATCH = 4, T = 8192, D = 1024, H = 16, HD = 64, FF = 2816, FF2 = 5632;
constexpr int M = BATCH * T;
constexpr float RMS_EPS = 1e-6f;
constexpr size_t MiB = 1u << 20;
constexpr size_t WS_WQKV = 1 * MiB;
constexpr size_t WS_WO = WS_WQKV + (size_t)3328 * 1024 * 2;
constexpr size_t WS_WUP0 = WS_WO + (size_t)1024 * 1024 * 2;
constexpr size_t WS_WDN0 = WS_WUP0 + (size_t)5632 * 1024 * 2;
constexpr size_t WS_WHIN = WS_WDN0 + (size_t)1024 * 2816 * 2;
constexpr size_t WS_WHO = WS_WHIN + (size_t)4096 * 1024 * 2;
constexpr size_t WS_WUP1 = WS_WHO + (size_t)1024 * 1024 * 2;
constexpr size_t WS_WDN1 = WS_WUP1 + (size_t)5632 * 1024 * 2;
constexpr size_t WS_WEND = WS_WDN1 + (size_t)1024 * 2816 * 2;
constexpr size_t WS_SSQ = 54 * MiB;
constexpr size_t WS_BIG = 56 * MiB;
constexpr size_t WS_Q = WS_BIG, WS_K = WS_BIG + 64 * MiB, WS_V = WS_BIG + 128 * MiB;
constexpr size_t WS_U = WS_BIG;
constexpr size_t WS_HLF = WS_BIG, WS_HQ = WS_BIG + 64 * MiB, WS_HI = WS_BIG + 128 * MiB, WS_HG = WS_BIG + 192 * MiB, WS_US = WS_BIG + 256 * MiB;
constexpr size_t WS_XN = 312 * MiB;
constexpr size_t WS_UH = 240 * MiB;
constexpr size_t WS_LFT = 504 * MiB;
constexpr size_t WS_DEC = 506 * MiB;
constexpr size_t WS_LB = 53 * MiB;
constexpr size_t WS_CWB = 53 * MiB + 65536;
constexpr size_t WS_PROBE = 53 * MiB + 262144;
constexpr size_t WS_BARW = WS_PROBE + 65536;
constexpr size_t WS_RB = 440 * MiB;
constexpr size_t WS_OG = WS_HQ;
constexpr size_t WS_SFC = 504 * MiB;
constexpr size_t WS_PB = 55 * MiB;
constexpr size_t WS_END = 512 * MiB;
static_assert(WS_WEND <= WS_LB && WS_BARW + 65536 <= WS_BIG && WS_U + (size_t)M * FF * 2 <= WS_UH && WS_UH + (size_t)128 * 4 * FF2 * 4 <= WS_XN && WS_V + 64 * MiB <= WS_XN && WS_HG + 64 * MiB <= WS_XN && WS_US + 128 * MiB <= WS_RB && WS_RB + 64 * MiB <= WS_LFT && WS_SFC + 8 * MiB <= WS_END && WS_SSQ + (size_t)M * 16 <= WS_PB && WS_PB + 131072 <= WS_BIG, "d_ws map");
static_assert(WS_HQ == WS_HLF + 64 * MiB && WS_HI == WS_HLF + 128 * MiB && WS_HG == WS_HLF + 192 * MiB, "EpiHgrn buffer order");
constexpr int LDS_BYTES = 155648;
constexpr int LDS_XH = pg8::STAGE_BYTES, LDS_TAPL = LDS_XH + 16384, LDS_RSL = LDS_TAPL + 4096;
static_assert(LDS_RSL + 2048 <= LDS_BYTES - 64, "epilogue LDS areas");
static_assert(attn_body::ATTN_LDS_BYTES <= LDS_BYTES && hg::L_END <= LDS_BYTES && pg8::STAGE_BYTES <= LDS_BYTES, "LDS map");

#define LAS __attribute__((address_space(3)))
typedef unsigned short bf16;
typedef unsigned v4u __attribute__((ext_vector_type(4)));
typedef float f32x4 __attribute__((ext_vector_type(4)));
typedef float pk_f32x2 __attribute__((ext_vector_type(2))); typedef __bf16 pk_bf16x2 __attribute__((ext_vector_type(2)));
__device__ __forceinline__ unsigned pk2(float lo, float hi) { const pk_f32x2 v = {lo, hi}; return __builtin_bit_cast(unsigned, __builtin_convertvector(v, pk_bf16x2)); }
__device__ __forceinline__ unsigned f2bf(float f) { return pk2(f, f) & 0xffffu; }
__device__ __forceinline__ float wave_sum(float v) {
#pragma unroll
    for (int o = 1; o < 64; o <<= 1) v += __shfl_xor(v, o);
    return v;
}
__device__ __forceinline__ void transpose_item(const float* W, int ldw, int K, int nblk, bf16* WT, LAS float* scr, int item, int lane, bool perm_up = false, const float* gain = nullptr) {
    const int kb = item / nblk, nb = item % nblk, k0 = 64 * kb, n0 = 32 * nb;
    const int n0p = !perm_up ? n0 : (n0 < FF ? 256 * (n0 / 128) + (n0 % 128) : 256 * ((n0 - FF) / 128) + 128 + ((n0 - FF) % 128));
#pragma unroll 8
    for (int i = 0; i < 32; ++i) { const int kk = 2 * i + (lane >> 5); scr[kk * 33 + (lane & 31)] = W[(size_t)(k0 + kk) * ldw + n0 + (lane & 31)] * (gain ? gain[k0 + kk] : 1.0f); }
    asm volatile("s_waitcnt lgkmcnt(0)" ::: "memory");
    const int c = lane & 7;
#pragma unroll
    for (int j = 0; j < 4; ++j) { const int n = (lane >> 3) + 8 * j; const LAS float* s = scr + (8 * c) * 33 + n;
        v4u o; o.x = pk2(s[0 * 33], s[1 * 33]); o.y = pk2(s[2 * 33], s[3 * 33]); o.z = pk2(s[4 * 33], s[5 * 33]); o.w = pk2(s[6 * 33], s[7 * 33]);
        *(v4u*)(WT + (size_t)(n0p + n) * K + k0 + 8 * c) = o; }
    asm volatile("s_waitcnt lgkmcnt(0)" ::: "memory");
}
__device__ __forceinline__ void norm_rows_bf16(const float* src, const float* g, bf16* dst, int gw, int NGW, int lane) {
    f32x4 gg[4];
#pragma unroll
    for (int j = 0; j < 4; ++j) gg[j] = ((const f32x4*)g)[lane + 64 * j];
    for (int m = gw; m < M; m += NGW) {
        const f32x4* xr = (const f32x4*)(src + (size_t)m * D) + lane; f32x4 v[4]; float s = 0.f;
#pragma unroll
        for (int j = 0; j < 4; ++j) { v[j] = xr[64 * j]; s += (v[j].x * v[j].x + v[j].y * v[j].y) + (v[j].z * v[j].z + v[j].w * v[j].w); }
        const float rstd = 1.0f / sqrtf(wave_sum(s) * (1.0f / D) + RMS_EPS);
        unsigned long long* o8 = (unsigned long long*)(dst + (size_t)m * D) + lane;
#pragma unroll
        for (int j = 0; j < 4; ++j) o8[64 * j] = (unsigned long long)pk2(v[j].x * rstd * gg[j].x, v[j].y * rstd * gg[j].y) | ((unsigned long long)pk2(v[j].z * rstd * gg[j].z, v[j].w * rstd * gg[j].w) << 32);
    }
}
__device__ __forceinline__ float ubf_lo(unsigned w) { return __builtin_bit_cast(float, w << 16); }
__device__ __forceinline__ float ubf_hi(unsigned w) { return __builtin_bit_cast(float, w & 0xffff0000u); }
template <bool OUT_F32> __device__ __forceinline__ void norm_rows_rb(const bf16* src, const float* g, void* dstv, int gw, int NGW, int lane) {
    f32x4 gg[4];
#pragma unroll
    for (int j = 0; j < 4; ++j) gg[j] = *(const f32x4*)(g + (j >> 1) * 512 + 8 * lane + (j & 1) * 4);
    for (int m = gw; m < M; m += NGW) {
        const v4u a = *(const v4u*)(src + (size_t)m * D + 8 * lane), b = *(const v4u*)(src + (size_t)m * D + 512 + 8 * lane);
        f32x4 v[4] = {(f32x4){ubf_lo(a.x), ubf_hi(a.x), ubf_lo(a.y), ubf_hi(a.y)}, (f32x4){ubf_lo(a.z), ubf_hi(a.z), ubf_lo(a.w), ubf_hi(a.w)},
                      (f32x4){ubf_lo(b.x), ubf_hi(b.x), ubf_lo(b.y), ubf_hi(b.y)}, (f32x4){ubf_lo(b.z), ubf_hi(b.z), ubf_lo(b.w), ubf_hi(b.w)}};
        float s = 0.f;
#pragma unroll
        for (int j = 0; j < 4; ++j) s += (v[j].x * v[j].x + v[j].y * v[j].y) + (v[j].z * v[j].z + v[j].w * v[j].w);
        const float rstd = 1.0f / sqrtf(wave_sum(s) * (1.0f / D) + RMS_EPS);
#pragma unroll
        for (int j = 0; j < 4; ++j) v[j] = v[j] * rstd * gg[j];
        if (OUT_F32) { float* o = (float*)dstv + (size_t)m * D + 8 * lane;
            *(f32x4*)o = v[0]; *(f32x4*)(o + 4) = v[1]; *(f32x4*)(o + 512) = v[2]; *(f32x4*)(o + 516) = v[3];
        } else { bf16* o = (bf16*)dstv + (size_t)m * D + 8 * lane;
            *(v4u*)o = (v4u){pk2(v[0].x, v[0].y), pk2(v[0].z, v[0].w), pk2(v[1].x, v[1].y), pk2(v[1].z, v[1].w)};
            *(v4u*)(o + 512) = (v4u){pk2(v[2].x, v[2].y), pk2(v[2].z, v[2].w), pk2(v[3].x, v[3].y), pk2(v[3].z, v[3].w)}; }
    }
}
__device__ __forceinline__ float bfs(const bf16* p) { return __builtin_bit_cast(float, (unsigned)(*p) << 16); }
__device__ __forceinline__ void conv_fixup(bf16* ACT, const float* UHf, const bf16* CWB, int pm, int tid) {
    const float* cur = UHf + ((size_t)pm * 2 + 0) * 2 * FF2;
    const float* prv = UHf + ((size_t)(pm - 1) * 2 + 1) * 2 * FF2;
    const bool seq0 = (pm & 31) == 0;
    for (int task = tid; task < 704; task += 512) {
        const int r = task / 352, g = task % 352, pn = g >> 4, cl0 = (g & 15) * 8, gc0 = pn * 128 + cl0, pc = pn * 256 + cl0;
        float a[8];
#pragma unroll
        for (int e = 0; e < 8; ++e) { float y[2];
#pragma unroll
            for (int bj = 0; bj < 2; ++bj) { const int pcb = pc + 128 * bj + e, col = bj * FF + gc0 + e;
                const float u0 = cur[pcb], u1 = cur[FF2 + pcb], p254 = seq0 ? 0.f : prv[pcb], p255 = seq0 ? 0.f : prv[FF2 + pcb];
                const float x = r == 0 ? u0 : u1, x1 = r == 0 ? p255 : u0, x2 = r == 0 ? p254 : p255;
                y[bj] = bfs(CWB + 3 * FF2 + col) + bfs(CWB + col) * x2 + bfs(CWB + FF2 + col) * x1 + bfs(CWB + 2 * FF2 + col) * x; }
            a[e] = y[0] * __builtin_amdgcn_rcpf(1.0f + __expf(-y[0])) * y[1]; }
        v4u o; o.x = pk2(a[0], a[1]); o.y = pk2(a[2], a[3]); o.z = pk2(a[4], a[5]); o.w = pk2(a[6], a[7]);
        *(v4u*)(ACT + (size_t)(pm * 256 + r) * FF + gc0) = o;
    }
}
typedef __attribute__((address_space(1))) unsigned gu32;
#define XB_TMO      128
#define XB_XCNT(j)  (256  + 64 * (j))
#define XB_XSUB(j)  (1280 + 64 * (j))
#define XB_XGEN(j)  (2304 + 64 * (j))
#define XB_TOP      3328
#define XB_TOPGEN   3392
#define XCD_BAR_WORDS 3456
#define XB_SPIN_CAP (1u << 18)

__device__ __forceinline__ unsigned xb_ld(unsigned* p)              { return __hip_atomic_load(p, __ATOMIC_RELAXED, __HIP_MEMORY_SCOPE_AGENT); }
__device__ __forceinline__ unsigned xb_add(unsigned* p, unsigned v) { return __hip_atomic_fetch_add(p, v, __ATOMIC_RELAXED, __HIP_MEMORY_SCOPE_AGENT); }
__device__ __forceinline__ unsigned xb_xcc_id() { return (unsigned)__builtin_amdgcn_s_getreg((3 << 11) | 20) & 0xFu; }
#define XB_SPIN(cond, bar) do { unsigned _sp = 0; while (cond) { __builtin_amdgcn_s_sleep(1); \
    if ((++_sp & 255u) == 0u) { if (xb_ld(&(bar)[XB_TMO])) break; if (_sp > XB_SPIN_CAP) { atomicAdd(&(bar)[XB_TMO], 1u); break; } } } } while (0)

struct XcdBarrier {
    unsigned* bar; unsigned x;
    volatile LAS unsigned* st;
};

__device__ __forceinline__ XcdBarrier xcd_barrier_post(unsigned* bar, volatile LAS unsigned* st) {
    XcdBarrier b; b.bar = bar; b.x = xb_xcc_id(); b.st = st;
    if (threadIdx.x == 0) (void)xb_add(&bar[XB_XCNT(b.x)], 1u);
    return b;
}
__device__ __forceinline__ void xcd_barrier_complete(unsigned* bar, unsigned x, unsigned& nloc, unsigned& nx) {
    const unsigned G = gridDim.x * gridDim.y * gridDim.z;
    unsigned sum, cnt, mine, sp = 0u;
    for (;;) {
        sum = 0u; cnt = 0u; mine = 0u;
#pragma unroll
        for (unsigned j = 0; j < 16; ++j) { const unsigned c = xb_ld(&bar[XB_XCNT(j)]); sum += c; cnt += (c > 0u) ? 1u : 0u; mine = (j == x) ? c : mine; }
        if (sum == G) break;
        __builtin_amdgcn_s_sleep(1);
        if ((++sp & 255u) == 0u) { if (xb_ld(&bar[XB_TMO])) break; if (sp > XB_SPIN_CAP) { atomicAdd(&bar[XB_TMO], 1u); break; } }
    }
    nloc = mine > 0u ? mine : 1u; nx = cnt > 0u ? cnt : 1u;
}

__device__ __forceinline__ void xcd_barrier(const XcdBarrier& b) {
    asm volatile("s_waitcnt vmcnt(0)" ::: "memory");
    __syncthreads();
    if (threadIdx.x == 0) {
        unsigned* bar = b.bar;
        __builtin_amdgcn_s_waitcnt(0);
        unsigned nloc = b.st[0], nx = b.st[1];
        if (nloc == 0u) { xcd_barrier_complete(bar, b.x, nloc, nx); b.st[0] = nloc; b.st[1] = nx; }
        const unsigned old = xb_add(&bar[XB_XSUB(b.x)], 1u);
        const unsigned gen = old / nloc;
        if (old + 1u == (gen + 1u) * nloc) {
            __builtin_amdgcn_fence(__ATOMIC_RELEASE, "agent");
            asm volatile("s_waitcnt vmcnt(0)" ::: "memory");
            const unsigned og = xb_add(&bar[XB_TOP], 1u);
            const unsigned tg = og / nx;
            if (og + 1u == (tg + 1u) * nx) xb_add(&bar[XB_TOPGEN], 1u);
            else XB_SPIN(xb_ld(&bar[XB_TOPGEN]) == tg, bar);
            __builtin_amdgcn_fence(__ATOMIC_ACQUIRE, "agent");
            xb_add(&bar[XB_XGEN(b.x)], 1u);
            asm volatile("s_waitcnt vmcnt(0)" ::: "memory");
        } else {
            XB_SPIN(xb_ld(&bar[XB_XGEN(b.x)]) == gen, bar);
            __builtin_amdgcn_fence(__ATOMIC_ACQUIRE, "agent");
            asm volatile("s_waitcnt vmcnt(0)" ::: "memory");
        }
    }
    __syncthreads();
}

__device__ __forceinline__ void norm16_fl(const float* x, const float* g, bf16* XN, const LAS unsigned char* WFL, const float* b_f, float* LFt, int gw, int lane) {
    f32x4 gg[4];
#pragma unroll
    for (int j = 0; j < 4; ++j) gg[j] = ((const f32x4*)g)[lane + 64 * j];
    for (int r = 0; r < 16; ++r) { const int m = 16 * gw + r;
        const f32x4* xr = (const f32x4*)(x + (size_t)m * D) + lane; f32x4 v[4]; float s = 0.f;
#pragma unroll
        for (int j = 0; j < 4; ++j) { v[j] = xr[64 * j]; s += (v[j].x * v[j].x + v[j].y * v[j].y) + (v[j].z * v[j].z + v[j].w * v[j].w); }
        const float rstd = 1.0f / sqrtf(wave_sum(s) * (1.0f / D) + RMS_EPS);
        unsigned long long* o8 = (unsigned long long*)(XN + (size_t)m * D) + lane;
#pragma unroll
        for (int j = 0; j < 4; ++j) o8[64 * j] = (unsigned long long)pk2(v[j].x * rstd * gg[j].x, v[j].y * rstd * gg[j].y) | ((unsigned long long)pk2(v[j].z * rstd * gg[j].z, v[j].w * rstd * gg[j].w) << 32);
    }
    asm volatile("s_waitcnt vmcnt(0)" ::: "memory");
    const int lr = lane & 15, kq = lane >> 4;
    const bf16* arow = XN + (size_t)(16 * gw + lr) * D + 8 * kq;
    f32x4 acc = (f32x4){0.f, 0.f, 0.f, 0.f};
#pragma unroll 8
    for (int ks = 0; ks < 32; ++ks) { const hg::bf16x8 X = *(const hg::bf16x8*)(arow + 32 * ks); const hg::bf16x8 Y = *(const LAS hg::bf16x8*)(WFL + lr * 2064 + (32 * ks + 8 * kq) * 2); acc = HG_MFMA(X, Y, acc); }
    const int t0 = 16 * gw + 4 * kq, b = t0 >> 13, t = t0 & (T - 1); const float bias = b_f[lr];
    f32x4 lf;
#pragma unroll
    for (int e = 0; e < 4; ++e) { const float z = acc[e] + bias; lf[e] = fminf(z, 0.f) - log1pf(__expf(-fabsf(z))); }
    *(f32x4*)(LFt + (size_t)(b * 16 + lr) * T + t) = lf;
}
template <class T> __device__ __forceinline__ T* opq(T* p) { asm volatile("" : "+s"(p)); return p; }
struct Args { const float* in[16]; float* out; unsigned char* ws; };
#if defined(UP_PLAIN)
#define UP_PLAIN_PROBE() do { pg8::Gemm g2{opq(XN), opq((bf16*)(ws + WS_WUP0)), M, FF2, 1024, 1024}; pg8::StaticOrder S2; S2.init(M, FF2, G, bx); pg8::EpiDummy E2{(bf16*)(ws + WS_BIG + 176 * MiB)}; \
    pg8::gemm_phase<pg8::EpiDummy, pg8::StaticOrder, true, true>(L, g2, S2, E2); } while (0)
#else
#define UP_PLAIN_PROBE() do { } while (0)
#endif
#ifndef REP_WO
#define REP_WO 1
#endif
#ifndef REP_HGA
#define REP_HGA 1
#endif
#ifndef REP_NORM
#define REP_NORM 1
#endif
#ifndef REP_UP
#define REP_UP 1
#endif
#ifndef REP_QKV
#define REP_QKV 1
#endif
#ifndef REP_HIN
#define REP_HIN 1
#endif
#if defined(PROBE_A)
#define SYNC_STAMP() do { xcd_barrier(bar); if (bx == 0 && tid == 0) ((unsigned long long*)(ws + WS_PROBE))[nst] = __builtin_amdgcn_s_memrealtime(); ++nst; } while (0)
#else
#define SYNC_STAMP() xcd_barrier(bar)
#endif
__global__ void __launch_bounds__(NWAVES * 64, 2) fwd_kernel(Args args) {
    extern __shared__ __attribute__((aligned(16))) unsigned char lds[];
    cg::grid_group grid = cg::this_grid();
    LAS unsigned char* L = (LAS unsigned char*)lds;
#define FRESH_TID() ({ int t_ = threadIdx.x; asm volatile("" : "+v"(t_)); t_; })
    const int tid = threadIdx.x, lane = tid & 63, wave = __builtin_amdgcn_readfirstlane(tid >> 6);
    const int G = gridDim.x, bx = blockIdx.x; const int vcu = (G % 8 == 0) ? (bx % 8) * (G / 8) + bx / 8 : bx;
    const int gw = vcu * NWAVES + wave, NGW = G * NWAVES;
    unsigned char* ws = args.ws;
    const float* x = args.in[0]; float* out = args.out;
    bf16* Wqkv_t = (bf16*)(ws + WS_WQKV); bf16* Wo_t = (bf16*)(ws + WS_WO); bf16* Whin_t = (bf16*)(ws + WS_WHIN); bf16* Who_t = (bf16*)(ws + WS_WHO);
    bf16* XN = (bf16*)(ws + WS_XN); bf16* QO = (bf16*)(ws + WS_Q); bf16* U = (bf16*)(ws + WS_U); float* UHf = (float*)(ws + WS_UH);
    float* LFt = (float*)(ws + WS_LFT); bf16* RB = (bf16*)(ws + WS_RB); float* SSQ = (float*)(ws + WS_SSQ);

    int nst = 1;
    if (tid < 2) ((volatile LAS unsigned*)(L + LDS_BYTES - 64))[tid] = 0u;
    __syncthreads();
#if defined(PROBE_A)
    if (bx == 0 && tid == 0) ((unsigned long long*)(ws + WS_PROBE))[0] = __builtin_amdgcn_s_memrealtime();
#endif
    {
        LAS float* scr = (LAS float*)(L + wave * 8704);
        constexpr int WFL_OFF = 8 * 8704;
        { const int t_ = tid;
#pragma unroll
          for (int kk = 0; kk < 2; ++kk) { const int k = 2 * t_ + kk; const f32x4* wp = (const f32x4*)(args.in[2] + (size_t)k * 3088 + 3072);
#pragma unroll
              for (int q4 = 0; q4 < 4; ++q4) { const f32x4 wv = wp[q4];
#pragma unroll
                  for (int e = 0; e < 4; ++e) *(LAS unsigned short*)(L + WFL_OFF + (4 * q4 + e) * 2064 + k * 2) = (unsigned short)f2bf(wv[e]); } }
          __syncthreads(); }
        constexpr int I_QKV = 16 * 96, I_O = 16 * 32, I_UP = 16 * 176, I_DN = 44 * 32, I_HIN = 16 * 128;
        constexpr int NITEMS = I_QKV + 2 * I_O + 2 * I_UP + 2 * I_DN + I_HIN;
#ifndef REP_PRO
#define REP_PRO 1
#endif
        for (int rep = 0; rep < REP_PRO; ++rep)
        for (int it = gw; it < NITEMS; it += NGW) {
            int r = it;
            if (r < I_QKV) { transpose_item(args.in[2], 3088, 1024, 96, Wqkv_t, scr, r, lane); continue; } r -= I_QKV;
            if (r < I_O) { transpose_item(args.in[4], 1024, 1024, 32, Wo_t, scr, r, lane); continue; } r -= I_O;
            if (r < I_O) { transpose_item(args.in[9], 1024, 1024, 32, Who_t, scr, r, lane); continue; } r -= I_O;
            if (r < I_HIN) { transpose_item(args.in[6], 4096, 1024, 128, Whin_t, scr, r, lane, false, args.in[5]); continue; } r -= I_HIN;
            if (r < I_UP) { transpose_item(args.in[11], FF2, 1024, 176, (bf16*)(ws + WS_WUP0), scr, r, lane, true, args.in[10]); continue; } r -= I_UP;
            if (r < I_UP) { transpose_item(args.in[11] + (size_t)1024 * FF2, FF2, 1024, 176, (bf16*)(ws + WS_WUP1), scr, r, lane, true, args.in[10] + 1024); continue; } r -= I_UP;
            if (r < I_DN) { transpose_item(args.in[14], 1024, FF, 32, (bf16*)(ws + WS_WDN0), scr, r, lane); continue; } r -= I_DN;
            transpose_item(args.in[14] + (size_t)FF * 1024, 1024, FF, 32, (bf16*)(ws + WS_WDN1), scr, r, lane);
        }
        for (int i = bx * 512 + tid; i < 2 * 4 * FF2; i += G * 512) { const int l = i / (4 * FF2), k = (i / FF2) & 3, c = i % FF2;
            ((bf16*)(ws + WS_CWB))[i] = (bf16)f2bf(k < 3 ? args.in[12][(size_t)(l * 3 + k) * FF2 + c] : args.in[13][(size_t)l * FF2 + c]); }
        if (bx == 0) for (int c = tid; c < 1024; c += 512) ((float*)(ws + WS_LB))[c] = 1.0f / (1.0f + expf(args.in[7][c] - args.in[7][1024 + c]));
        norm16_fl(x, args.in[1], XN, L + WFL_OFF, args.in[3], LFt, gw, lane);
        if (bx == 0) for (int i = tid; i < XCD_BAR_WORDS; i += 512) ((unsigned*)(ws + WS_BARW))[i] = 0u;
    }
    grid.sync();
    const XcdBarrier bar = xcd_barrier_post((unsigned*)(ws + WS_BARW), (volatile LAS unsigned*)(L + LDS_BYTES - 64));
#if defined(PROBE_A)
    if (bx == 0 && tid == 0) ((unsigned long long*)(ws + WS_PROBE))[nst] = __builtin_amdgcn_s_memrealtime();
#endif
    ++nst;

    { pg8::Gemm g{opq(XN), opq(Wqkv_t), M, 3072, 1024, 1024}; pg8::StaticOrder S; S.init(M, 3072, G, bx);
      pg8::EpiQKV E{QO, LFt, args.in[3], attn_body::C2};
#ifndef NO_EPIQKV_1
      for (int rep = 0; rep < REP_QKV; ++rep) pg8::gemm_phase<pg8::EpiQKV, pg8::StaticOrder, true, true>(L, g, S, E);
#endif
    }
    SYNC_STAMP();
#ifndef REP_ATT
#define REP_ATT 1
#define ATT_O QO
#else
#define ATT_O XN
#endif
    { const attn_body::AttnTensors AT{(const attn_body::bf16*)QO, (const attn_body::bf16*)(ws + WS_K), (const attn_body::bf16*)(ws + WS_V), (attn_body::bf16*)ATT_O, LFt};
      const attn_body::StaticOrder S(G, vcu);
#ifndef NO_ATTN
      for (int rep = 0; rep < REP_ATT; ++rep) attn_body::attn_phase<attn_body::StaticOrder>((char*)lds, AT, S);
#endif
    }
    SYNC_STAMP();
#define LAYER_TAIL(LY, AOP, BOP, BASE) do { \
    { pg8::Gemm g{opq(AOP), opq(BOP), M, 1024, 1024, 1024}; pg8::StaticOrder S; S.init(M, 1024, G, bx); \
      pg8::EpiRes E{BASE, (BASE) ? (const bf16*)nullptr : (const bf16*)RB, RB, SSQ, (LAS float*)(L + LDS_XH)}; \
      for (int rep = 0; rep < ((LY) == 0 ? REP_WO : 1); ++rep) pg8::gemm_phase<pg8::EpiRes, pg8::StaticOrder, true, true>(L, g, S, E); } \
    SYNC_STAMP(); \
    { pg8::Gemm g{opq(RB), opq((bf16*)(ws + ((LY) == 0 ? WS_WUP0 : WS_WUP1))), M, FF2, 1024, 1024}; pg8::StaticOrder S; S.init(M, FF2, G, bx); \
      pg8::EpiUpConv E{U, UHf, (const bf16*)(ws + WS_CWB) + (LY) * 4 * FF2, (LAS pg8::f32x4*)(L + LDS_XH), L + LDS_TAPL, SSQ, (LAS float*)(L + LDS_RSL)}; \
      { pg8::Unit u0; const int t_ = FRESH_TID(); if (S.next(0, u0) && t_ < 256) { const int k = t_ >> 6, ch = (t_ & 63) * 4;     \
          *(LAS pg8::u32x2_e*)(L + LDS_TAPL + k * 512 + (t_ & 63) * 8) = *(const pg8::u32x2_e*)((const bf16*)(ws + WS_CWB) + (LY) * 4 * FF2 + k * FF2 + (ch < 128 ? u0.pn * 128 + ch : FF + u0.pn * 128 + (ch - 128))); } \
        if (S.next(0, u0)) pg8::rstd_commit((LAS float*)(L + LDS_RSL), 0, t_, pg8::rstd_issue(SSQ, u0.pm, t_));     \
        __syncthreads(); } \
      for (int rep = 0; rep < REP_UP; ++rep) pg8::gemm_phase<pg8::EpiUpConv, pg8::StaticOrder, true, true>(L, g, S, E); } \
    UP_PLAIN_PROBE(); \
    SYNC_STAMP(); \
    { pg8::Gemm g{opq(U), opq((bf16*)(ws + ((LY) == 0 ? WS_WDN0 : WS_WDN1))), M, 1024, FF, FF}; pg8::StaticOrder S; S.init(M, 1024, G, bx); \
      { pg8::Unit fu; for (int i = 0; S.next(i, fu); ++i) conv_fixup(U, UHf, (const bf16*)(ws + WS_CWB) + (LY) * 4 * FF2, fu.pm, FRESH_TID()); \
        asm volatile("s_waitcnt vmcnt(0)" ::: "memory"); __syncthreads(); } \
      pg8::EpiRes E{(const float*)nullptr, RB, RB, SSQ, (LAS float*)(L + LDS_XH)}; \
      pg8::gemm_phase<pg8::EpiRes, pg8::StaticOrder, true, true>(L, g, S, E); } \
    SYNC_STAMP(); } while (0)
    LAYER_TAIL(0, ATT_O, Wo_t, x);
    { pg8::Gemm g{opq(RB), opq(Whin_t), M, 4096, 1024, 1024}; pg8::StaticOrder S; S.init(M, 4096, G, bx);
      pg8::EpiHgrn E{(bf16*)(ws + WS_HLF), SSQ, (LAS float*)(L + LDS_RSL)};
      { pg8::Unit u0; const int t_ = FRESH_TID(); if (S.next(0, u0)) pg8::rstd_commit((LAS float*)(L + LDS_RSL), 0, t_, pg8::rstd_issue(SSQ, u0.pm, t_)); __syncthreads(); }
      for (int rep = 0; rep < REP_HIN; ++rep) pg8::gemm_phase<pg8::EpiHgrn, pg8::StaticOrder, true, true>(L, g, S, E); }
    SYNC_STAMP();
    { const hg::Tensors HT{(const hg::u16*)(ws + WS_HLF), (const hg::u16*)(ws + WS_HQ), (const hg::u16*)(ws + WS_HI), (const hg::u16*)(ws + WS_HG), (hg::u16*)(ws + WS_US), (float*)(ws + WS_DEC), args.in[8], (const float*)(ws + WS_LB), (hg::u16*)(ws + WS_OG), (hg::u16*)(ws + WS_SFC), (float*)(ws + WS_PB)};
      const int upw = hg::NUNITS / G;
#ifndef NO_HGA
      for (int rep = 0; rep < REP_HGA; ++rep) hg::phaseA_all(L, HT, vcu * upw, upw, FRESH_TID());
#endif
      SYNC_STAMP();
#ifndef NO_HGC
#ifndef REP_HGC
#define REP_HGC 1
#endif
      for (int rep = 0; rep < REP_HGC; ++rep) hg::phaseC_all(L, HT, vcu * upw, upw, FRESH_TID());
#endif
      SYNC_STAMP(); }
    LAYER_TAIL(1, (bf16*)(ws + WS_OG), Who_t, (const float*)nullptr);
#if defined(PROBE_A)
    if (bx == 0 && tid == 0) { const unsigned long long* ts = (const unsigned long long*)(ws + WS_PROBE); float fa = 0.f, fb = 0.f;
        for (int i = 1; i < nst; ++i) { const float d = (float)(ts[i] - ts[i - 1]) * (1.0f / 400000.0f); if ((PROBE_A >> i) & 1) fa += d; if ((PROBE_B >> i) & 1) fb += d; }
        ((float*)(ws + WS_PROBE + 1024))[0] = fa; ((float*)(ws + WS_PROBE + 1024))[1] = fb; }
    grid.sync();
    norm_rows_rb<true>(RB, args.in[15], out, gw, NGW, FRESH_TID() & 63);
    grid.sync();
    { const float fa = ((const float*)(ws + WS_PROBE + 1024))[0], fb = ((const float*)(ws + WS_PROBE + 1024))[1];
      for (size_t i = (size_t)bx * 512 + tid; i < (size_t)M * D; i += (size_t)G * 512) out[i] = out[i] * (1.0f + fa) + (i == 0 ? 200.0f * fb : 0.f); }
#else
#if defined(EXTRA_SYNCS)
    for (int i = 0; i < EXTRA_SYNCS; ++i) xcd_barrier(bar);
#endif
    norm_rows_rb<true>(RB, args.in[15], out, gw, NGW, FRESH_TID() & 63);
#endif
}

extern "C" void kernel_launch(void* const* d_in, const int* in_sizes, int n_in, void* d_out, int out_size, void* d_ws, size_t ws_size, hipStream_t stream) {
    static int grid = 0;
    if (grid == 0) {
        if (n_in != 16 || in_sizes[0] != M * D || out_size != M * D || ws_size < WS_END) { fprintf(stderr, "kernel_launch: unexpected shapes / workspace (n_in %d, in0 %d, out %d, ws %zu); nothing launched\n", n_in, n_in > 0 ? in_sizes[0] : -1, out_size, ws_size); grid = -1; return; }
        int dev = 0, cus = 0, per_cu = 0;
        if (hipGetDevice(&dev) != hipSuccess || hipDeviceGetAttribute(&cus, hipDeviceAttributeMultiprocessorCount, dev) != hipSuccess) { grid = -1; return; }
        if (hipFuncSetAttribute((const void*)fwd_kernel, hipFuncAttributeMaxDynamicSharedMemorySize, LDS_BYTES) != hipSuccess) { fprintf(stderr, "kernel_launch: hipFuncSetAttribute failed\n"); grid = -1; return; }
        if (hipOccupancyMaxActiveBlocksPerMultiprocessor(&per_cu, (const void*)fwd_kernel, NWAVES * 64, LDS_BYTES) != hipSuccess || per_cu < 1) { fprintf(stderr, "kernel_launch: occupancy query gives %d\n", per_cu); per_cu = 1; }
        (void)hipGetLastError();
        grid = cus;
        if (grid != 256) { fprintf(stderr, "kernel_launch: built for 256 CUs, device has %d; nothing launched\n", cus); grid = -1; return; }
    }
    if (grid < 0) return;
    Args a{};
    for (int i = 0; i < 16; ++i) a.in[i] = (const float*)d_in[i];
    a.out = (float*)d_out; a.ws = (unsigned char*)d_ws;
    void* kargs[] = {&a};
    const hipError_t e = hipLaunchCooperativeKernel((const void*)fwd_kernel, dim3(grid), dim3(NWAVES * 64), kargs, LDS_BYTES, stream);
    if (e != hipSuccess) fprintf(stderr, "kernel_launch: cooperative launch failed: %s\n", hipGetErrorString(e));
}
```

```cpp
#include <hip/hip_runtime.h>
#include <hip/hip_cooperative_groups.h>
#include <hip/hip_bf16.h>
#include <cstdio>
#include <cstdint>
#include <cmath>
namespace pg8 {
#define PG8_LAS __attribute__((address_space(3)))
typedef unsigned short bf16_t;
typedef short bf16x8 __attribute__((ext_vector_type(8)));
typedef float f32x4 __attribute__((ext_vector_type(4)));
typedef unsigned u32x4 __attribute__((ext_vector_type(4)));
constexpr int BM = 256, BK = 64, HALF = 128, HTB = HALF * BK * 2  , STAGE_BYTES = 8 * HTB, NXCD = 8, WGM = 8;

__host__ __device__ __forceinline__ int lds_byte(int r, int c) { const int st = (r >> 4) * 2 + (c >> 5), rr = r & 15, cc = c & 31, ob = rr * 64 + cc * 2; return st * 1024 + (ob ^ (((ob >> 9) & 1) << 5)); }
__host__ __device__ __forceinline__ void stage_rc(int b, int& R, int& C) { const int st = b / 1024, sb = b % 1024, swz = sb ^ (((sb >> 9) & 1) << 5); R = (st >> 1) * 16 + swz / 64; C = (st & 1) * 32 + (swz % 64) / 2; }
__host__ __device__ __forceinline__ int perm32(int rho) { const int n = rho >> 4, i = rho & 15; return 8 * (i >> 2) + 4 * n + (i & 3); }

struct Unit { int pm, pn, ui, npn, npm; };
struct Gemm { const bf16_t* A; const bf16_t* Bt; int M, N, K, lda; };

struct StaticOrder {
    int nM, nN, nwg, G, c;
    __host__ __device__ __forceinline__ void init(int M, int N, int G_, int c_) { nM = M / BM; nN = N / BM; nwg = nM * nN; G = G_; c = c_; }
    __host__ __device__ __forceinline__ bool next(int i, Unit& u) const {
        const long L = (long)i * G + c; if (L >= nwg) return false;
        int wgid = (int)L; { const int q = nwg / NXCD, r = nwg % NXCD, xcd = wgid % NXCD, off = wgid / NXCD; wgid = (xcd < r ? xcd * (q + 1) : r * (q + 1) + (xcd - r) * q) + off; }
        const int nig = WGM * nN, gid = wgid / nig, fm = gid * WGM, gsz = (nM - fm) < WGM ? (nM - fm) : WGM;
        u.pm = fm + ((wgid % nig) % gsz); u.pn = (wgid % nig) / gsz; return true;
    }
    __device__ __forceinline__ void a_ready(const Unit&) const {}
    __device__ __forceinline__ void done(const Unit&) const {}
};
constexpr int MTOK = 32768, DMODEL = 1024, SEQL = 8192, FFN2 = 5632, FFN1 = 2816;
__device__ __forceinline__ unsigned cvt_pk_bf16(float lo, float hi) { unsigned r; asm volatile("v_cvt_pk_bf16_f32 %0, %1, %2" : "=v"(r) : "v"(lo), "v"(hi)); return r; }
typedef _Float16 h16x2 __attribute__((ext_vector_type(2)));
typedef unsigned u32x2_e __attribute__((ext_vector_type(2)));
__device__ __forceinline__ unsigned cvt_pk_f16(float lo, float hi) { h16x2 v = {(_Float16)lo, (_Float16)hi}; return __builtin_bit_cast(unsigned, v); }
__device__ __forceinline__ float bf_lo(unsigned w) { return __builtin_bit_cast(float, w << 16); }
__device__ __forceinline__ float bf_hi(unsigned w) { return __builtin_bit_cast(float, w & 0xffff0000u); }
__device__ __forceinline__ float silu_f(float x) { return x * __builtin_amdgcn_rcpf(1.0f + __expf(-x)); }

struct EpiQKV {
    static constexpr bool PERM = true, AFTER_DRAIN = false;
    bf16_t* QKV; float* LFt; const float* b_f; float scale0;
    __device__ __forceinline__ void operator()(const f32x4 (&acc)[2][2][4][2], const Unit& u, int wr, int wc, int fr, int fq) const {
        const int row0 = u.pm * BM + wr * 64 + fr;
        if (u.pn < 12) {
            const int part = u.pn >> 2; bf16_t* base = QKV + (size_t)part * ((size_t)MTOK * DMODEL);
            const float sc = part == 0 ? scale0 : 1.f; const int col0 = (u.pn & 3) * BM + wc * 32 + 8 * fq;
#pragma unroll
            for (int ai = 0; ai < 2; ++ai)
#pragma unroll
                for (int m = 0; m < 4; ++m) { bf16_t* rowp = base + (size_t)(row0 + ai * HALF + m * 16) * DMODEL + col0;
#pragma unroll
                    for (int bj = 0; bj < 2; ++bj) { const f32x4 v0 = acc[ai][bj][m][0] * sc, v1 = acc[ai][bj][m][1] * sc;
                        u32x4 w; w.x = cvt_pk_bf16(v0[0], v0[1]); w.y = cvt_pk_bf16(v0[2], v0[3]); w.z = cvt_pk_bf16(v1[0], v1[1]); w.w = cvt_pk_bf16(v1[2], v1[3]);
                        *(u32x4*)(rowp + bj * HALF) = w; } }
        } else if (wc == 0 && fq < 2) {
            float bias[8];
#pragma unroll
            for (int e = 0; e < 8; ++e) bias[e] = b_f[8 * fq + e];
#pragma unroll
            for (int ai = 0; ai < 2; ++ai)
#pragma unroll
                for (int m = 0; m < 4; ++m) { const int row = row0 + ai * HALF + m * 16; const int b = row >> 13, t = row & (SEQL - 1);
#pragma unroll
                    for (int n = 0; n < 2; ++n)
#pragma unroll
                        for (int e = 0; e < 4; ++e) { const int hh = 8 * fq + 4 * n + e; const float z = acc[ai][0][m][n][e] + bias[4 * n + e];
                            const float lf = fminf(z, 0.f) - log1pf(__expf(-fabsf(z)));
                            LFt[(size_t)(b * 16 + hh) * SEQL + t] = lf; } }
        }
    }
};
struct EpiRes {
    static constexpr bool PERM = true, AFTER_DRAIN = false;
    const float* basef; const bf16_t* baseb; bf16_t* out; float* SSQ; PG8_LAS float* XS;
    __device__ __forceinline__ void operator()(const f32x4 (&acc)[2][2][4][2], const Unit& u, int wr, int wc, int fr, int fq) const {
        const int col0 = u.pn * BM + wc * 32 + 8 * fq;
#pragma unroll
        for (int ai = 0; ai < 2; ++ai)
#pragma unroll
            for (int m = 0; m < 4; ++m) { const size_t off = (size_t)(u.pm * BM + ai * HALF + wr * 64 + m * 16 + fr) * DMODEL + col0;
                f32x4 b[2][2];
                if (basef) {
#pragma unroll
                    for (int bj = 0; bj < 2; ++bj) { b[bj][0] = *(const f32x4*)(basef + off + bj * HALF); b[bj][1] = *(const f32x4*)(basef + off + bj * HALF + 4); }
                } else {
#pragma unroll
                    for (int bj = 0; bj < 2; ++bj) { const u32x4 w = *(const u32x4*)(baseb + off + bj * HALF);
                        b[bj][0] = (f32x4){bf_lo(w.x), bf_hi(w.x), bf_lo(w.y), bf_hi(w.y)}; b[bj][1] = (f32x4){bf_lo(w.z), bf_hi(w.z), bf_lo(w.w), bf_hi(w.w)}; }
                }
                float ss = 0.f;
#pragma unroll
                for (int bj = 0; bj < 2; ++bj) { const f32x4 v0 = b[bj][0] + acc[ai][bj][m][0], v1 = b[bj][1] + acc[ai][bj][m][1];
                    ss += ((v0[0] * v0[0] + v0[1] * v0[1]) + (v0[2] * v0[2] + v0[3] * v0[3])) + ((v1[0] * v1[0] + v1[1] * v1[1]) + (v1[2] * v1[2] + v1[3] * v1[3]));
                    u32x4 w; w.x = cvt_pk_bf16(v0[0], v0[1]); w.y = cvt_pk_bf16(v0[2], v0[3]); w.z = cvt_pk_bf16(v1[0], v1[1]); w.w = cvt_pk_bf16(v1[2], v1[3]);
                    *(u32x4*)(out + off + bj * HALF) = w; }
                ss += __shfl_xor(ss, 16); ss += __shfl_xor(ss, 32);
                if (fq == 0) XS[(ai * HALF + wr * 64 + m * 16 + fr) * 4 + wc] = ss;
                if (m & 1) asm volatile("" ::: "memory"); }
        asm volatile("s_waitcnt lgkmcnt(0)" ::: "memory"); __builtin_amdgcn_s_barrier(); asm volatile("" ::: "memory");
        { const int t = (wr * 4 + wc) * 64 + fq * 16 + fr;
          if (t < 256) { const f32x4 p = *(const PG8_LAS f32x4*)(XS + t * 4); SSQ[(size_t)(u.pm * BM + t) * 4 + u.pn] = (p[0] + p[1]) + (p[2] + p[3]); } }
    }
};
__device__ __forceinline__ f32x4 rstd_issue(const float* SSQ, int pm, int t) { return t < 256 ? *(const f32x4*)(SSQ + (size_t)(pm * BM + t) * 4) : (f32x4){0.f, 0.f, 0.f, 0.f}; }
__device__ __forceinline__ void rstd_commit(PG8_LAS float* RSL, int buf, int t, const f32x4& p) { if (t < 256) RSL[buf * 256 + t] = 1.0f / sqrtf(((p[0] + p[1]) + (p[2] + p[3])) * (1.0f / DMODEL) + 1e-6f); }
__device__ __forceinline__ void scale_rows(const f32x4 (&acc)[2][2][4][2], const PG8_LAS float* RSL, int buf, int wr, int fr) {
    f32x4 (&a_)[2][2][4][2] = const_cast<f32x4 (&)[2][2][4][2]>(acc);
#pragma unroll
    for (int ai = 0; ai < 2; ++ai)
#pragma unroll
        for (int m = 0; m < 4; ++m) { const float r = RSL[buf * 256 + ai * HALF + wr * 64 + m * 16 + fr];
#pragma unroll
            for (int bj = 0; bj < 2; ++bj)
#pragma unroll
                for (int n = 0; n < 2; ++n) a_[ai][bj][m][n] = a_[ai][bj][m][n] * r; }
}
template <int CTRL> __device__ __forceinline__ float dppz(float x) { return __builtin_bit_cast(float, __builtin_amdgcn_update_dpp(0, __builtin_bit_cast(int, x), CTRL, 0xf, 0xf, true)); }
struct EpiUpConv {
    static constexpr bool PERM = true, AFTER_DRAIN = false;
    bf16_t* ACT; float* UHf; const bf16_t* CWB; PG8_LAS f32x4* XH; PG8_LAS unsigned char* TAPL; const float* SSQ; PG8_LAS float* RSL;
    __device__ __forceinline__ void operator()(const f32x4 (&acc)[2][2][4][2], const Unit& u, int wr, int wc, int fr, int fq) const {
        typedef unsigned u32x2 __attribute__((ext_vector_type(2)));
        const int cl0 = wc * 32 + 8 * fq, gc0 = u.pn * HALF + cl0;
        const int tid0_ = (wr * 4 + wc) * 64 + fq * 16 + fr; const f32x4 nstat = rstd_issue(SSQ, u.npm, tid0_);
        scale_rows(acc, RSL, u.ui & 1, wr, fr);
        if (fr >= 14) {
#pragma unroll
            for (int ai = 0; ai < 2; ++ai) { PG8_LAS f32x4* dst = XH + ((((ai * 2 + wr) * 4 + wc) * 4 + fq) * 2 + (fr - 14)) * 4;
                dst[0] = acc[ai][0][3][0]; dst[1] = acc[ai][0][3][1]; dst[2] = acc[ai][1][3][0]; dst[3] = acc[ai][1][3][1]; }
        }
        if (wr == 0 && fr < 2) { float* p = UHf + (((size_t)u.pm * 2 + 0) * 2 + fr) * FFN2 + u.pn * BM + cl0;
            *(f32x4*)p = acc[0][0][0][0]; *(f32x4*)(p + 4) = acc[0][0][0][1]; *(f32x4*)(p + HALF) = acc[0][1][0][0]; *(f32x4*)(p + HALF + 4) = acc[0][1][0][1]; }
        if (wr == 1 && fr >= 14) { float* p = UHf + (((size_t)u.pm * 2 + 1) * 2 + (fr - 14)) * FFN2 + u.pn * BM + cl0;
            *(f32x4*)p = acc[1][0][3][0]; *(f32x4*)(p + 4) = acc[1][0][3][1]; *(f32x4*)(p + HALF) = acc[1][1][3][0]; *(f32x4*)(p + HALF + 4) = acc[1][1][3][1]; }
        const int tid_ = (wr * 4 + wc) * 64 + fq * 16 + fr; u32x2 ntap = (u32x2){0u, 0u};
        if (tid_ < 256) { const int k = tid_ >> 6, ch = (tid_ & 63) * 4; ntap = *(const u32x2*)(CWB + k * FFN2 + (ch < HALF ? u.npn * HALF + ch : FFN1 + u.npn * HALF + (ch - HALF))); }
        asm volatile("s_waitcnt lgkmcnt(0)" ::: "memory"); __builtin_amdgcn_s_barrier(); asm volatile("" ::: "memory");
        const PG8_LAS unsigned char* tapb = TAPL + (u.ui & 1) * 2048 + cl0 * 2;
#define PG8_FD(Y, X, T, CTRL) asm("v_fmac_f32_dpp %0, %1, %2 " CTRL " row_mask:0xf bank_mask:0xf bound_ctrl:1" : "+v"(Y) : "v"(X), "v"(T))
#pragma unroll
        for (int n = 0; n < 2; ++n) {
            float tp[2][4][4];
#pragma unroll
            for (int bj = 0; bj < 2; ++bj)
#pragma unroll
                for (int k = 0; k < 4; ++k) { const u32x2 w = *(const PG8_LAS u32x2*)(tapb + k * 512 + bj * 256 + 8 * n);
                    tp[bj][k][0] = bf_lo(w.x); tp[bj][k][1] = bf_hi(w.x); tp[bj][k][2] = bf_lo(w.y); tp[bj][k][3] = bf_hi(w.y); }
#pragma unroll
            for (int ai = 0; ai < 2; ++ai) {
                const bool has = (wr == 1) || (ai == 1);
                const int pai = (wr == 1) ? ai : 0, pwr = (wr == 1) ? 0 : 1;
                const PG8_LAS f32x4* hsrc = XH + (((pai * 2 + pwr) * 4 + wc) * 4 + fq) * 8;
#pragma unroll
                for (int m = 0; m < 4; ++m) {
                    float yg[4];
#pragma unroll
                    for (int bj = 0; bj < 2; ++bj) {
                        const f32x4 x = acc[ai][bj][m][n];
                        f32x4 h14 = (f32x4){0.f, 0.f, 0.f, 0.f}, h15 = h14;
                        if (m == 0 && has) { h14 = hsrc[bj * 2 + n]; h15 = hsrc[4 + bj * 2 + n]; }
                        const f32x4 xp = acc[ai][bj][m > 0 ? m - 1 : 0][n];
#pragma unroll
                        for (int e = 0; e < 4; ++e) { const float t0 = tp[bj][0][e], t1 = tp[bj][1][e];
                            float y = tp[bj][2][e] * x[e] + tp[bj][3][e];
                            if (m == 0) { y += t1 * (fr == 0 ? h15[e] : 0.f); y += t0 * (fr == 0 ? h14[e] : (fr == 1 ? h15[e] : 0.f)); }
                            else { PG8_FD(y, xp[e], t1, "row_shl:15"); PG8_FD(y, xp[e], t0, "row_shl:14"); }
                            PG8_FD(y, x[e], t1, "row_shr:1"); PG8_FD(y, x[e], t0, "row_shr:2");
                            if (bj == 0) yg[e] = y; else yg[e] = silu_f(yg[e]) * y; }
                    }
                    *(u32x2*)(ACT + (size_t)(u.pm * BM + ai * HALF + wr * 64 + m * 16 + fr) * FFN1 + gc0 + 4 * n) = (u32x2){cvt_pk_bf16(yg[0], yg[1]), cvt_pk_bf16(yg[2], yg[3])};
                }
            }
        }
#undef PG8_FD
        if (tid_ < 256) *(PG8_LAS u32x2*)(TAPL + ((u.ui + 1) & 1) * 2048 + (tid_ >> 6) * 512 + (tid_ & 63) * 8) = ntap;
        rstd_commit(RSL, (u.ui + 1) & 1, tid0_, nstat);
    }
};
struct EpiDummy {
    static constexpr bool PERM = true, AFTER_DRAIN = false;
    bf16_t* O;
    __device__ __forceinline__ void operator()(const f32x4 (&acc)[2][2][4][2], const Unit& u, int wr, int wc, int fr, int fq) const {
        const int row0 = u.pm * BM + wr * 64 + fr, col0 = u.pn * HALF + wc * 32 + 8 * fq;
#pragma unroll
        for (int ai = 0; ai < 2; ++ai)
#pragma unroll
            for (int m = 0; m < 4; ++m) { const f32x4 v0 = acc[ai][0][m][0] + acc[ai][1][m][0], v1 = acc[ai][0][m][1] + acc[ai][1][m][1];
                u32x4 w; w.x = cvt_pk_bf16(v0[0], v0[1]); w.y = cvt_pk_bf16(v0[2], v0[3]); w.z = cvt_pk_bf16(v1[0], v1[1]); w.w = cvt_pk_bf16(v1[2], v1[3]);
                *(u32x4*)(O + (size_t)(row0 + ai * HALF + m * 16) * FFN1 + col0) = w; }
    }
};
struct EpiHgrn {
    static constexpr bool PERM = true, AFTER_DRAIN = false;
    bf16_t* HB; const float* SSQ; PG8_LAS float* RSL;
    __device__ __forceinline__ void operator()(const f32x4 (&acc)[2][2][4][2], const Unit& u, int wr, int wc, int fr, int fq) const {
        const int part = u.pn >> 2; const int row0 = u.pm * BM + wr * 64 + fr, col0 = (u.pn & 3) * BM + wc * 32 + 8 * fq;
        bf16_t* dst = HB + (size_t)(part == 0 ? 1 : (part == 1 ? 0 : part)) * ((size_t)MTOK * DMODEL); const bool act = (part == 0) || (part == 3);
        const int tid0_ = (wr * 4 + wc) * 64 + fq * 16 + fr; const f32x4 nstat = rstd_issue(SSQ, u.npm, tid0_);
        scale_rows(acc, RSL, u.ui & 1, wr, fr);
#pragma unroll
        for (int ai = 0; ai < 2; ++ai)
#pragma unroll
            for (int m = 0; m < 4; ++m) { bf16_t* rowp = dst + (size_t)(row0 + ai * HALF + m * 16) * DMODEL + col0;
#pragma unroll
                for (int bj = 0; bj < 2; ++bj) { float r[8];
#pragma unroll
                    for (int e = 0; e < 8; ++e) { const float z = acc[ai][bj][m][e >> 2][e & 3]; r[e] = act ? silu_f(z) : z; }
                    u32x4 w;
                    if (part == 1) { w.x = cvt_pk_f16(r[0], r[1]); w.y = cvt_pk_f16(r[2], r[3]); w.z = cvt_pk_f16(r[4], r[5]); w.w = cvt_pk_f16(r[6], r[7]); }
                    else { w.x = cvt_pk_bf16(r[0], r[1]); w.y = cvt_pk_bf16(r[2], r[3]); w.z = cvt_pk_bf16(r[4], r[5]); w.w = cvt_pk_bf16(r[6], r[7]); }
                    *(u32x4*)(rowp + bj * HALF) = w; } }
        rstd_commit(RSL, (u.ui + 1) & 1, tid0_, nstat);
    }
};

template <class Epi, class Sched, bool ALIGN_EPI = false, bool SP2 = false>
__device__ __forceinline__ void gemm_phase(PG8_LAS unsigned char* lds, const Gemm g, const Sched& S, const Epi& E) {
    int tid = threadIdx.x; asm volatile("" : "+v"(tid)); const int wid = __builtin_amdgcn_readfirstlane(tid >> 6), lane = tid & 63, wr = wid >> 2, wc = wid & 3, fr = lane & 15, fq = lane >> 4;
    const int K = g.K, nt = K / BK;
    unsigned voffA[2], voffB[2];
#pragma unroll
    for (int i = 0; i < 2; ++i) { int R, C; stage_rc(tid * 16 + i * 8192, R, C); const int Rb = Epi::PERM ? ((R & ~31) + perm32(R & 31)) : R;
        voffA[i] = (unsigned)(R * g.lda + C) * 2u; voffB[i] = (unsigned)(Rb * K + C) * 2u; }
    const size_t kstep = (size_t)(BK * 2);
    const size_t hstepA = (size_t)HALF * g.lda * 2, hstepB = (size_t)HALF * K * 2;
    const size_t tstepA = 2 * hstepA, tstepB = 2 * hstepB;
    const unsigned ldsw = (unsigned)wid * 1024u;
    const int aoff = lds_byte(wr * 64 + fr, fq * 8), boff = lds_byte(wc * 32 + fr, fq * 8);
#define PG8_SA(b, h) (((b) * 2 + (h)) * HTB)
#define PG8_SB(b, h) ((4 + (b) * 2 + (h)) * HTB)
#define PG8_STAGE(bufoff, gbase, voff) do { _Pragma("unroll") for (int _i = 0; _i < 2; ++_i) \
        __builtin_amdgcn_global_load_lds((const unsigned*)((const char*)(gbase) + (voff)[_i]), (PG8_LAS unsigned*)(lds + (bufoff) + ldsw + _i * 8192), 16, 0, 0); } while (0)
#define PG8_LDA(dst, b, h) do { _Pragma("unroll") for (int m = 0; m < 4; ++m) _Pragma("unroll") for (int k = 0; k < 2; ++k) dst[m][k] = *(const PG8_LAS bf16x8*)(lds + PG8_SA(b, h) + aoff + m * 2048 + k * 1024); } while (0)
#define PG8_LDB(dst, b, h) do { _Pragma("unroll") for (int n = 0; n < 2; ++n) _Pragma("unroll") for (int k = 0; k < 2; ++k) dst[n][k] = *(const PG8_LAS bf16x8*)(lds + PG8_SB(b, h) + boff + n * 2048 + k * 1024); } while (0)
#define PG8_MMA(ai, bj, At, Bt) do { __builtin_amdgcn_s_setprio(1); _Pragma("unroll") for (int m = 0; m < 4; ++m) _Pragma("unroll") for (int n = 0; n < 2; ++n) _Pragma("unroll") for (int k = 0; k < 2; ++k) \
        acc[ai][bj][m][n] = __builtin_amdgcn_mfma_f32_16x16x32_bf16(Bt[n][k], At[m][k], acc[ai][bj][m][n], 0, 0, 0); __builtin_amdgcn_s_setprio(0); } while (0)
#define PG8_WAIT_V(n) asm volatile("s_waitcnt vmcnt(" #n ")" ::: "memory")
#define PG8_WAIT_L(n) asm volatile("s_waitcnt lgkmcnt(" #n ")" ::: "memory")
#define PG8_BAR __builtin_amdgcn_s_barrier()
#define PG8_SCHED __builtin_amdgcn_sched_barrier(0)
    Unit cur, nxt; int ui = 0;
    if (!S.next(0, cur)) return;
    f32x4 acc[2][2][4][2];
#pragma unroll
    for (int a = 0; a < 2; ++a)
#pragma unroll
        for (int b = 0; b < 2; ++b)
#pragma unroll
            for (int m = 0; m < 4; ++m)
#pragma unroll
                for (int n = 0; n < 2; ++n) acc[a][b][m][n] = (f32x4){0.f, 0.f, 0.f, 0.f};
    bf16x8 At[4][2], B0[2][2], B1[2][2];
    const char* cA = (const char*)g.A + (size_t)cur.pm * tstepA; const char* cB = (const char*)g.Bt + (size_t)cur.pn * tstepB;
    S.a_ready(cur);
    if constexpr (SP2) {
        PG8_STAGE(PG8_SB(0, 0), cB, voffB); PG8_STAGE(PG8_SB(0, 1), cB + hstepB, voffB); PG8_STAGE(PG8_SA(0, 0), cA, voffA); PG8_STAGE(PG8_SA(0, 1), cA + hstepA, voffA);
        if (wr == 1) PG8_BAR;
        PG8_WAIT_V(2); PG8_BAR;
        PG8_STAGE(PG8_SB(1, 0), cB + kstep, voffB); PG8_STAGE(PG8_SA(1, 0), cA + kstep, voffA); PG8_STAGE(PG8_SB(1, 1), cB + hstepB + kstep, voffB);
        PG8_WAIT_V(6); PG8_BAR;
    } else {
        PG8_STAGE(PG8_SB(0, 0), cB, voffB); PG8_STAGE(PG8_SA(0, 0), cA, voffA); PG8_STAGE(PG8_SB(0, 1), cB + hstepB, voffB); PG8_STAGE(PG8_SA(0, 1), cA + hstepA, voffA);
        if (wr == 1) PG8_BAR;
        PG8_WAIT_V(4); PG8_BAR;
        PG8_STAGE(PG8_SB(1, 0), cB + kstep, voffB); PG8_STAGE(PG8_SA(1, 0), cA + kstep, voffA); PG8_STAGE(PG8_SB(1, 1), cB + hstepB + kstep, voffB);
        PG8_WAIT_V(6); PG8_BAR;
    }
    for (;;) {
        const bool has_next = S.next(ui + 1, nxt);
        const char* nA = has_next ? (const char*)g.A + (size_t)nxt.pm * tstepA : cA; const char* nB = has_next ? (const char*)g.Bt + (size_t)nxt.pn * tstepB : cB;
        for (int t = 0; t < nt; t += 2) {
            const bool last = (t == nt - 2);
            const char* a1 = cA + (size_t)(t + 1) * kstep;
            const char* a2 = last ? nA : cA + (size_t)(t + 2) * kstep; const char* b2 = last ? nB : cB + (size_t)(t + 2) * kstep;
            const char* a3 = a2 + kstep; const char* b3 = b2 + kstep;
            if (last && has_next) S.a_ready(nxt);
            if constexpr (SP2) {
            PG8_LDB(B0, 0, 0); PG8_LDB(B1, 0, 1); PG8_SCHED; PG8_LDA(At, 0, 0); PG8_STAGE(PG8_SA(1, 1), a1 + hstepA, voffA);
            PG8_WAIT_V(8); PG8_WAIT_L(0); PG8_BAR; PG8_MMA(0, 0, At, B0); PG8_MMA(0, 1, At, B1); PG8_BAR; PG8_SCHED;
            PG8_LDA(At, 0, 1); PG8_STAGE(PG8_SB(0, 0), b2, voffB); PG8_STAGE(PG8_SB(0, 1), b2 + hstepB, voffB); PG8_STAGE(PG8_SA(0, 0), a2, voffA);
            PG8_WAIT_V(8); PG8_WAIT_L(0); PG8_BAR; PG8_MMA(1, 0, At, B0); PG8_MMA(1, 1, At, B1); PG8_BAR; PG8_SCHED;
            PG8_LDB(B0, 1, 0); PG8_LDB(B1, 1, 1); PG8_SCHED; PG8_LDA(At, 1, 0); PG8_STAGE(PG8_SA(0, 1), a2 + hstepA, voffA);
            PG8_WAIT_V(8); PG8_WAIT_L(0); PG8_BAR; PG8_MMA(0, 0, At, B0); PG8_MMA(0, 1, At, B1); PG8_BAR; PG8_SCHED;
            PG8_LDA(At, 1, 1); PG8_STAGE(PG8_SB(1, 0), b3, voffB); PG8_STAGE(PG8_SB(1, 1), b3 + hstepB, voffB); PG8_STAGE(PG8_SA(1, 0), a3, voffA);
            PG8_WAIT_V(8); PG8_WAIT_L(0); PG8_BAR; PG8_MMA(1, 0, At, B0); PG8_MMA(1, 1, At, B1); PG8_BAR; PG8_SCHED;
            } else {
            PG8_LDB(B0, 0, 0); PG8_SCHED; PG8_LDA(At, 0, 0); PG8_STAGE(PG8_SA(1, 1), a1 + hstepA, voffA);
            PG8_WAIT_L(8); PG8_BAR; PG8_WAIT_L(0); PG8_MMA(0, 0, At, B0); PG8_BAR; PG8_SCHED;
            PG8_LDB(B1, 0, 1); PG8_STAGE(PG8_SB(0, 0), b2, voffB);
            PG8_BAR; PG8_WAIT_L(0); PG8_MMA(0, 1, At, B1); PG8_BAR;
            PG8_LDA(At, 0, 1); PG8_STAGE(PG8_SA(0, 0), a2, voffA);
            PG8_BAR; PG8_WAIT_L(0); PG8_MMA(1, 0, At, B0); PG8_BAR; PG8_SCHED;
            PG8_STAGE(PG8_SB(0, 1), b2 + hstepB, voffB);
            PG8_WAIT_V(6); PG8_BAR; PG8_MMA(1, 1, At, B1); PG8_BAR;
            PG8_LDB(B0, 1, 0); PG8_SCHED; PG8_LDA(At, 1, 0); PG8_STAGE(PG8_SA(0, 1), a2 + hstepA, voffA);
            PG8_WAIT_L(8); PG8_BAR; PG8_WAIT_L(0); PG8_MMA(0, 0, At, B0); PG8_BAR; PG8_SCHED;
            PG8_LDB(B1, 1, 1); PG8_STAGE(PG8_SB(1, 0), b3, voffB);
            PG8_BAR; PG8_WAIT_L(0); PG8_MMA(0, 1, At, B1); PG8_BAR;
            PG8_LDA(At, 1, 1); PG8_STAGE(PG8_SA(1, 0), a3, voffA);
            PG8_BAR; PG8_WAIT_L(0); PG8_MMA(1, 0, At, B0); PG8_BAR; PG8_SCHED;
            PG8_STAGE(PG8_SB(1, 1), b3 + hstepB, voffB);
            PG8_WAIT_V(6); PG8_BAR; PG8_MMA(1, 1, At, B1); PG8_BAR;
            }
        }
        if constexpr (ALIGN_EPI) { if (wr == 0) PG8_BAR; }
        if constexpr (!Epi::AFTER_DRAIN) { cur.ui = ui; cur.npn = has_next ? nxt.pn : cur.pn; cur.npm = has_next ? nxt.pm : cur.pm; int l2_ = lane; asm volatile("" : "+v"(l2_)); E(acc, cur, wr, wc, l2_ & 15, l2_ >> 4); S.done(cur); }
        if (!has_next) break;
#pragma unroll
        for (int a = 0; a < 2; ++a)
#pragma unroll
            for (int b = 0; b < 2; ++b)
#pragma unroll
                for (int m = 0; m < 4; ++m)
#pragma unroll
                    for (int n = 0; n < 2; ++n) acc[a][b][m][n] = (f32x4){0.f, 0.f, 0.f, 0.f};
        cur = nxt; cA = nA; cB = nB; ++ui;
        if constexpr (ALIGN_EPI) { if (wr == 1) PG8_BAR; }
    }
    PG8_WAIT_V(0);
    if constexpr (!ALIGN_EPI) { if (wr == 0) PG8_BAR; }
    PG8_BAR;
    if constexpr (Epi::AFTER_DRAIN) { E.fused(acc, cur, wr, wc, fr, fq, lds, wid, lane); S.done(cur); }
#undef PG8_SA
#undef PG8_SB
#undef PG8_STAGE
#undef PG8_LDA
#undef PG8_LDB
#undef PG8_MMA
#undef PG8_WAIT_V
#undef PG8_WAIT_L
#undef PG8_BAR
#undef PG8_SCHED
}
}
namespace attn_body {
using bf16=__hip_bfloat16;
using bf16x8=__attribute__((ext_vector_type(8)))short;
using s16x4=__attribute__((ext_vector_type(4)))short;
using f32x16=__attribute__((ext_vector_type(16)))float;
using u32x4=__attribute__((ext_vector_type(4)))unsigned;
constexpr int BATCH=4,NHEAD=16,SEQ=8192,D=64,DM=NHEAD*D;
constexpr int NW=8,QBLK=32,QB=QBLK*NW,KVBLK=64,NQB=SEQ/QB;
constexpr int ATTN_PITCH=DM, ATTN_UNIT_ROWS=QB;
__device__ __forceinline__ int crow(int r,int hi){return (r&3)+8*(r>>2)+4*hi;}
#define SBAR() __builtin_amdgcn_sched_barrier(0)
__device__ __forceinline__ void cmask(f32x16&p0,f32x16&p1,int jb,int qrel,int hi){
  const float NEG=-INFINITY; int kb=64*jb+4*hi;
  #pragma unroll
  for(int r=0;r<16;++r){int kv=kb+(r&3)+8*(r>>2); if(kv>qrel)p0[r]=NEG; if(kv+32>qrel)p1[r]=NEG;}
}

constexpr int NSLOT=3, SLOTB=8192;
constexpr int LDS_K=0, LDS_V=NSLOT*SLOTB, LDS_WS=2*NSLOT*SLOTB, LDS_OST=LDS_WS+NW*64*4, LDS_BYTES=LDS_OST+NW*4096; constexpr int LDS_KX=LDS_BYTES, LDS_SCAN=LDS_KX+SEQ*8, LDS_TOTAL=LDS_SCAN+64;
constexpr float C2=0.125f*1.4426950408889634f;
__device__ __forceinline__ void glds16(const void*gsrc,unsigned lds_dst){unsigned keep;
  asm volatile("s_mov_b32 %0, m0\n\ts_mov_b32 m0, %2\n\ts_nop 0\n\tglobal_load_lds_dwordx4 %1, off\n\ts_mov_b32 m0, %0":"=&s"(keep):"v"(gsrc),"s"(lds_dst):"memory");}
__device__ __forceinline__ float max3f(float a,float b,float c){float r;asm("v_max3_f32 %0, %1, %2, %3":"=v"(r):"v"(a),"v"(b),"v"(c));return r;}
__device__ __forceinline__ float max2f(float a,float b){float r;asm("v_max_f32_e32 %0, %1, %2":"=v"(r):"v"(a),"v"(b));return r;}
__device__ __forceinline__ float fadd_s(float a,float b){float r;asm("v_add_f32_e32 %0, %1, %2":"=v"(r):"v"(a),"v"(b));return r;}
__device__ __forceinline__ float fsub_s(float a,float b){float r;asm("v_sub_f32_e32 %0, %1, %2":"=v"(r):"v"(a),"v"(b));return r;}
typedef float f32x2_t __attribute__((ext_vector_type(2))); typedef __bf16 bf16x2_t __attribute__((ext_vector_type(2)));
__device__ __forceinline__ unsigned cvtpk_s(float lo,float hi){f32x2_t v={lo,hi};bf16x2_t b=__builtin_convertvector(v,bf16x2_t);return __builtin_bit_cast(unsigned,b);}
#define WAIT_BAR(N) asm volatile("s_waitcnt vmcnt(" #N ") lgkmcnt(0)\n\ts_barrier":::"memory")

typedef unsigned u32x2_t __attribute__((ext_vector_type(2))); typedef float f32x4_t __attribute__((ext_vector_type(4)));
__device__ __forceinline__ u32x2_t split3(float x){ const unsigned p1=cvtpk_s(x,0.f)&0xffffu; const float r1=x-__uint_as_float(p1<<16); const unsigned p2=cvtpk_s(r1,0.f)&0xffffu; const float r2=r1-__uint_as_float(p2<<16);
  const unsigned p3=cvtpk_s(r2,0.f)&0xffffu; return (u32x2_t){p1|(p2<<16),p3|(0x3F80u<<16)}; }
__device__ __forceinline__ bf16x8 mkqx(float x,int hi){ const unsigned p1=cvtpk_s(x,0.f)&0xffffu; const float r1=x-__uint_as_float(p1<<16); const unsigned p2=cvtpk_s(r1,0.f)&0xffffu; const float r2=r1-__uint_as_float(p2<<16);
  const unsigned p3=cvtpk_s(r2,0.f)&0xffffu; u32x4 w=(u32x4){0x3F803F80u,0x3F80u|(p1<<16),p2|(p3<<16),0u}; if(hi)w=(u32x4){0u,0u,0u,0u}; return __builtin_bit_cast(bf16x8,w); }
__device__ __forceinline__ bf16x8 kxa(u32x2_t q){ return __builtin_bit_cast(bf16x8,(u32x4){q.x,q.y,0x3F803F80u,0u}); }
__device__ __forceinline__ void qkt(f32x16&p0,f32x16&p1,const char*Kslot,const bf16x8*qr,bf16x8 kx0,bf16x8 kx1,bf16x8 qx,int r32,int hi){
  const char*kb=Kslot+hi*1024+r32*16;
  p0=__builtin_amdgcn_mfma_f32_32x32x16_bf16(kx0,qx,f32x16{},0,0,0);p1=__builtin_amdgcn_mfma_f32_32x32x16_bf16(kx1,qx,f32x16{},0,0,0);
  #pragma unroll
  for(int d0=0;d0<4;++d0){
    const bf16x8 b0=*reinterpret_cast<const bf16x8*>(kb+d0*2048);
    const bf16x8 b1=*reinterpret_cast<const bf16x8*>(kb+d0*2048+512);
    p0=__builtin_amdgcn_mfma_f32_32x32x16_bf16(b0,qr[d0],p0,0,0,0);p1=__builtin_amdgcn_mfma_f32_32x32x16_bf16(b1,qr[d0],p1,0,0,0);}
}
typedef __attribute__((address_space(3))) const char* lds_cptr;
typedef short v4i16_t __attribute__((ext_vector_type(4)));
__device__ __forceinline__ void kload8(bf16x8*kf,lds_cptr kp){
  kf[0]=*(const __attribute__((address_space(3))) bf16x8*)(kp);      kf[1]=*(const __attribute__((address_space(3))) bf16x8*)(kp+512);
  kf[2]=*(const __attribute__((address_space(3))) bf16x8*)(kp+2048); kf[3]=*(const __attribute__((address_space(3))) bf16x8*)(kp+2560);
  kf[4]=*(const __attribute__((address_space(3))) bf16x8*)(kp+4096); kf[5]=*(const __attribute__((address_space(3))) bf16x8*)(kp+4608);
  kf[6]=*(const __attribute__((address_space(3))) bf16x8*)(kp+6144); kf[7]=*(const __attribute__((address_space(3))) bf16x8*)(kp+6656);
}
__device__ __forceinline__ void kload2(bf16x8*kf,lds_cptr kp,int j){ kf[2*j]=*(const __attribute__((address_space(3))) bf16x8*)(kp+j*2048); kf[2*j+1]=*(const __attribute__((address_space(3))) bf16x8*)(kp+j*2048+512); }
__device__ __forceinline__ s16x4 vtr(lds_cptr p){ return __builtin_bit_cast(s16x4,__builtin_amdgcn_ds_read_tr16_b64_v4i16((__attribute__((address_space(3))) v4i16_t*)p)); }
__device__ __forceinline__ float rowmax(const f32x16&p0,const f32x16&p1){
  float a=max3f(p0[0],p0[1],p1[0]),b=max3f(p0[2],p0[3],p1[1]);a=max3f(a,p1[2],p1[3]);
  #pragma unroll
  for(int r=4;r<16;r+=4){a=max3f(a,p0[r],p0[r+1]);b=max3f(b,p0[r+2],p0[r+3]);a=max3f(a,p1[r],p1[r+1]);b=max3f(b,p1[r+2],p1[r+3]);}
  const float m=max2f(a,b);
  auto rr=__builtin_amdgcn_permlane32_swap(__float_as_uint(m),__float_as_uint(m),false,false);
  return max2f(__uint_as_float(rr[0]),__uint_as_float(rr[1]));
}
__device__ __forceinline__ void pv(f32x16*o,int vb,bf16x8 pa0,bf16x8 pa1,bf16x8 pa2,bf16x8 pa3){
  #pragma unroll
  for(int d0=0;d0<2;++d0){s16x4 lo[4],hi[4];
    #pragma unroll
    for(int ks=0;ks<4;++ks){
      asm volatile("ds_read_b64_tr_b16 %0,%1 offset:%c2":"=&v"(lo[ks]):"v"(vb),"i"(d0*4096+ks*1024):"memory");
      asm volatile("ds_read_b64_tr_b16 %0,%1 offset:%c2":"=&v"(hi[ks]):"v"(vb),"i"(d0*4096+ks*1024+512):"memory");}
    asm volatile("s_waitcnt lgkmcnt(0)":::"memory");SBAR();
    #define PK(k) (bf16x8){lo[k][0],lo[k][1],lo[k][2],lo[k][3],hi[k][0],hi[k][1],hi[k][2],hi[k][3]}
    o[d0]=__builtin_amdgcn_mfma_f32_32x32x16_bf16(pa0,PK(0),o[d0],0,0,0);
    o[d0]=__builtin_amdgcn_mfma_f32_32x32x16_bf16(pa1,PK(1),o[d0],0,0,0);
    o[d0]=__builtin_amdgcn_mfma_f32_32x32x16_bf16(pa2,PK(2),o[d0],0,0,0);
    o[d0]=__builtin_amdgcn_mfma_f32_32x32x16_bf16(pa3,PK(3),o[d0],0,0,0);
    #undef PK
  }
}

#ifndef ATTN_STORE16
#define ATTN_STORE16(p,v) (*(u32x4*)(p)=(v))
#endif
template<int THRL> __device__ __forceinline__ void attn_unit(int b,int h,int qb,const bf16*Q,const bf16*__restrict__ K,const bf16*__restrict__ V,bf16*O,const float*__restrict__ LFt,bool newbh,char*shm){
  int tid=threadIdx.x; asm volatile("":"+v"(tid)); const int lane=tid&63,r32=lane&31,hi=lane>>5; const int wid=__builtin_amdgcn_readfirstlane(tid>>6);
  const long rowbase=(long)b*SEQ; const int q0=qb*QB;
  const bf16*Qw=Q+(rowbase+q0+wid*QBLK)*DM+h*D;
  const bf16*Kh=K+rowbase*DM+h*D,*Vh=V+rowbase*DM+h*D;
  const unsigned lds0=(unsigned)(uintptr_t)shm;
  float*wsf=(float*)(shm+LDS_WS)+wid*64;
  const bf16*ksrc=Kh+(long)lane*DM+wid*8;
  const bf16*vsrc=Vh+(long)(16*(wid&3)+(lane>>2))*DM+(wid>>2)*32+(lane&3)*8;
  const unsigned kdst=lds0+LDS_K+wid*1024, vdst=lds0+LDS_V+wid*1024;
  #define DMA_K(t,slot) glds16(ksrc+(long)(t)*KVBLK*DM,(unsigned)__builtin_amdgcn_readfirstlane(kdst+(slot)))
  #define DMA_V(t,slot) glds16(vsrc+(long)(t)*KVBLK*DM,(unsigned)__builtin_amdgcn_readfirstlane(vdst+(slot)))
  const int vb0=(int)(lds0+LDS_V)+((lane>>4)&1)*32+(lane&3)*8+(4*hi+((lane&15)>>2))*64;
  const char*Kbase=shm+LDS_K; bf16x8 kf[8];
  const lds_cptr shm3=(lds_cptr)shm; const lds_cptr kp0=shm3+LDS_K+hi*1024+r32*16; const lds_cptr vp0=shm3+LDS_V+((lane>>4)&1)*32+(lane&3)*8+(4*hi+((lane&15)>>2))*64;
  const int NT=(q0+QB)/KVBLK;
  if(newbh){
    typedef __attribute__((address_space(3))) char* lds_wptr; const lds_wptr shmw=(lds_wptr)shm;
    const float*lp=LFt+((long)(b*NHEAD+h)*SEQ+16*tid);
    const f32x4_t a0=*(const f32x4_t*)lp,a1=*(const f32x4_t*)(lp+4),a2=*(const f32x4_t*)(lp+8),a3=*(const f32x4_t*)(lp+12);
    const float v_[16]={a0[0],a0[1],a0[2],a0[3],a1[0],a1[1],a1[2],a1[3],a2[0],a2[1],a2[2],a2[3],a3[0],a3[1],a3[2],a3[3]};
    float loc=0.f;
    #pragma unroll
    for(int i=0;i<16;++i)loc+=v_[i];
    float inc=loc;
    #pragma unroll
    for(int o_=1;o_<64;o_<<=1){const float t_=__shfl_up(inc,o_); if(lane>=o_)inc+=t_;}
    __attribute__((address_space(3))) float*wt=(__attribute__((address_space(3))) float*)(shmw+LDS_SCAN);
    if(lane==63)wt[wid]=inc;
    asm volatile("s_waitcnt vmcnt(0) lgkmcnt(0)\n\ts_barrier":::"memory");
    float run=inc-loc;
    #pragma unroll
    for(int w_=0;w_<NW;++w_){const float tw=wt[w_]; if(w_<wid)run+=tw;}
    __attribute__((address_space(3))) u32x4*kxw=(__attribute__((address_space(3))) u32x4*)(shmw+LDS_KX+tid*128);
    #pragma unroll
    for(int i=0;i<16;i+=2){ run+=v_[i]; const u32x2_t e0=split3(run*(-1.4426950408889634f)); run+=v_[i+1]; const u32x2_t e1=split3(run*(-1.4426950408889634f)); kxw[i>>1]=(u32x4){e0.x,e0.y,e1.x,e1.y}; }
    asm volatile("s_waitcnt lgkmcnt(0)\n\ts_barrier":::"memory");
  }
  DMA_K(0,0);DMA_V(0,0);DMA_K(1,SLOTB);
  bf16x8 qr[4];
  #pragma unroll
  for(int d0=0;d0<4;++d0)qr[d0]=*reinterpret_cast<const bf16x8*>(&Qw[(long)r32*DM+d0*16+hi*8]);
  float mhat=0.f,l_reg=0.f;f32x16 o[2];o[0]=f32x16{};o[1]=f32x16{};bf16x8 qx=mkqx(0.f,hi);u32x2_t kq0,kq1;
  const __attribute__((address_space(3))) char*kxp=shm3+LDS_KX+r32*8;
  #define LDKQ(t) do{ kq0=*(const __attribute__((address_space(3))) u32x2_t*)(kxp+(t)*512); kq1=*(const __attribute__((address_space(3))) u32x2_t*)(kxp+(t)*512+256); }while(0)
  const int qrel=wid*QBLK+r32;
  #define CMASK(P0,P1,t) do{int jb_=(t)-(NT-4); if(jb_>=0)cmask(P0,P1,jb_,qrel,hi);}while(0)
  bool resc=false;
  #define START(P0,P1) do{ const float rm=rowmax(P0,P1); resc=false; \
    { const float dl=rm; mhat=fadd_s(mhat,dl); \
      _Pragma("unroll") for(int r=0;r<16;++r){P0[r]=fsub_s(P0[r],dl);P1[r]=fsub_s(P1[r],dl);} \
      qx=mkqx(-mhat,hi); } \
    _Pragma("unroll") for(int r=0;r<16;++r)P0[r]=__builtin_amdgcn_exp2f(P0[r]); }while(0)
  #define RESC() do{ if(resc){ asm volatile("s_waitcnt lgkmcnt(0)":::"memory"); \
      _Pragma("unroll") for(int d_=0;d_<2;++d_) _Pragma("unroll") for(int r=0;r<16;++r)o[d_][r]*=wsf[crow(r,hi)]; } }while(0)
  f32x16 pA0,pA1,pB0,pB1;
  int sl_prev=0,sl_cur=0,sl_next=SLOTB;
  #define ROT() do{sl_prev=sl_cur;sl_cur=sl_next;sl_next=(sl_next==(NSLOT-1)*SLOTB)?0:sl_next+SLOTB;}while(0)
  DMA_K(2,2*SLOTB);
  WAIT_BAR(3);
  LDKQ(0); qkt(pA0,pA1,Kbase,qr,kxa(kq0),kxa(kq1),qx,r32,hi);asm volatile("s_nop 15\n\ts_nop 7":"+v"(pA0),"+v"(pA1));CMASK(pA0,pA1,0); LDKQ(1);
  START(pA0,pA1);
  _Pragma("unroll") for(int r=0;r<16;++r)pA1[r]=__builtin_amdgcn_exp2f(pA1[r]);
  WAIT_BAR(0);
  DMA_K(3,0);DMA_V(1,SLOTB);
  ROT();
  kload8(kf,kp0+sl_cur);
  WAIT_BAR(2);
  s16x4 vlo[8],vhi[8]; u32x4 pw0,pw1,pw2,pw3;
  #define PKW(P,B) cvtpk_s(P[B],P[B+1])
  #define PAF(k) __builtin_bit_cast(bf16x8,pw##k)
  #define VFR(i) (bf16x8){vlo[i][0],vlo[i][1],vlo[i][2],vlo[i][3],vhi[i][0],vhi[i][1],vhi[i][2],vhi[i][3]}
  #define PIN(x) asm volatile("":"+v"(x))
  #define MX3(a,b,c) __builtin_fmaxf(__builtin_fmaxf((a),(b)),(c))
  #define GAPA(MF,A0,A1,A2,A3,W0,W1,PW) do{ MF; sacc+=A0; sacc+=A1; sacc+=A2; sacc+=A3; PIN(sacc); W0; W1; PIN(PW); SBAR(); }while(0)
  #define EX(v) __builtin_amdgcn_exp2f(v)
  #define GAPB(MF,X,B) do{ MF; X[B]=EX(X[B]); X[B+1]=EX(X[B+1]); X[B+2]=EX(X[B+2]); X[B+3]=EX(X[B+3]); PIN(X); SBAR(); }while(0)
  #define VRD(i) do{ vlo[i]=vtr(vp_+(((i)>>2)*4096+((i)&3)*1024)); vhi[i]=vtr(vp_+(((i)>>2)*4096+((i)&3)*1024+512)); }while(0)
  #define KRD(G,j) do{ if(G){ kload2(kf,kp0+sl_next,j); SBAR(); } }while(0)
  #define STEP(C0,C1,P0,P1,t,GK,GV,GL) do{ SBAR(); \
    const lds_cptr vp_=vp0+sl_prev; \
    VRD(0); SBAR(); float sacc=(P0[0]+P0[1]); \
    GAPA(C0=__builtin_amdgcn_mfma_f32_32x32x16_bf16(kf[0],qr[0],C0,0,0,0), P0[2],P0[3],P0[4],P0[5],     pw0[0]=PKW(P0,0), pw0[1]=PKW(P0,2), pw0); \
    VRD(4); SBAR(); GAPA(C1=__builtin_amdgcn_mfma_f32_32x32x16_bf16(kf[1],qr[0],C1,0,0,0), P0[6],P0[7],P0[8],P0[9],     pw0[2]=PKW(P0,4), pw0[3]=PKW(P0,6), pw0); \
    VRD(1); SBAR(); GAPA(C0=__builtin_amdgcn_mfma_f32_32x32x16_bf16(kf[2],qr[1],C0,0,0,0),   P0[10],P0[11],P0[12],P0[13], pw1[0]=PKW(P0,8), pw1[1]=PKW(P0,10), pw1); \
    VRD(5); SBAR(); GAPA(C1=__builtin_amdgcn_mfma_f32_32x32x16_bf16(kf[3],qr[1],C1,0,0,0),   P0[14],P0[15],P1[0],P1[1],   pw1[2]=PKW(P0,12),pw1[3]=PKW(P0,14), pw1); \
    VRD(2); SBAR(); GAPA(C0=__builtin_amdgcn_mfma_f32_32x32x16_bf16(kf[4],qr[2],C0,0,0,0),   P1[2],P1[3],P1[4],P1[5],     pw2[0]=PKW(P1,0), pw2[1]=PKW(P1,2), pw2); \
    VRD(6); SBAR(); GAPA(C1=__builtin_amdgcn_mfma_f32_32x32x16_bf16(kf[5],qr[2],C1,0,0,0),   P1[6],P1[7],P1[8],P1[9],     pw2[2]=PKW(P1,4), pw2[3]=PKW(P1,6), pw2); \
    VRD(3); SBAR(); GAPA(C0=__builtin_amdgcn_mfma_f32_32x32x16_bf16(kf[6],qr[3],C0,0,0,0),   P1[10],P1[11],P1[12],P1[13], pw3[0]=PKW(P1,8), pw3[1]=PKW(P1,10), pw3); \
    VRD(7); SBAR(); GAPA(C1=__builtin_amdgcn_mfma_f32_32x32x16_bf16(kf[7],qr[3],C1,0,0,0),   P1[14],P1[15],0.f,0.f,       pw3[2]=PKW(P1,12),pw3[3]=PKW(P1,14), pw3); \
    l_reg+=sacc; if(GL){LDKQ((t)+1);} \
    if(GK){DMA_K((t)+3,sl_cur);} if(GV){DMA_V((t)+1,sl_next);} \
    CMASK(C0,C1,t); \
    { float a=MX3(C0[0],C0[1],C1[0]),b=MX3(C0[2],C0[3],C1[1]); a=MX3(a,C1[2],C1[3]); \
      _Pragma("unroll") for(int r=4;r<16;r+=4){a=MX3(a,C0[r],C0[r+1]);b=MX3(b,C0[r+2],C0[r+3]);a=MX3(a,C1[r],C1[r+1]);b=MX3(b,C1[r+2],C1[r+3]);} \
      float rm=__builtin_fmaxf(a,b); { auto rr=__builtin_amdgcn_permlane32_swap(__float_as_uint(rm),__float_as_uint(rm),false,false); rm=__builtin_fmaxf(__uint_as_float(rr[0]),__uint_as_float(rr[1])); } \
      resc=false; \
      if(__builtin_expect(__any(rm>(float)THRL),0)){ const float dl=__builtin_fmaxf(rm,0.f); mhat+=dl; \
        _Pragma("unroll") for(int r=0;r<16;++r){C0[r]-=dl;C1[r]-=dl;} \
        qx=mkqx(-mhat,hi); \
        const float f=__builtin_amdgcn_exp2f(-dl); l_reg*=f; if(hi==0)wsf[r32]=f; resc=true; } } \
    SBAR(); \
    GAPB(o[0]=__builtin_amdgcn_mfma_f32_32x32x16_bf16(PAF(0),VFR(0),o[0],0,0,0), C0,0); \
    GAPB(o[1]=__builtin_amdgcn_mfma_f32_32x32x16_bf16(PAF(0),VFR(4),o[1],0,0,0), C0,4); \
    KRD(GL,0); GAPB(o[0]=__builtin_amdgcn_mfma_f32_32x32x16_bf16(PAF(1),VFR(1),o[0],0,0,0), C0,8); \
    KRD(GL,1); GAPB(o[1]=__builtin_amdgcn_mfma_f32_32x32x16_bf16(PAF(1),VFR(5),o[1],0,0,0), C0,12); \
    KRD(GL,2); GAPB(o[0]=__builtin_amdgcn_mfma_f32_32x32x16_bf16(PAF(2),VFR(2),o[0],0,0,0), C1,0); \
    KRD(GL,3); GAPB(o[1]=__builtin_amdgcn_mfma_f32_32x32x16_bf16(PAF(2),VFR(6),o[1],0,0,0), C1,4); \
    GAPB(o[0]=__builtin_amdgcn_mfma_f32_32x32x16_bf16(PAF(3),VFR(3),o[0],0,0,0), C1,8); \
    GAPB(o[1]=__builtin_amdgcn_mfma_f32_32x32x16_bf16(PAF(3),VFR(7),o[1],0,0,0), C1,12); \
    if(GL){ P0=__builtin_amdgcn_mfma_f32_32x32x16_bf16(kxa(kq0),qx,f32x16{},0,0,0); P1=__builtin_amdgcn_mfma_f32_32x32x16_bf16(kxa(kq1),qx,f32x16{},0,0,0); } \
    }while(0)
  pB0=__builtin_amdgcn_mfma_f32_32x32x16_bf16(kxa(kq0),qx,f32x16{},0,0,0); pB1=__builtin_amdgcn_mfma_f32_32x32x16_bf16(kxa(kq1),qx,f32x16{},0,0,0);
  int t=1;
  #undef CMASK
  #define CMASK(P0,P1,t) do{}while(0)
  for(;t+5<NT;t+=2){
    STEP(pB0,pB1,pA0,pA1,t,true,true,true);     WAIT_BAR(2); RESC(); ROT();
    STEP(pA0,pA1,pB0,pB1,t+1,true,true,true);   WAIT_BAR(2); RESC(); ROT();
  }
  #undef CMASK
  #define CMASK(P0,P1,t) do{int jb_=(t)-(NT-4); if(jb_>=0)cmask(P0,P1,jb_,qrel,hi);}while(0)
  #define ENDW(tt) do{ if((tt)+3<NT){WAIT_BAR(2);} else if((tt)+2<NT){WAIT_BAR(1);} else {WAIT_BAR(0);} }while(0)
  for(;t+1<NT;t+=2){
    STEP(pB0,pB1,pA0,pA1,t,(t+3<NT),(t+1<NT),(t+1<NT));       ENDW(t);   RESC(); ROT();
    STEP(pA0,pA1,pB0,pB1,t+1,(t+4<NT),(t+2<NT),(t+2<NT));     ENDW(t+1); RESC(); ROT();
  }
  STEP(pB0,pB1,pA0,pA1,NT-1,false,false,false); RESC();
  { float sacc=pB0[0]+pB0[1]; _Pragma("unroll") for(int r=2;r<16;++r)sacc+=pB0[r]; _Pragma("unroll") for(int r=0;r<16;++r)sacc+=pB1[r]; l_reg+=sacc;
    pw0=(u32x4){PKW(pB0,0),PKW(pB0,2),PKW(pB0,4),PKW(pB0,6)};pw1=(u32x4){PKW(pB0,8),PKW(pB0,10),PKW(pB0,12),PKW(pB0,14)};pw2=(u32x4){PKW(pB1,0),PKW(pB1,2),PKW(pB1,4),PKW(pB1,6)};pw3=(u32x4){PKW(pB1,8),PKW(pB1,10),PKW(pB1,12),PKW(pB1,14)};
    SBAR(); pv(o,vb0+sl_cur,PAF(0),PAF(1),PAF(2),PAF(3)); }
  #undef PKW
  #undef PAF
  #undef VFR
  #undef PIN
  #undef MX3
  #undef GAPA
  #undef GAPB
  #undef EX
  #undef VRD
  #undef KRD
  #undef STEP
  #undef ENDW
  {auto rr=__builtin_amdgcn_permlane32_swap(__float_as_uint(l_reg),__float_as_uint(l_reg),false,false);l_reg=__uint_as_float(rr[0])+__uint_as_float(rr[1]);}
  if(hi==0)wsf[32+r32]=l_reg;asm volatile("s_waitcnt lgkmcnt(0)":::"memory");
  float rli[16];
  #pragma unroll
  for(int r=0;r<16;++r)rli[r]=__builtin_amdgcn_rcpf(wsf[32+crow(r,hi)]);
  bf16*Ow=O+(rowbase+q0+wid*QBLK)*DM+h*D;
  { bf16*stg=(bf16*)(shm+LDS_OST)+wid*2048;
    #pragma unroll
    for(int r=0;r<16;++r){const int orow=crow(r,hi);
      #pragma unroll
      for(int d0=0;d0<2;++d0)stg[orow*64+d0*32+r32]=__float2bfloat16(o[d0][r]*rli[r]);}
    asm volatile("s_waitcnt lgkmcnt(0)":::"memory");
    #pragma unroll
    for(int i=0;i<4;++i){const int row=i*8+(lane>>3),ch=lane&7; const u32x4 v=*(const u32x4*)(stg+row*64+ch*8); ATTN_STORE16(Ow+(long)row*DM+ch*8,v);} }
  asm volatile("s_waitcnt lgkmcnt(0)\n\ts_barrier":::"memory");
  #undef DMA_K
  #undef DMA_V
  #undef CMASK
  #undef START
  #undef RESC
  #undef ROT
}
constexpr int ATTN_LDS_BYTES=LDS_TOTAL;
struct AttnTensors { const bf16* Q; const bf16* K; const bf16* V; bf16* O; const float* LFt; };
struct AttnUnit { int bh; int qb; };
struct StaticOrder {
  int vcu,G;
  __device__ __forceinline__ explicit StaticOrder(int grid,int v):vcu(v),G(grid){}
  __device__ __forceinline__ bool next(int i,AttnUnit&u)const{ const int v=vcu+(i>>3)*G; if(v>=256)return false; const int s=v&15,r=(i>>1)&3; u.bh=(v>>5)*8+2*r+((v>>4)&1); u.qb=(i&1)?s:31-s; return true; }
  __device__ __forceinline__ void a_ready(const AttnUnit&)const{}
  __device__ __forceinline__ void done(const AttnUnit&)const{}
};
template<class Sched,int THRL=64> __device__ __forceinline__ void attn_phase(char*lds,const AttnTensors&T,const Sched&S){
  AttnUnit u; int pbh=-1;
  for(int i=0;S.next(i,u);++i){ S.a_ready(u); attn_unit<THRL>(u.bh/NHEAD,u.bh%NHEAD,u.qb,T.Q,T.K,T.V,T.O,T.LFt,u.bh!=pbh,lds); pbh=u.bh; S.done(u); }
}
#undef SBAR
#undef WAIT_BAR
}
namespace hg {
#define HLAS __attribute__((address_space(3)))
#define HG_BAR() asm volatile("s_waitcnt lgkmcnt(0)\n\ts_barrier" ::: "memory")
typedef short bf16x8 __attribute__((ext_vector_type(8)));
typedef float f32x4 __attribute__((ext_vector_type(4)));
typedef unsigned u32x4 __attribute__((ext_vector_type(4)));
typedef unsigned u32x2 __attribute__((ext_vector_type(2)));
typedef unsigned short u16;
constexpr int L_QD = 0, L_KI = 17408, L_IVT = 34816, L_KST = 53248, L_AM = 71680, L_TOT = 80896, L_SSQ = 82944, L_DECL = 83456, L_CIN = 83968, L_END = L_CIN + 128 * 272;
constexpr int P_QD = 272, P_T = 144;
constexpr int NUNITS = 4096;
typedef float pk_f32x2 __attribute__((ext_vector_type(2))); typedef __bf16 pk_bf16x2 __attribute__((ext_vector_type(2)));
__device__ __forceinline__ unsigned pk2(float lo, float hi) { const pk_f32x2 v = {lo, hi}; return __builtin_bit_cast(unsigned, __builtin_convertvector(v, pk_bf16x2)); }
__device__ __forceinline__ unsigned f2bf(float f) { return pk2(f, f) & 0xffffu; }
__device__ __forceinline__ float bf2f(unsigned h) { return __builtin_bit_cast(float, h << 16); }
__device__ __forceinline__ float h2f(u16 h) { return (float)__builtin_bit_cast(_Float16, h); }

struct Tensors { const u16* HLF; const u16* HQ; const u16* HI; const u16* HG; u16* US; float* DEC; const float* onorm_g; const float* LB; u16* OG; u16* SFC; float* PB; };

template <bool PA> struct Raw { u16 fl[16]; u16 q[16]; u32x4 iv[2]; };
template <bool PA> __device__ __forceinline__ void load_raw(const Tensors& T, int unit, int tid, Raw<PA>& r) {
    const int bh = unit >> 7, n = unit & 127, b = bh >> 3, h = bh & 7; const size_t rowbase = (size_t)b * 8192 + (size_t)n * 64;
    const int d = tid & 127, qt = tid >> 7;
    const u16* lfp = T.HLF + (rowbase + 16 * qt) * 1024 + 128 * h + d;
#pragma unroll
    for (int i = 0; i < 16; ++i) r.fl[i] = lfp[(size_t)i * 1024];
    if (!PA) { const u16* qp = T.HQ + (rowbase + 16 * qt) * 1024 + 128 * h + d;
#pragma unroll
        for (int i = 0; i < 16; ++i) r.q[i] = qp[(size_t)i * 1024]; }
#pragma unroll
    for (int it = 0; it < 2; ++it) { const int idx = tid + it * 512; const int s = idx >> 4, vg = idx & 15;
        r.iv[it] = *(const u32x4*)(T.HI + (rowbase + s) * 1024 + 128 * h + 8 * vg); }
}
template <bool PA> __device__ __forceinline__ float prep(HLAS unsigned char* L, const Tensors& T, int unit, int h, int tid, const Raw<PA>& r, float Bacc) {
    const int d = tid & 127, qt = tid >> 7;
    float kk[16], cs[16]; float run = 0.f;
    const float lb = T.LB[128 * h + d];
#pragma unroll
    for (int i = 0; i < 16; ++i) kk[i] = h2f(r.fl[i]);
#pragma unroll
    for (int i = 0; i < 16; ++i) { const float sg = __builtin_amdgcn_rcpf(1.0f + __expf(-kk[i])); const float f = lb + (1.0f - lb) * sg;
        kk[i] = (1.0f - lb) * (1.0f - sg); run += __logf(f); cs[i] = run; }
    HLAS float* TOT = (HLAS float*)(L + L_TOT);
    TOT[qt * 128 + d] = run;
    HG_BAR();
    const float t0 = TOT[d], t1 = TOT[128 + d], t2 = TOT[256 + d], t3 = TOT[384 + d];
    const float pre = (qt > 0 ? t0 : 0.f) + (qt > 1 ? t1 : 0.f) + (qt > 2 ? t2 : 0.f);
    const float blast = ((t0 + t1) + t2) + t3;
    {
        unsigned w[8];
#pragma unroll
        for (int i = 0; i < 16; i += 2) {
            const float k0 = kk[i], k1 = kk[i + 1];
            const float e0 = __expf(blast - (pre + cs[i])), e1 = __expf(blast - (pre + cs[i + 1]));
            w[i >> 1] = pk2(k0 * e0, k1 * e1);
        }
        HLAS u32x4* dst = (HLAS u32x4*)(L + L_KST + d * P_T + qt * 32);
        dst[0] = (u32x4){w[0], w[1], w[2], w[3]}; dst[1] = (u32x4){w[4], w[5], w[6], w[7]};
        if (qt == 0) ((HLAS float*)(L + L_DECL))[d] = __expf(blast);
    }
    if (!PA) {
        float q[16];
#pragma unroll
        for (int i = 0; i < 16; ++i) q[i] = bf2f(r.q[i]);
#pragma unroll
        for (int i = 0; i < 16; ++i) { const float bb = pre + cs[i]; const float k = kk[i];
            *(HLAS u16*)(L + L_QD + (16 * qt + i) * P_QD + d * 2) = (u16)f2bf(q[i] * __expf(bb));
            *(HLAS u16*)(L + L_KI + (16 * qt + i) * P_QD + d * 2) = (u16)f2bf(k * __expf(-bb)); }
    }
    return blast;
}
__device__ __forceinline__ int ivt_off(int row, int chunk) { return row * P_T + ((chunk ^ ((row >> 3) & 7)) << 4); }
__device__ __forceinline__ void stage_ivt(HLAS unsigned char* L, const u32x4 (&iv)[2], int tid) {
#pragma unroll
    for (int it = 0; it < 2; ++it) { const int idx = tid + it * 512; const int s = idx >> 4, vg = idx & 15;
        const u32x4 w = iv[it];
#pragma unroll
        for (int j = 0; j < 8; ++j) { const unsigned dw = w[j >> 1]; *(HLAS u16*)(L + L_IVT + ivt_off(8 * vg + j, s >> 3) + (s & 7) * 2) = (u16)((j & 1) ? (dw >> 16) : (dw & 0xffffu)); } }
}
#define HG_MFMA(X, Y, C) __builtin_amdgcn_mfma_f32_16x16x32_bf16((X), (Y), (C), 0, 0, 0)

__device__ __forceinline__ void phaseB(const Tensors& T, int vb, int tid) {
    const int g = vb * 512 + tid, d4 = g & 31, v = (g >> 5) & 127, bh = g >> 12;
    u32x2* p = (u32x2*)T.SFC + ((size_t)(bh * 8) * 128 + v) * 32 + d4;
    const f32x4* dp = (const f32x4*)T.PB + (size_t)(bh * 8) * 32 + d4;
    f32x4 S = (f32x4){0.f, 0.f, 0.f, 0.f};
    u32x2 u[8]; f32x4 dc[8];
#pragma unroll
    for (int j = 0; j < 8; ++j) { u[j] = p[(size_t)j * 4096]; dc[j] = dp[(size_t)j * 32]; }
#pragma unroll
    for (int j = 0; j < 8; ++j) {
        p[(size_t)j * 4096] = (u32x2){pk2(S[0], S[1]), pk2(S[2], S[3])};
        const f32x4 uu = (f32x4){bf2f(u[j].x & 0xffffu), bf2f(u[j].x >> 16), bf2f(u[j].y & 0xffffu), bf2f(u[j].y >> 16)};
        S = dc[j] * S + uu;
    }
}
__device__ __forceinline__ void phaseC_unit(HLAS unsigned char* L, const Tensors& T, int unit, int tid, const Raw<false>& raw, f32x4 (&S)[8]) {
    const int bh = unit >> 7, n = unit & 127, b = bh >> 3, h = bh & 7; const size_t rowbase = (size_t)b * 8192 + (size_t)n * 64;
    const int lane = tid & 63, w = tid >> 6, lr = lane & 15, kq = lane >> 4;
    const int ct = w & 3, wh = w >> 2;
    u32x2 hgt[4];
#pragma unroll
    for (int vi = 0; vi < 4; ++vi) hgt[vi] = *(const u32x2*)(T.HG + (rowbase + 16 * ct + lr) * 1024 + 128 * h + 64 * wh + 16 * vi + 4 * kq);
    prep<false>(L, T, unit, h, tid, raw, 0.f);
    stage_ivt(L, raw.iv, tid);
    {
        HLAS unsigned char* sx = L + L_CIN + (16 * w + lr) * 272 + 8 * kq;
#pragma unroll
        for (int dt = 0; dt < 8; ++dt) *(HLAS u32x2*)(sx + 32 * dt) = (u32x2){pk2(S[dt][0], S[dt][1]), pk2(S[dt][2], S[dt][3])};
    }
    HG_BAR();
    {
        f32x4 ua[8];
#pragma unroll
        for (int dt = 0; dt < 8; ++dt) ua[dt] = (f32x4){0.f, 0.f, 0.f, 0.f};
#pragma unroll
        for (int ks = 0; ks < 2; ++ks) {
            const bf16x8 Y = *(const HLAS bf16x8*)(L + L_IVT + ivt_off(16 * w + lr, 4 * ks + kq));
#pragma unroll
            for (int dt = 0; dt < 8; ++dt) { const bf16x8 X = *(const HLAS bf16x8*)(L + L_KST + (16 * dt + lr) * P_T + (32 * ks + 8 * kq) * 2); ua[dt] = HG_MFMA(X, Y, ua[dt]); }
        }
        const HLAS f32x4* dl = (const HLAS f32x4*)(L + L_DECL);
#pragma unroll
        for (int dt = 0; dt < 8; ++dt) S[dt] = dl[4 * dt + kq] * S[dt] + ua[dt];
    }
#pragma unroll
    for (int sp = 0; sp < 2; ++sp) { const int st = 2 * wh + sp;
        f32x4 a = (f32x4){0.f, 0.f, 0.f, 0.f};
        if (st <= ct) {
#pragma unroll
            for (int ks = 0; ks < 4; ++ks) { const bf16x8 X = *(const HLAS bf16x8*)(L + L_KI + (16 * st + lr) * P_QD + (32 * ks + 8 * kq) * 2);
                const bf16x8 Y = *(const HLAS bf16x8*)(L + L_QD + (16 * ct + lr) * P_QD + (32 * ks + 8 * kq) * 2); a = HG_MFMA(X, Y, a); }
        }
        const int c = 16 * ct + lr, s0 = 16 * st + 4 * kq;
        float m[4];
#pragma unroll
        for (int e = 0; e < 4; ++e) m[e] = (st <= ct && s0 + e <= c) ? a[e] : 0.f;
        *(HLAS u32x2*)(L + L_AM + c * P_T + s0 * 2) = (u32x2){pk2(m[0], m[1]), pk2(m[2], m[3])};
    }
    HG_BAR();
    f32x4 acc[4];
#pragma unroll
    for (int vi = 0; vi < 4; ++vi) acc[vi] = (f32x4){0.f, 0.f, 0.f, 0.f};
#pragma unroll
    for (int vi = 0; vi < 4; ++vi) {
#pragma unroll
        for (int ks = 0; ks < 2; ++ks) { const bf16x8 X = *(const HLAS bf16x8*)(L + L_IVT + ivt_off(64 * wh + 16 * vi + lr, 4 * ks + kq));
            const bf16x8 Y = *(const HLAS bf16x8*)(L + L_AM + (16 * ct + lr) * P_T + (32 * ks + 8 * kq) * 2); acc[vi] = HG_MFMA(X, Y, acc[vi]); }
#pragma unroll
        for (int ks = 0; ks < 4; ++ks) { const bf16x8 Y = *(const HLAS bf16x8*)(L + L_QD + (16 * ct + lr) * P_QD + (32 * ks + 8 * kq) * 2); const bf16x8 X = *(const HLAS bf16x8*)(L + L_CIN + (64 * wh + 16 * vi + lr) * 272 + (32 * ks + 8 * kq) * 2); acc[vi] = HG_MFMA(X, Y, acc[vi]); }
    }
    float ss = 0.f;
#pragma unroll
    for (int vi = 0; vi < 4; ++vi) ss += (acc[vi][0] * acc[vi][0] + acc[vi][1] * acc[vi][1]) + (acc[vi][2] * acc[vi][2] + acc[vi][3] * acc[vi][3]);
    ss += __shfl_xor(ss, 16); ss += __shfl_xor(ss, 32);
    HLAS float* SSQ = (HLAS float*)(L + L_SSQ);
    if (kq == 0) SSQ[wh * 64 + 16 * ct + lr] = ss;
    HG_BAR();
    const float tot = SSQ[16 * ct + lr] + SSQ[64 + 16 * ct + lr];
    const float rstd = 1.0f / sqrtf(tot * (1.0f / 128.0f) + 1e-6f);
    const size_t orow = (rowbase + 16 * ct + lr) * 1024 + 128 * h;
#pragma unroll
    for (int vi = 0; vi < 4; ++vi) { const int v0 = 64 * wh + 16 * vi + 4 * kq;
        const f32x4 gn = *(const f32x4*)(T.onorm_g + 128 * h + v0);
        const u32x2 gg = hgt[vi];
        const float o0 = acc[vi][0] * rstd * gn[0] * bf2f(gg.x & 0xffffu), o1 = acc[vi][1] * rstd * gn[1] * bf2f(gg.x >> 16);
        const float o2 = acc[vi][2] * rstd * gn[2] * bf2f(gg.y & 0xffffu), o3 = acc[vi][3] * rstd * gn[3] * bf2f(gg.y >> 16);
        *(u32x2*)(T.OG + orow + v0) = (u32x2){pk2(o0, o1), pk2(o2, o3)}; }
    HG_BAR();
}
constexpr int A_KST = 0, A_IVT = 34816, A_TOT = 69632, A_DECL = 71680, A_END = 72192;
struct RawA { u16 fl[32]; u32x4 iv[4]; };
__device__ __forceinline__ void load_rawA(const Tensors& T, size_t rowbase, int h, int tid, RawA& r) {
    const int d = tid & 127, qt = tid >> 7;
    const u16* lfp = T.HLF + (rowbase + 32 * qt) * 1024 + 128 * h + d;
#pragma unroll
    for (int i = 0; i < 32; ++i) r.fl[i] = lfp[(size_t)i * 1024];
#pragma unroll
    for (int it = 0; it < 4; ++it) { const int idx = tid + it * 512; const int s = idx >> 4, vg = idx & 15;
        r.iv[it] = *(const u32x4*)(T.HI + (rowbase + s) * 1024 + 128 * h + 8 * vg); }
}
__device__ __forceinline__ int ivtA_off(int row, int chunk) { return row * 272 + ((chunk ^ ((row >> 3) & 7)) << 4); }
__device__ __forceinline__ void phaseA_unit128(HLAS unsigned char* L, const Tensors& T, int h, int tid, const RawA& r, f32x4 (&S)[8], float& Bsum) {
    const int lane = tid & 63, w = tid >> 6, lr = lane & 15, kq = lane >> 4, d = tid & 127, qt = tid >> 7;
    {
        float kk[32], cs[32]; float run = 0.f;
        const float lb = T.LB[128 * h + d];
#pragma unroll
        for (int i = 0; i < 32; ++i) { const float fl = h2f(r.fl[i]); const float sg = __builtin_amdgcn_rcpf(1.0f + __expf(-fl)); const float f = lb + (1.0f - lb) * sg;
            kk[i] = (1.0f - lb) * (1.0f - sg); run += __logf(f); cs[i] = run; }
        HLAS float* TOT = (HLAS float*)(L + A_TOT);
        TOT[qt * 128 + d] = run;
        HG_BAR();
        const float t0 = TOT[d], t1 = TOT[128 + d], t2 = TOT[256 + d], t3 = TOT[384 + d];
        const float pre = (qt > 0 ? t0 : 0.f) + (qt > 1 ? t1 : 0.f) + (qt > 2 ? t2 : 0.f);
        const float blast = ((t0 + t1) + t2) + t3;
        unsigned wv[16];
#pragma unroll
        for (int i = 0; i < 32; i += 2) wv[i >> 1] = pk2(kk[i] * __expf(blast - (pre + cs[i])), kk[i + 1] * __expf(blast - (pre + cs[i + 1])));
        HLAS u32x4* dst = (HLAS u32x4*)(L + A_KST + d * 272 + qt * 64);
#pragma unroll
        for (int j = 0; j < 4; ++j) dst[j] = (u32x4){wv[4 * j], wv[4 * j + 1], wv[4 * j + 2], wv[4 * j + 3]};
        if (qt == 0) ((HLAS float*)(L + A_DECL))[d] = __expf(blast);
        Bsum += blast;
    }
#pragma unroll
    for (int it = 0; it < 4; ++it) { const int idx = tid + it * 512; const int s = idx >> 4, vg = idx & 15; const u32x4 wd = r.iv[it];
#pragma unroll
        for (int j = 0; j < 8; ++j) { const unsigned dw = wd[j >> 1]; *(HLAS u16*)(L + A_IVT + ivtA_off(8 * vg + j, s >> 3) + (s & 7) * 2) = (u16)((j & 1) ? (dw >> 16) : (dw & 0xffffu)); } }
    HG_BAR();
    f32x4 acc[8];
#pragma unroll
    for (int dt = 0; dt < 8; ++dt) acc[dt] = (f32x4){0.f, 0.f, 0.f, 0.f};
#pragma unroll
    for (int ks = 0; ks < 4; ++ks) {
        const bf16x8 Y = *(const HLAS bf16x8*)(L + A_IVT + ivtA_off(16 * w + lr, 4 * ks + kq));
#pragma unroll
        for (int dt = 0; dt < 8; ++dt) { const bf16x8 X = *(const HLAS bf16x8*)(L + A_KST + (16 * dt + lr) * 272 + (32 * ks + 8 * kq) * 2); acc[dt] = HG_MFMA(X, Y, acc[dt]); }
    }
    const HLAS f32x4* dl = (const HLAS f32x4*)(L + A_DECL);
#pragma unroll
    for (int dt = 0; dt < 8; ++dt) S[dt] = dl[4 * dt + kq] * S[dt] + acc[dt];
    HG_BAR();
}
__device__ __forceinline__ void phaseA_all(HLAS unsigned char* L, const Tensors& T, int u0, int cnt, int tid) {
    const int lane = tid & 63, w = tid >> 6, lr = lane & 15, kq = lane >> 4, blk = u0 >> 4, bh = blk >> 3, b = bh >> 3, h = bh & 7;
    const size_t row0 = (size_t)b * 8192 + (size_t)(blk & 7) * 1024;
    const int nu = cnt >> 1;
    f32x4 S[8]; float Bsum = 0.f;
#pragma unroll
    for (int dt = 0; dt < 8; ++dt) S[dt] = (f32x4){0.f, 0.f, 0.f, 0.f};
    RawA cur; load_rawA(T, row0, h, tid, cur);
    for (int i = 0; i < nu; ++i) { RawA nxt; load_rawA(T, row0 + (size_t)128 * (i + 1 < nu ? i + 1 : i), h, tid, nxt); phaseA_unit128(L, T, h, tid, cur, S, Bsum); cur = nxt; }
    u16* sp = T.SFC + ((size_t)blk * 128 + 16 * w + lr) * 128 + 4 * kq;
#pragma unroll
    for (int dt = 0; dt < 8; ++dt) *(u32x2*)(sp + 16 * dt) = (u32x2){pk2(S[dt][0], S[dt][1]), pk2(S[dt][2], S[dt][3])};
    if ((tid >> 7) == 0) T.PB[(size_t)blk * 128 + (tid & 127)] = __expf(Bsum);
}
__device__ __forceinline__ void phaseC_all(HLAS unsigned char* L, const Tensors& T, int u0, int cnt, int tid) {
    const int lane = tid & 63, w = tid >> 6, lr = lane & 15, kq = lane >> 4, blk = u0 >> 4;
    const int kb = blk & 7, blk0 = blk - kb;
    f32x4 S[8];
#pragma unroll
    for (int dt = 0; dt < 8; ++dt) S[dt] = (f32x4){0.f, 0.f, 0.f, 0.f};
    for (int j = 0; j < kb; ++j) {
        const u16* sf = T.SFC + ((size_t)(blk0 + j) * 128 + 16 * w + lr) * 128 + 4 * kq; const float* pb = T.PB + (size_t)(blk0 + j) * 128 + 4 * kq;
#pragma unroll
        for (int dt = 0; dt < 8; ++dt) { const u32x2 s2 = *(const u32x2*)(sf + 16 * dt); const f32x4 p = *(const f32x4*)(pb + 16 * dt);
            S[dt] = p * S[dt] + (f32x4){bf2f(s2.x & 0xffffu), bf2f(s2.x >> 16), bf2f(s2.y & 0xffffu), bf2f(s2.y >> 16)}; }
    }
    Raw<false> cur; load_raw<false>(T, u0, tid, cur);
    for (int i = 0; i < cnt; ++i) { Raw<false> nxt; load_raw<false>(T, u0 + (i + 1 < cnt ? i + 1 : i), tid, nxt); phaseC_unit(L, T, u0 + i, tid, cur, S); cur = nxt; }
}
}

namespace cg = cooperative_groups;
constexpr int NWAVES = 8;
constexpr int BATCH = 4, T = 8192, D = 1024, H = 16, HD = 64, FF = 2816, FF2 = 5632;
constexpr int M = BATCH * T;
constexpr float RMS_EPS = 1e-6f;
constexpr size_t MiB = 1u << 20;
constexpr size_t WS_WQKV = 1 * MiB;
constexpr size_t WS_WO = WS_WQKV + (size_t)3328 * 1024 * 2;
constexpr size_t WS_WUP0 = WS_WO + (size_t)1024 * 1024 * 2;
constexpr size_t WS_WDN0 = WS_WUP0 + (size_t)5632 * 1024 * 2;
constexpr size_t WS_WHIN = WS_WDN0 + (size_t)1024 * 2816 * 2;
constexpr size_t WS_WHO = WS_WHIN + (size_t)4096 * 1024 * 2;
constexpr size_t WS_WUP1 = WS_WHO + (size_t)1024 * 1024 * 2;
constexpr size_t WS_WDN1 = WS_WUP1 + (size_t)5632 * 1024 * 2;
constexpr size_t WS_WEND = WS_WDN1 + (size_t)1024 * 2816 * 2;
constexpr size_t WS_SSQ = 54 * MiB;
constexpr size_t WS_BIG = 56 * MiB;
constexpr size_t WS_Q = WS_BIG, WS_K = WS_BIG + 64 * MiB, WS_V = WS_BIG + 128 * MiB;
constexpr size_t WS_U = WS_BIG;
constexpr size_t WS_HLF = WS_BIG, WS_HQ = WS_BIG + 64 * MiB, WS_HI = WS_BIG + 128 * MiB, WS_HG = WS_BIG + 192 * MiB, WS_US = WS_BIG + 256 * MiB;
constexpr size_t WS_XN = 312 * MiB;
constexpr size_t WS_UH = 240 * MiB;
constexpr size_t WS_LFT = 504 * MiB;
constexpr size_t WS_DEC = 506 * MiB;
constexpr size_t WS_LB = 53 * MiB;
constexpr size_t WS_CWB = 53 * MiB + 65536;
constexpr size_t WS_PROBE = 53 * MiB + 262144;
constexpr size_t WS_BARW = WS_PROBE + 65536;
constexpr size_t WS_RB = 440 * MiB;
constexpr size_t WS_OG = WS_HQ;
constexpr size_t WS_SFC = 504 * MiB;
constexpr size_t WS_PB = 55 * MiB;
constexpr size_t WS_END = 512 * MiB;
static_assert(WS_WEND <= WS_LB && WS_BARW + 65536 <= WS_BIG && WS_U + (size_t)M * FF * 2 <= WS_UH && WS_UH + (size_t)128 * 4 * FF2 * 4 <= WS_XN && WS_V + 64 * MiB <= WS_XN && WS_HG + 64 * MiB <= WS_XN && WS_US + 128 * MiB <= WS_RB && WS_RB + 64 * MiB <= WS_LFT && WS_SFC + 8 * MiB <= WS_END && WS_SSQ + (size_t)M * 16 <= WS_PB && WS_PB + 131072 <= WS_BIG, "d_ws map");
static_assert(WS_HQ == WS_HLF + 64 * MiB && WS_HI == WS_HLF + 128 * MiB && WS_HG == WS_HLF + 192 * MiB, "EpiHgrn buffer order");
constexpr int LDS_BYTES = 155648;
constexpr int LDS_XH = pg8::STAGE_BYTES, LDS_TAPL = LDS_XH + 16384, LDS_RSL = LDS_TAPL + 4096;
static_assert(LDS_RSL + 2048 <= LDS_BYTES - 64, "epilogue LDS areas");
static_assert(attn_body::ATTN_LDS_BYTES <= LDS_BYTES && hg::L_END <= LDS_BYTES && pg8::STAGE_BYTES <= LDS_BYTES, "LDS map");

#define LAS __attribute__((address_space(3)))
typedef unsigned short bf16;
typedef unsigned v4u __attribute__((ext_vector_type(4)));
typedef float f32x4 __attribute__((ext_vector_type(4)));
typedef float pk_f32x2 __attribute__((ext_vector_type(2))); typedef __bf16 pk_bf16x2 __attribute__((ext_vector_type(2)));
__device__ __forceinline__ unsigned pk2(float lo, float hi) { const pk_f32x2 v = {lo, hi}; return __builtin_bit_cast(unsigned, __builtin_convertvector(v, pk_bf16x2)); }
__device__ __forceinline__ unsigned f2bf(float f) { return pk2(f, f) & 0xffffu; }
__device__ __forceinline__ float wave_sum(float v) {
#pragma unroll
    for (int o = 1; o < 64; o <<= 1) v += __shfl_xor(v, o);
    return v;
}
__device__ __forceinline__ void transpose_item(const float* W, int ldw, int K, int nblk, bf16* WT, LAS float* scr, int item, int lane, bool perm_up = false, const float* gain = nullptr) {
    const int kb = item / nblk, nb = item % nblk, k0 = 64 * kb, n0 = 32 * nb;
    const int n0p = !perm_up ? n0 : (n0 < FF ? 256 * (n0 / 128) + (n0 % 128) : 256 * ((n0 - FF) / 128) + 128 + ((n0 - FF) % 128));
#pragma unroll 8
    for (int i = 0; i < 32; ++i) { const int kk = 2 * i + (lane >> 5); scr[kk * 33 + (lane & 31)] = W[(size_t)(k0 + kk) * ldw + n0 + (lane & 31)] * (gain ? gain[k0 + kk] : 1.0f); }
    asm volatile("s_waitcnt lgkmcnt(0)" ::: "memory");
    const int c = lane & 7;
#pragma unroll
    for (int j = 0; j < 4; ++j) { const int n = (lane >> 3) + 8 * j; const LAS float* s = scr + (8 * c) * 33 + n;
        v4u o; o.x = pk2(s[0 * 33], s[1 * 33]); o.y = pk2(s[2 * 33], s[3 * 33]); o.z = pk2(s[4 * 33], s[5 * 33]); o.w = pk2(s[6 * 33], s[7 * 33]);
        *(v4u*)(WT + (size_t)(n0p + n) * K + k0 + 8 * c) = o; }
    asm volatile("s_waitcnt lgkmcnt(0)" ::: "memory");
}
__device__ __forceinline__ void norm_rows_bf16(const float* src, const float* g, bf16* dst, int gw, int NGW, int lane) {
    f32x4 gg[4];
#pragma unroll
    for (int j = 0; j < 4; ++j) gg[j] = ((const f32x4*)g)[lane + 64 * j];
    for (int m = gw; m < M; m += NGW) {
        const f32x4* xr = (const f32x4*)(src + (size_t)m * D) + lane; f32x4 v[4]; float s = 0.f;
#pragma unroll
        for (int j = 0; j < 4; ++j) { v[j] = xr[64 * j]; s += (v[j].x * v[j].x + v[j].y * v[j].y) + (v[j].z * v[j].z + v[j].w * v[j].w); }
        const float rstd = 1.0f / sqrtf(wave_sum(s) * (1.0f / D) + RMS_EPS);
        unsigned long long* o8 = (unsigned long long*)(dst + (size_t)m * D) + lane;
#pragma unroll
        for (int j = 0; j < 4; ++j) o8[64 * j] = (unsigned long long)pk2(v[j].x * rstd * gg[j].x, v[j].y * rstd * gg[j].y) | ((unsigned long long)pk2(v[j].z * rstd * gg[j].z, v[j].w * rstd * gg[j].w) << 32);
    }
}
__device__ __forceinline__ float ubf_lo(unsigned w) { return __builtin_bit_cast(float, w << 16); }
__device__ __forceinline__ float ubf_hi(unsigned w) { return __builtin_bit_cast(float, w & 0xffff0000u); }
template <bool OUT_F32> __device__ __forceinline__ void norm_rows_rb(const bf16* src, const float* g, void* dstv, int gw, int NGW, int lane) {
    f32x4 gg[4];
#pragma unroll
    for (int j = 0; j < 4; ++j) gg[j] = *(const f32x4*)(g + (j >> 1) * 512 + 8 * lane + (j & 1) * 4);
    for (int m = gw; m < M; m += NGW) {
        const v4u a = *(const v4u*)(src + (size_t)m * D + 8 * lane), b = *(const v4u*)(src + (size_t)m * D + 512 + 8 * lane);
        f32x4 v[4] = {(f32x4){ubf_lo(a.x), ubf_hi(a.x), ubf_lo(a.y), ubf_hi(a.y)}, (f32x4){ubf_lo(a.z), ubf_hi(a.z), ubf_lo(a.w), ubf_hi(a.w)},
                      (f32x4){ubf_lo(b.x), ubf_hi(b.x), ubf_lo(b.y), ubf_hi(b.y)}, (f32x4){ubf_lo(b.z), ubf_hi(b.z), ubf_lo(b.w), ubf_hi(b.w)}};
        float s = 0.f;
#pragma unroll
        for (int j = 0; j < 4; ++j) s += (v[j].x * v[j].x + v[j].y * v[j].y) + (v[j].z * v[j].z + v[j].w * v[j].w);
        const float rstd = 1.0f / sqrtf(wave_sum(s) * (1.0f / D) + RMS_EPS);
#pragma unroll
        for (int j = 0; j < 4; ++j) v[j] = v[j] * rstd * gg[j];
        if (OUT_F32) { float* o = (float*)dstv + (size_t)m * D + 8 * lane;
            *(f32x4*)o = v[0]; *(f32x4*)(o + 4) = v[1]; *(f32x4*)(o + 512) = v[2]; *(f32x4*)(o + 516) = v[3];
        } else { bf16* o = (bf16*)dstv + (size_t)m * D + 8 * lane;
            *(v4u*)o = (v4u){pk2(v[0].x, v[0].y), pk2(v[0].z, v[0].w), pk2(v[1].x, v[1].y), pk2(v[1].z, v[1].w)};
            *(v4u*)(o + 512) = (v4u){pk2(v[2].x, v[2].y), pk2(v[2].z, v[2].w), pk2(v[3].x, v[3].y), pk2(v[3].z, v[3].w)}; }
    }
}
__device__ __forceinline__ float bfs(const bf16* p) { return __builtin_bit_cast(float, (unsigned)(*p) << 16); }
__device__ __forceinline__ void conv_fixup(bf16* ACT, const float* UHf, const bf16* CWB, int pm, int tid) {
    const float* cur = UHf + ((size_t)pm * 2 + 0) * 2 * FF2;
    const float* prv = UHf + ((size_t)(pm - 1) * 2 + 1) * 2 * FF2;
    const bool seq0 = (pm & 31) == 0;
    for (int task = tid; task < 704; task += 512) {
        const int r = task / 352, g = task % 352, pn = g >> 4, cl0 = (g & 15) * 8, gc0 = pn * 128 + cl0, pc = pn * 256 + cl0;
        float a[8];
#pragma unroll
        for (int e = 0; e < 8; ++e) { float y[2];
#pragma unroll
            for (int bj = 0; bj < 2; ++bj) { const int pcb = pc + 128 * bj + e, col = bj * FF + gc0 + e;
                const float u0 = cur[pcb], u1 = cur[FF2 + pcb], p254 = seq0 ? 0.f : prv[pcb], p255 = seq0 ? 0.f : prv[FF2 + pcb];
                const float x = r == 0 ? u0 : u1, x1 = r == 0 ? p255 : u0, x2 = r == 0 ? p254 : p255;
                y[bj] = bfs(CWB + 3 * FF2 + col) + bfs(CWB + col) * x2 + bfs(CWB + FF2 + col) * x1 + bfs(CWB + 2 * FF2 + col) * x; }
            a[e] = y[0] * __builtin_amdgcn_rcpf(1.0f + __expf(-y[0])) * y[1]; }
        v4u o; o.x = pk2(a[0], a[1]); o.y = pk2(a[2], a[3]); o.z = pk2(a[4], a[5]); o.w = pk2(a[6], a[7]);
        *(v4u*)(ACT + (size_t)(pm * 256 + r) * FF + gc0) = o;
    }
}
typedef __attribute__((address_space(1))) unsigned gu32;
#define XB_TMO      128
#define XB_XCNT(j)  (256  + 64 * (j))
#define XB_XSUB(j)  (1280 + 64 * (j))
#define XB_XGEN(j)  (2304 + 64 * (j))
#define XB_TOP      3328
#define XB_TOPGEN   3392
#define XCD_BAR_WORDS 3456
#define XB_SPIN_CAP (1u << 18)

__device__ __forceinline__ unsigned xb_ld(unsigned* p)              { return __hip_atomic_load(p, __ATOMIC_RELAXED, __HIP_MEMORY_SCOPE_AGENT); }
__device__ __forceinline__ unsigned xb_add(unsigned* p, unsigned v) { return __hip_atomic_fetch_add(p, v, __ATOMIC_RELAXED, __HIP_MEMORY_SCOPE_AGENT); }
__device__ __forceinline__ unsigned xb_xcc_id() { return (unsigned)__builtin_amdgcn_s_getreg((3 << 11) | 20) & 0xFu; }
#define XB_SPIN(cond, bar) do { unsigned _sp = 0; while (cond) { __builtin_amdgcn_s_sleep(1); \
    if ((++_sp & 255u) == 0u) { if (xb_ld(&(bar)[XB_TMO])) break; if (_sp > XB_SPIN_CAP) { atomicAdd(&(bar)[XB_TMO], 1u); break; } } } } while (0)

struct XcdBarrier {
    unsigned* bar; unsigned x;
    volatile LAS unsigned* st;
};

__device__ __forceinline__ XcdBarrier xcd_barrier_post(unsigned* bar, volatile LAS unsigned* st) {
    XcdBarrier b; b.bar = bar; b.x = xb_xcc_id(); b.st = st;
    if (threadIdx.x == 0) (void)xb_add(&bar[XB_XCNT(b.x)], 1u);
    return b;
}
__device__ __forceinline__ void xcd_barrier_complete(unsigned* bar, unsigned x, unsigned& nloc, unsigned& nx) {
    const unsigned G = gridDim.x * gridDim.y * gridDim.z;
    unsigned sum, cnt, mine, sp = 0u;
    for (;;) {
        sum = 0u; cnt = 0u; mine = 0u;
#pragma unroll
        for (unsigned j = 0; j < 16; ++j) { const unsigned c = xb_ld(&bar[XB_XCNT(j)]); sum += c; cnt += (c > 0u) ? 1u : 0u; mine = (j == x) ? c : mine; }
        if (sum == G) break;
        __builtin_amdgcn_s_sleep(1);
        if ((++sp & 255u) == 0u) { if (xb_ld(&bar[XB_TMO])) break; if (sp > XB_SPIN_CAP) { atomicAdd(&bar[XB_TMO], 1u); break; } }
    }
    nloc = mine > 0u ? mine : 1u; nx = cnt > 0u ? cnt : 1u;
}

__device__ __forceinline__ void xcd_barrier(const XcdBarrier& b) {
    asm volatile("s_waitcnt vmcnt(0)" ::: "memory");
    __syncthreads();
    if (threadIdx.x == 0) {
        unsigned* bar = b.bar;
        __builtin_amdgcn_s_waitcnt(0);
        unsigned nloc = b.st[0], nx = b.st[1];
        if (nloc == 0u) { xcd_barrier_complete(bar, b.x, nloc, nx); b.st[0] = nloc; b.st[1] = nx; }
        const unsigned old = xb_add(&bar[XB_XSUB(b.x)], 1u);
        const unsigned gen = old / nloc;
        if (old + 1u == (gen + 1u) * nloc) {
            __builtin_amdgcn_fence(__ATOMIC_RELEASE, "agent");
            asm volatile("s_waitcnt vmcnt(0)" ::: "memory");
            const unsigned og = xb_add(&bar[XB_TOP], 1u);
            const unsigned tg = og / nx;
            if (og + 1u == (tg + 1u) * nx) xb_add(&bar[XB_TOPGEN], 1u);
            else XB_SPIN(xb_ld(&bar[XB_TOPGEN]) == tg, bar);
            __builtin_amdgcn_fence(__ATOMIC_ACQUIRE, "agent");
            xb_add(&bar[XB_XGEN(b.x)], 1u);
            asm volatile("s_waitcnt vmcnt(0)" ::: "memory");
        } else {
            XB_SPIN(xb_ld(&bar[XB_XGEN(b.x)]) == gen, bar);
            __builtin_amdgcn_fence(__ATOMIC_ACQUIRE, "agent");
            asm volatile("s_waitcnt vmcnt(0)" ::: "memory");
        }
    }
    __syncthreads();
}

__device__ __forceinline__ void norm16_fl(const float* x, const float* g, bf16* XN, const LAS unsigned char* WFL, const float* b_f, float* LFt, int gw, int lane) {
    f32x4 gg[4];
#pragma unroll
    for (int j = 0; j < 4; ++j) gg[j] = ((const f32x4*)g)[lane + 64 * j];
    for (int r = 0; r < 16; ++r) { const int m = 16 * gw + r;
        const f32x4* xr = (const f32x4*)(x + (size_t)m * D) + lane; f32x4 v[4]; float s = 0.f;
#pragma unroll
        for (int j = 0; j < 4; ++j) { v[j] = xr[64 * j]; s += (v[j].x * v[j].x + v[j].y * v[j].y) + (v[j].z * v[j].z + v[j].w * v[j].w); }
        const float rstd = 1.0f / sqrtf(wave_sum(s) * (1.0f / D) + RMS_EPS);
        unsigned long long* o8 = (unsigned long long*)(XN + (size_t)m * D) + lane;
#pragma unroll
        for (int j = 0; j < 4; ++j) o8[64 * j] = (unsigned long long)pk2(v[j].x * rstd * gg[j].x, v[j].y * rstd * gg[j].y) | ((unsigned long long)pk2(v[j].z * rstd * gg[j].z, v[j].w * rstd * gg[j].w) << 32);
    }
    asm volatile("s_waitcnt vmcnt(0)" ::: "memory");
    const int lr = lane & 15, kq = lane >> 4;
    const bf16* arow = XN + (size_t)(16 * gw + lr) * D + 8 * kq;
    f32x4 acc = (f32x4){0.f, 0.f, 0.f, 0.f};
    hg::bf16x8 XA[32];
#pragma unroll
    for (int ks = 0; ks < 32; ++ks) XA[ks] = *(const hg::bf16x8*)(arow + 32 * ks);
    f32x4 acc2 = (f32x4){0.f, 0.f, 0.f, 0.f};
#pragma unroll
    for (int ks = 0; ks < 32; ks += 2) { const hg::bf16x8 Y0 = *(const LAS hg::bf16x8*)(WFL + lr * 2064 + (32 * ks + 8 * kq) * 2), Y1 = *(const LAS hg::bf16x8*)(WFL + lr * 2064 + (32 * ks + 32 + 8 * kq) * 2);
        acc = HG_MFMA(XA[ks], Y0, acc); acc2 = HG_MFMA(XA[ks + 1], Y1, acc2); }
    acc = acc + acc2;
    const int t0 = 16 * gw + 4 * kq, b = t0 >> 13, t = t0 & (T - 1); const float bias = b_f[lr];
    f32x4 lf;
#pragma unroll
    for (int e = 0; e < 4; ++e) { const float z = acc[e] + bias; lf[e] = fminf(z, 0.f) - log1pf(__expf(-fabsf(z))); }
    *(f32x4*)(LFt + (size_t)(b * 16 + lr) * T + t) = lf;
}
template <class T> __device__ __forceinline__ T* opq(T* p) { asm volatile("" : "+s"(p)); return p; }
struct Args { const float* in[16]; float* out; unsigned char* ws; };
#if defined(UP_PLAIN)
#define UP_PLAIN_PROBE() do { pg8::Gemm g2{opq(XN), opq((bf16*)(ws + WS_WUP0)), M, FF2, 1024, 1024}; pg8::StaticOrder S2; S2.init(M, FF2, G, bx); pg8::EpiDummy E2{(bf16*)(ws + WS_BIG + 176 * MiB)}; \
    pg8::gemm_phase<pg8::EpiDummy, pg8::StaticOrder, true, true>(L, g2, S2, E2); } while (0)
#else
#define UP_PLAIN_PROBE() do { } while (0)
#endif
#ifndef REP_WO
#define REP_WO 1
#endif
#ifndef REP_HGA
#define REP_HGA 1
#endif
#ifndef REP_NORM
#define REP_NORM 1
#endif
#ifndef REP_UP
#define REP_UP 1
#endif
#ifndef REP_QKV
#define REP_QKV 1
#endif
#ifndef REP_HIN
#define REP_HIN 1
#endif
#if defined(PROBE_A)
#define SYNC_STAMP() do { xcd_barrier(bar); if (bx == 0 && tid == 0) ((unsigned long long*)(ws + WS_PROBE))[nst] = __builtin_amdgcn_s_memrealtime(); ++nst; } while (0)
#else
#define SYNC_STAMP() xcd_barrier(bar)
#endif
__global__ void __launch_bounds__(NWAVES * 64, 2) fwd_kernel(Args args) {
    extern __shared__ __attribute__((aligned(16))) unsigned char lds[];
    cg::grid_group grid = cg::this_grid();
    LAS unsigned char* L = (LAS unsigned char*)lds;
#define FRESH_TID() ({ int t_ = threadIdx.x; asm volatile("" : "+v"(t_)); t_; })
    const int tid = threadIdx.x, lane = tid & 63, wave = __builtin_amdgcn_readfirstlane(tid >> 6);
    const int G = gridDim.x, bx = blockIdx.x; const int vcu = (G % 8 == 0) ? (bx % 8) * (G / 8) + bx / 8 : bx;
    const int gw = vcu * NWAVES + wave, NGW = G * NWAVES;
    unsigned char* ws = args.ws;
    const float* x = args.in[0]; float* out = args.out;
    bf16* Wqkv_t = (bf16*)(ws + WS_WQKV); bf16* Wo_t = (bf16*)(ws + WS_WO); bf16* Whin_t = (bf16*)(ws + WS_WHIN); bf16* Who_t = (bf16*)(ws + WS_WHO);
    bf16* XN = (bf16*)(ws + WS_XN); bf16* QO = (bf16*)(ws + WS_Q); bf16* U = (bf16*)(ws + WS_U); float* UHf = (float*)(ws + WS_UH);
    float* LFt = (float*)(ws + WS_LFT); bf16* RB = (bf16*)(ws + WS_RB); float* SSQ = (float*)(ws + WS_SSQ);

    int nst = 1;
    if (tid < 2) ((volatile LAS unsigned*)(L + LDS_BYTES - 64))[tid] = 0u;
    __syncthreads();
#if defined(PROBE_A)
    if (bx == 0 && tid == 0) ((unsigned long long*)(ws + WS_PROBE))[0] = __builtin_amdgcn_s_memrealtime();
#endif
    {
        LAS float* scr = (LAS float*)(L + wave * 8704);
        constexpr int WFL_OFF = 8 * 8704;
        { const int t_ = tid;
#pragma unroll
          for (int kk = 0; kk < 2; ++kk) { const int k = 2 * t_ + kk; const f32x4* wp = (const f32x4*)(args.in[2] + (size_t)k * 3088 + 3072);
#pragma unroll
              for (int q4 = 0; q4 < 4; ++q4) { const f32x4 wv = wp[q4];
#pragma unroll
                  for (int e = 0; e < 4; ++e) *(LAS unsigned short*)(L + WFL_OFF + (4 * q4 + e) * 2064 + k * 2) = (unsigned short)f2bf(wv[e]); } }
          __syncthreads(); }
        constexpr int I_QKV = 16 * 96, I_O = 16 * 32, I_UP = 16 * 176, I_DN = 44 * 32, I_HIN = 16 * 128;
        constexpr int NITEMS = I_QKV + 2 * I_O + 2 * I_UP + 2 * I_DN + I_HIN;
#ifndef REP_PRO
#define REP_PRO 1
#endif
        for (int rep = 0; rep < REP_PRO; ++rep)
        for (int it = gw; it < NITEMS; it += NGW) {
            int r = it;
            if (r < I_QKV) { transpose_item(args.in[2], 3088, 1024, 96, Wqkv_t, scr, r, lane); continue; } r -= I_QKV;
            if (r < I_O) { transpose_item(args.in[4], 1024, 1024, 32, Wo_t, scr, r, lane); continue; } r -= I_O;
            if (r < I_O) { transpose_item(args.in[9], 1024, 1024, 32, Who_t, scr, r, lane); continue; } r -= I_O;
            if (r < I_HIN) { transpose_item(args.in[6], 4096, 1024, 128, Whin_t, scr, r, lane, false, args.in[5]); continue; } r -= I_HIN;
            if (r < I_UP) { transpose_item(args.in[11], FF2, 1024, 176, (bf16*)(ws + WS_WUP0), scr, r, lane, true, args.in[10]); continue; } r -= I_UP;
            if (r < I_UP) { transpose_item(args.in[11] + (size_t)1024 * FF2, FF2, 1024, 176, (bf16*)(ws + WS_WUP1), scr, r, lane, true, args.in[10] + 1024); continue; } r -= I_UP;
            if (r < I_DN) { transpose_item(args.in[14], 1024, FF, 32, (bf16*)(ws + WS_WDN0), scr, r, lane); continue; } r -= I_DN;
            transpose_item(args.in[14] + (size_t)FF * 1024, 1024, FF, 32, (bf16*)(ws + WS_WDN1), scr, r, lane);
        }
        for (int i = bx * 512 + tid; i < 2 * 4 * FF2; i += G * 512) { const int l = i / (4 * FF2), k = (i / FF2) & 3, c = i % FF2;
            ((bf16*)(ws + WS_CWB))[i] = (bf16)f2bf(k < 3 ? args.in[12][(size_t)(l * 3 + k) * FF2 + c] : args.in[13][(size_t)l * FF2 + c]); }
        if (bx == 0) for (int c = tid; c < 1024; c += 512) ((float*)(ws + WS_LB))[c] = 1.0f / (1.0f + expf(args.in[7][c] - args.in[7][1024 + c]));
        norm16_fl(x, args.in[1], XN, L + WFL_OFF, args.in[3], LFt, gw, lane);
        if (bx == 0) for (int i = tid; i < XCD_BAR_WORDS; i += 512) ((unsigned*)(ws + WS_BARW))[i] = 0u;
    }
    grid.sync();
    const XcdBarrier bar = xcd_barrier_post((unsigned*)(ws + WS_BARW), (volatile LAS unsigned*)(L + LDS_BYTES - 64));
#if defined(PROBE_A)
    if (bx == 0 && tid == 0) ((unsigned long long*)(ws + WS_PROBE))[nst] = __builtin_amdgcn_s_memrealtime();
#endif
    ++nst;

    { pg8::Gemm g{opq(XN), opq(Wqkv_t), M, 3072, 1024, 1024}; pg8::StaticOrder S; S.init(M, 3072, G, bx);
      pg8::EpiQKV E{QO, LFt, args.in[3], attn_body::C2};
#ifndef NO_EPIQKV_1
      for (int rep = 0; rep < REP_QKV; ++rep) pg8::gemm_phase<pg8::EpiQKV, pg8::StaticOrder, true, true>(L, g, S, E);
#endif
    }
    SYNC_STAMP();
#ifndef REP_ATT
#define REP_ATT 1
#define ATT_O QO
#else
#define ATT_O XN
#endif
    { const attn_body::AttnTensors AT{(const attn_body::bf16*)QO, (const attn_body::bf16*)(ws + WS_K), (const attn_body::bf16*)(ws + WS_V), (attn_body::bf16*)ATT_O, LFt};
      const attn_body::StaticOrder S(G, vcu);
#ifndef NO_ATTN
      for (int rep = 0; rep < REP_ATT; ++rep) attn_body::attn_phase<attn_body::StaticOrder>((char*)lds, AT, S);
#endif
    }
    SYNC_STAMP();
#define LAYER_TAIL(LY, AOP, BOP, BASE) do { \
    { pg8::Gemm g{opq(AOP), opq(BOP), M, 1024, 1024, 1024}; pg8::StaticOrder S; S.init(M, 1024, G, bx); \
      pg8::EpiRes E{BASE, (BASE) ? (const bf16*)nullptr : (const bf16*)RB, RB, SSQ, (LAS float*)(L + LDS_XH)}; \
      for (int rep = 0; rep < ((LY) == 0 ? REP_WO : 1); ++rep) pg8::gemm_phase<pg8::EpiRes, pg8::StaticOrder, true, true>(L, g, S, E); } \
    SYNC_STAMP(); \
    { pg8::Gemm g{opq(RB), opq((bf16*)(ws + ((LY) == 0 ? WS_WUP0 : WS_WUP1))), M, FF2, 1024, 1024}; pg8::StaticOrder S; S.init(M, FF2, G, bx); \
      pg8::EpiUpConv E{U, UHf, (const bf16*)(ws + WS_CWB) + (LY) * 4 * FF2, (LAS pg8::f32x4*)(L + LDS_XH), L + LDS_TAPL, SSQ, (LAS float*)(L + LDS_RSL)}; \
      { pg8::Unit u0; const int t_ = FRESH_TID(); if (S.next(0, u0) && t_ < 256) { const int k = t_ >> 6, ch = (t_ & 63) * 4;     \
          *(LAS pg8::u32x2_e*)(L + LDS_TAPL + k * 512 + (t_ & 63) * 8) = *(const pg8::u32x2_e*)((const bf16*)(ws + WS_CWB) + (LY) * 4 * FF2 + k * FF2 + (ch < 128 ? u0.pn * 128 + ch : FF + u0.pn * 128 + (ch - 128))); } \
        if (S.next(0, u0)) pg8::rstd_commit((LAS float*)(L + LDS_RSL), 0, t_, pg8::rstd_issue(SSQ, u0.pm, t_));     \
        __syncthreads(); } \
      for (int rep = 0; rep < REP_UP; ++rep) pg8::gemm_phase<pg8::EpiUpConv, pg8::StaticOrder, true, true>(L, g, S, E); } \
    UP_PLAIN_PROBE(); \
    SYNC_STAMP(); \
    { pg8::Gemm g{opq(U), opq((bf16*)(ws + ((LY) == 0 ? WS_WDN0 : WS_WDN1))), M, 1024, FF, FF}; pg8::StaticOrder S; S.init(M, 1024, G, bx); \
      { pg8::Unit fu; for (int i = 0; S.next(i, fu); ++i) conv_fixup(U, UHf, (const bf16*)(ws + WS_CWB) + (LY) * 4 * FF2, fu.pm, FRESH_TID()); \
        asm volatile("s_waitcnt vmcnt(0)" ::: "memory"); __syncthreads(); } \
      pg8::EpiRes E{(const float*)nullptr, RB, RB, SSQ, (LAS float*)(L + LDS_XH)}; \
      pg8::gemm_phase<pg8::EpiRes, pg8::StaticOrder, true, true>(L, g, S, E); } \
    SYNC_STAMP(); } while (0)
    LAYER_TAIL(0, ATT_O, Wo_t, x);
    { pg8::Gemm g{opq(RB), opq(Whin_t), M, 4096, 1024, 1024}; pg8::StaticOrder S; S.init(M, 4096, G, bx);
      pg8::EpiHgrn E{(bf16*)(ws + WS_HLF), SSQ, (LAS float*)(L + LDS_RSL)};
      { pg8::Unit u0; const int t_ = FRESH_TID(); if (S.next(0, u0)) pg8::rstd_commit((LAS float*)(L + LDS_RSL), 0, t_, pg8::rstd_issue(SSQ, u0.pm, t_)); __syncthreads(); }
      for (int rep = 0; rep < REP_HIN; ++rep) pg8::gemm_phase<pg8::EpiHgrn, pg8::StaticOrder, true, true>(L, g, S, E); }
    SYNC_STAMP();
    { const hg::Tensors HT{(const hg::u16*)(ws + WS_HLF), (const hg::u16*)(ws + WS_HQ), (const hg::u16*)(ws + WS_HI), (const hg::u16*)(ws + WS_HG), (hg::u16*)(ws + WS_US), (float*)(ws + WS_DEC), args.in[8], (const float*)(ws + WS_LB), (hg::u16*)(ws + WS_OG), (hg::u16*)(ws + WS_SFC), (float*)(ws + WS_PB)};
      const int upw = hg::NUNITS / G;
#ifndef NO_HGA
      for (int rep = 0; rep < REP_HGA; ++rep) hg::phaseA_all(L, HT, vcu * upw, upw, FRESH_TID());
#endif
      SYNC_STAMP();
#ifndef NO_HGC
#ifndef REP_HGC
#define REP_HGC 1
#endif
      for (int rep = 0; rep < REP_HGC; ++rep) hg::phaseC_all(L, HT, vcu * upw, upw, FRESH_TID());
#endif
      SYNC_STAMP(); }
    LAYER_TAIL(1, (bf16*)(ws + WS_OG), Who_t, (const float*)nullptr);
#if defined(PROBE_A)
    if (bx == 0 && tid == 0) { const unsigned long long* ts = (const unsigned long long*)(ws + WS_PROBE); float fa = 0.f, fb = 0.f;
        for (int i = 1; i < nst; ++i) { const float d = (float)(ts[i] - ts[i - 1]) * (1.0f / 400000.0f); if ((PROBE_A >> i) & 1) fa += d; if ((PROBE_B >> i) & 1) fb += d; }
        ((float*)(ws + WS_PROBE + 1024))[0] = fa; ((float*)(ws + WS_PROBE + 1024))[1] = fb; }
    grid.sync();
    norm_rows_rb<true>(RB, args.in[15], out, gw, NGW, FRESH_TID() & 63);
    grid.sync();
    { const float fa = ((const float*)(ws + WS_PROBE + 1024))[0], fb = ((const float*)(ws + WS_PROBE + 1024))[1];
      for (size_t i = (size_t)bx * 512 + tid; i < (size_t)M * D; i += (size_t)G * 512) out[i] = out[i] * (1.0f + fa) + (i == 0 ? 200.0f * fb : 0.f); }
#else
#if defined(EXTRA_SYNCS)
    for (int i = 0; i < EXTRA_SYNCS; ++i) xcd_barrier(bar);
#endif
    norm_rows_rb<true>(RB, args.in[15], out, gw, NGW, FRESH_TID() & 63);
#endif
}

extern "C" void kernel_launch(void* const* d_in, const int* in_sizes, int n_in, void* d_out, int out_size, void* d_ws, size_t ws_size, hipStream_t stream) {
    static int grid = 0;
    if (grid == 0) {
        if (n_in != 16 || in_sizes[0] != M * D || out_size != M * D || ws_size < WS_END) { fprintf(stderr, "kernel_launch: unexpected shapes / workspace (n_in %d, in0 %d, out %d, ws %zu); nothing launched\n", n_in, n_in > 0 ? in_sizes[0] : -1, out_size, ws_size); grid = -1; return; }
        int dev = 0, cus = 0, per_cu = 0;
        if (hipGetDevice(&dev) != hipSuccess || hipDeviceGetAttribute(&cus, hipDeviceAttributeMultiprocessorCount, dev) != hipSuccess) { grid = -1; return; }
        if (hipFuncSetAttribute((const void*)fwd_kernel, hipFuncAttributeMaxDynamicSharedMemorySize, LDS_BYTES) != hipSuccess) { fprintf(stderr, "kernel_launch: hipFuncSetAttribute failed\n"); grid = -1; return; }
        if (hipOccupancyMaxActiveBlocksPerMultiprocessor(&per_cu, (const void*)fwd_kernel, NWAVES * 64, LDS_BYTES) != hipSuccess || per_cu < 1) { fprintf(stderr, "kernel_launch: occupancy query gives %d\n", per_cu); per_cu = 1; }
        (void)hipGetLastError();
        grid = cus;
        if (grid != 256) { fprintf(stderr, "kernel_launch: built for 256 CUs, device has %d; nothing launched\n", cus); grid = -1; return; }
    }
    if (grid < 0) return;
    Args a{};
    for (int i = 0; i < 16; ++i) a.in[i] = (const float*)d_in[i];
    a.out = (float*)d_out; a.ws = (unsigned char*)d_ws;
    void* kargs[] = {&a};
    const hipError_t e = hipLaunchCooperativeKernel((const void*)fwd_kernel, dim3(grid), dim3(NWAVES * 64), kargs, LDS_BYTES, stream);
    if (e != hipSuccess) fprintf(stderr, "kernel_launch: cooperative launch failed: %s\n", hipGetErrorString(e));
}
```

```cpp
#include <hip/hip_runtime.h>
#include <hip/hip_cooperative_groups.h>
#include <hip/hip_bf16.h>
#include <cstdio>
#include <cstdint>
#include <cmath>
namespace pg8 {
#define PG8_LAS __attribute__((address_space(3)))
typedef unsigned short bf16_t;
typedef short bf16x8 __attribute__((ext_vector_type(8)));
typedef float f32x4 __attribute__((ext_vector_type(4)));
typedef unsigned u32x4 __attribute__((ext_vector_type(4)));
constexpr int BM = 256, BK = 64, HALF = 128, HTB = HALF * BK * 2  , STAGE_BYTES = 8 * HTB, NXCD = 8, WGM = 4;

__host__ __device__ __forceinline__ int lds_byte(int r, int c) { const int st = (r >> 4) * 2 + (c >> 5), rr = r & 15, cc = c & 31, ob = rr * 64 + cc * 2; return st * 1024 + (ob ^ (((ob >> 9) & 1) << 5)); }
__host__ __device__ __forceinline__ void stage_rc(int b, int& R, int& C) { const int st = b / 1024, sb = b % 1024, swz = sb ^ (((sb >> 9) & 1) << 5); R = (st >> 1) * 16 + swz / 64; C = (st & 1) * 32 + (swz % 64) / 2; }
__host__ __device__ __forceinline__ int perm32(int rho) { const int n = rho >> 4, i = rho & 15; return 8 * (i >> 2) + 4 * n + (i & 3); }

struct Unit { int pm, pn, ui, npn, npm; };
struct Gemm { const bf16_t* A; const bf16_t* Bt; int M, N, K, lda; };

struct StaticOrder {
    int nM, nN, nwg, G, c;
    __host__ __device__ __forceinline__ void init(int M, int N, int G_, int c_) { nM = M / BM; nN = N / BM; nwg = nM * nN; G = G_; c = c_; }
    __host__ __device__ __forceinline__ bool next(int i, Unit& u) const {
        const long L = (long)i * G + c; if (L >= nwg) return false;
        int wgid = (int)L; { const int q = nwg / NXCD, r = nwg % NXCD, xcd = wgid % NXCD, off = wgid / NXCD; wgid = (xcd < r ? xcd * (q + 1) : r * (q + 1) + (xcd - r) * q) + off; }
        const int nig = WGM * nN, gid = wgid / nig, fm = gid * WGM, gsz = (nM - fm) < WGM ? (nM - fm) : WGM;
        u.pm = fm + ((wgid % nig) % gsz); u.pn = (wgid % nig) / gsz; return true;
    }
    __device__ __forceinline__ void a_ready(const Unit&) const {}
    __device__ __forceinline__ void done(const Unit&) const {}
};
constexpr int MTOK = 32768, DMODEL = 1024, SEQL = 8192, FFN2 = 5632, FFN1 = 2816;
__device__ __forceinline__ unsigned cvt_pk_bf16(float lo, float hi) { unsigned r; asm volatile("v_cvt_pk_bf16_f32 %0, %1, %2" : "=v"(r) : "v"(lo), "v"(hi)); return r; }
typedef _Float16 h16x2 __attribute__((ext_vector_type(2)));
typedef unsigned u32x2_e __attribute__((ext_vector_type(2)));
__device__ __forceinline__ unsigned cvt_pk_f16(float lo, float hi) { h16x2 v = {(_Float16)lo, (_Float16)hi}; return __builtin_bit_cast(unsigned, v); }
__device__ __forceinline__ float bf_lo(unsigned w) { return __builtin_bit_cast(float, w << 16); }
__device__ __forceinline__ float bf_hi(unsigned w) { return __builtin_bit_cast(float, w & 0xffff0000u); }
__device__ __forceinline__ float silu_f(float x) { return x * __builtin_amdgcn_rcpf(1.0f + __expf(-x)); }

struct EpiQKV {
    static constexpr bool PERM = true, AFTER_DRAIN = false;
    bf16_t* QKV; float* LFt; const float* b_f; float scale0;
    __device__ __forceinline__ void operator()(const f32x4 (&acc)[2][2][4][2], const Unit& u, int wr, int wc, int fr, int fq) const {
        const int row0 = u.pm * BM + wr * 64 + fr;
        if (u.pn < 12) {
            const int part = u.pn >> 2; bf16_t* base = QKV + (size_t)part * ((size_t)MTOK * DMODEL);
            const float sc = part == 0 ? scale0 : 1.f; const int col0 = (u.pn & 3) * BM + wc * 32 + 8 * fq;
#pragma unroll
            for (int ai = 0; ai < 2; ++ai)
#pragma unroll
                for (int m = 0; m < 4; ++m) { bf16_t* rowp = base + (size_t)(row0 + ai * HALF + m * 16) * DMODEL + col0;
#pragma unroll
                    for (int bj = 0; bj < 2; ++bj) { const f32x4 v0 = acc[ai][bj][m][0] * sc, v1 = acc[ai][bj][m][1] * sc;
                        u32x4 w; w.x = cvt_pk_bf16(v0[0], v0[1]); w.y = cvt_pk_bf16(v0[2], v0[3]); w.z = cvt_pk_bf16(v1[0], v1[1]); w.w = cvt_pk_bf16(v1[2], v1[3]);
                        *(u32x4*)(rowp + bj * HALF) = w; } }
        } else if (wc == 0 && fq < 2) {
            float bias[8];
#pragma unroll
            for (int e = 0; e < 8; ++e) bias[e] = b_f[8 * fq + e];
#pragma unroll
            for (int ai = 0; ai < 2; ++ai)
#pragma unroll
                for (int m = 0; m < 4; ++m) { const int row = row0 + ai * HALF + m * 16; const int b = row >> 13, t = row & (SEQL - 1);
#pragma unroll
                    for (int n = 0; n < 2; ++n)
#pragma unroll
                        for (int e = 0; e < 4; ++e) { const int hh = 8 * fq + 4 * n + e; const float z = acc[ai][0][m][n][e] + bias[4 * n + e];
                            const float lf = fminf(z, 0.f) - log1pf(__expf(-fabsf(z)));
                            LFt[(size_t)(b * 16 + hh) * SEQL + t] = lf; } }
        }
    }
};
struct EpiRes {
    static constexpr bool PERM = true, AFTER_DRAIN = false;
    const float* basef; const bf16_t* baseb; bf16_t* out; float* SSQ; PG8_LAS float* XS;
    __device__ __forceinline__ void operator()(const f32x4 (&acc)[2][2][4][2], const Unit& u, int wr, int wc, int fr, int fq) const {
        const int col0 = u.pn * BM + wc * 32 + 8 * fq;
#pragma unroll
        for (int ai = 0; ai < 2; ++ai)
#pragma unroll
            for (int m = 0; m < 4; ++m) { const size_t off = (size_t)(u.pm * BM + ai * HALF + wr * 64 + m * 16 + fr) * DMODEL + col0;
                f32x4 b[2][2];
                if (basef) {
#pragma unroll
                    for (int bj = 0; bj < 2; ++bj) { b[bj][0] = *(const f32x4*)(basef + off + bj * HALF); b[bj][1] = *(const f32x4*)(basef + off + bj * HALF + 4); }
                } else {
#pragma unroll
                    for (int bj = 0; bj < 2; ++bj) { const u32x4 w = *(const u32x4*)(baseb + off + bj * HALF);
                        b[bj][0] = (f32x4){bf_lo(w.x), bf_hi(w.x), bf_lo(w.y), bf_hi(w.y)}; b[bj][1] = (f32x4){bf_lo(w.z), bf_hi(w.z), bf_lo(w.w), bf_hi(w.w)}; }
                }
                float ss = 0.f;
#pragma unroll
                for (int bj = 0; bj < 2; ++bj) { const f32x4 v0 = b[bj][0] + acc[ai][bj][m][0], v1 = b[bj][1] + acc[ai][bj][m][1];
                    ss += ((v0[0] * v0[0] + v0[1] * v0[1]) + (v0[2] * v0[2] + v0[3] * v0[3])) + ((v1[0] * v1[0] + v1[1] * v1[1]) + (v1[2] * v1[2] + v1[3] * v1[3]));
                    u32x4 w; w.x = cvt_pk_bf16(v0[0], v0[1]); w.y = cvt_pk_bf16(v0[2], v0[3]); w.z = cvt_pk_bf16(v1[0], v1[1]); w.w = cvt_pk_bf16(v1[2], v1[3]);
                    *(u32x4*)(out + off + bj * HALF) = w; }
                ss += __shfl_xor(ss, 16); ss += __shfl_xor(ss, 32);
                if (fq == 0) XS[(ai * HALF + wr * 64 + m * 16 + fr) * 4 + wc] = ss;
                if (m & 1) asm volatile("" ::: "memory"); }
        asm volatile("s_waitcnt lgkmcnt(0)" ::: "memory"); __builtin_amdgcn_s_barrier(); asm volatile("" ::: "memory");
        { const int t = (wr * 4 + wc) * 64 + fq * 16 + fr;
          if (t < 256) { const f32x4 p = *(const PG8_LAS f32x4*)(XS + t * 4); SSQ[(size_t)(u.pm * BM + t) * 4 + u.pn] = (p[0] + p[1]) + (p[2] + p[3]); } }
    }
};
__device__ __forceinline__ f32x4 rstd_issue(const float* SSQ, int pm, int t) { return t < 256 ? *(const f32x4*)(SSQ + (size_t)(pm * BM + t) * 4) : (f32x4){0.f, 0.f, 0.f, 0.f}; }
__device__ __forceinline__ void rstd_commit(PG8_LAS float* RSL, int buf, int t, const f32x4& p) { if (t < 256) RSL[buf * 256 + t] = 1.0f / sqrtf(((p[0] + p[1]) + (p[2] + p[3])) * (1.0f / DMODEL) + 1e-6f); }
__device__ __forceinline__ void scale_rows(const f32x4 (&acc)[2][2][4][2], const PG8_LAS float* RSL, int buf, int wr, int fr) {
    f32x4 (&a_)[2][2][4][2] = const_cast<f32x4 (&)[2][2][4][2]>(acc);
#pragma unroll
    for (int ai = 0; ai < 2; ++ai)
#pragma unroll
        for (int m = 0; m < 4; ++m) { const float r = RSL[buf * 256 + ai * HALF + wr * 64 + m * 16 + fr];
#pragma unroll
            for (int bj = 0; bj < 2; ++bj)
#pragma unroll
                for (int n = 0; n < 2; ++n) a_[ai][bj][m][n] = a_[ai][bj][m][n] * r; }
}
template <int CTRL> __device__ __forceinline__ float dppz(float x) { return __builtin_bit_cast(float, __builtin_amdgcn_update_dpp(0, __builtin_bit_cast(int, x), CTRL, 0xf, 0xf, true)); }
struct EpiUpConv {
    static constexpr bool PERM = true, AFTER_DRAIN = false;
    bf16_t* ACT; float* UHf; const bf16_t* CWB; PG8_LAS f32x4* XH; PG8_LAS unsigned char* TAPL; const float* SSQ; PG8_LAS float* RSL;
    __device__ __forceinline__ void operator()(const f32x4 (&acc)[2][2][4][2], const Unit& u, int wr, int wc, int fr, int fq) const {
        typedef unsigned u32x2 __attribute__((ext_vector_type(2)));
        const int cl0 = wc * 32 + 8 * fq, gc0 = u.pn * HALF + cl0;
        const int tid0_ = (wr * 4 + wc) * 64 + fq * 16 + fr; const f32x4 nstat = rstd_issue(SSQ, u.npm, tid0_);
        scale_rows(acc, RSL, u.ui & 1, wr, fr);
        if (fr >= 14) {
#pragma unroll
            for (int ai = 0; ai < 2; ++ai) { PG8_LAS f32x4* dst = XH + ((((ai * 2 + wr) * 4 + wc) * 4 + fq) * 2 + (fr - 14)) * 4;
                dst[0] = acc[ai][0][3][0]; dst[1] = acc[ai][0][3][1]; dst[2] = acc[ai][1][3][0]; dst[3] = acc[ai][1][3][1]; }
        }
        if (wr == 0 && fr < 2) { float* p = UHf + (((size_t)u.pm * 2 + 0) * 2 + fr) * FFN2 + u.pn * BM + cl0;
            *(f32x4*)p = acc[0][0][0][0]; *(f32x4*)(p + 4) = acc[0][0][0][1]; *(f32x4*)(p + HALF) = acc[0][1][0][0]; *(f32x4*)(p + HALF + 4) = acc[0][1][0][1]; }
        if (wr == 1 && fr >= 14) { float* p = UHf + (((size_t)u.pm * 2 + 1) * 2 + (fr - 14)) * FFN2 + u.pn * BM + cl0;
            *(f32x4*)p = acc[1][0][3][0]; *(f32x4*)(p + 4) = acc[1][0][3][1]; *(f32x4*)(p + HALF) = acc[1][1][3][0]; *(f32x4*)(p + HALF + 4) = acc[1][1][3][1]; }
        const int tid_ = (wr * 4 + wc) * 64 + fq * 16 + fr; u32x2 ntap = (u32x2){0u, 0u};
        if (tid_ < 256) { const int k = tid_ >> 6, ch = (tid_ & 63) * 4; ntap = *(const u32x2*)(CWB + k * FFN2 + (ch < HALF ? u.npn * HALF + ch : FFN1 + u.npn * HALF + (ch - HALF))); }
        asm volatile("s_waitcnt lgkmcnt(0)" ::: "memory"); __builtin_amdgcn_s_barrier(); asm volatile("" ::: "memory");
        const PG8_LAS unsigned char* tapb = TAPL + (u.ui & 1) * 2048 + cl0 * 2;
#define PG8_FD(Y, X, T, CTRL) asm("v_fmac_f32_dpp %0, %1, %2 " CTRL " row_mask:0xf bank_mask:0xf bound_ctrl:1" : "+v"(Y) : "v"(X), "v"(T))
#pragma unroll
        for (int n = 0; n < 2; ++n) {
            float tp[2][4][4];
#pragma unroll
            for (int bj = 0; bj < 2; ++bj)
#pragma unroll
                for (int k = 0; k < 4; ++k) { const u32x2 w = *(const PG8_LAS u32x2*)(tapb + k * 512 + bj * 256 + 8 * n);
                    tp[bj][k][0] = bf_lo(w.x); tp[bj][k][1] = bf_hi(w.x); tp[bj][k][2] = bf_lo(w.y); tp[bj][k][3] = bf_hi(w.y); }
#pragma unroll
            for (int ai = 0; ai < 2; ++ai) {
                const bool has = (wr == 1) || (ai == 1);
                const int pai = (wr == 1) ? ai : 0, pwr = (wr == 1) ? 0 : 1;
                const PG8_LAS f32x4* hsrc = XH + (((pai * 2 + pwr) * 4 + wc) * 4 + fq) * 8;
#pragma unroll
                for (int m = 0; m < 4; ++m) {
                    float yg[4];
#pragma unroll
                    for (int bj = 0; bj < 2; ++bj) {
                        const f32x4 x = acc[ai][bj][m][n];
                        f32x4 h14 = (f32x4){0.f, 0.f, 0.f, 0.f}, h15 = h14;
                        if (m == 0 && has) { h14 = hsrc[bj * 2 + n]; h15 = hsrc[4 + bj * 2 + n]; }
                        const f32x4 xp = acc[ai][bj][m > 0 ? m - 1 : 0][n];
#pragma unroll
                        for (int e = 0; e < 4; ++e) { const float t0 = tp[bj][0][e], t1 = tp[bj][1][e];
                            float y = tp[bj][2][e] * x[e] + tp[bj][3][e];
                            if (m == 0) { y += t1 * (fr == 0 ? h15[e] : 0.f); y += t0 * (fr == 0 ? h14[e] : (fr == 1 ? h15[e] : 0.f)); }
                            else { PG8_FD(y, xp[e], t1, "row_shl:15"); PG8_FD(y, xp[e], t0, "row_shl:14"); }
                            PG8_FD(y, x[e], t1, "row_shr:1"); PG8_FD(y, x[e], t0, "row_shr:2");
                            if (bj == 0) yg[e] = y; else yg[e] = silu_f(yg[e]) * y; }
                    }
                    *(u32x2*)(ACT + (size_t)(u.pm * BM + ai * HALF + wr * 64 + m * 16 + fr) * FFN1 + gc0 + 4 * n) = (u32x2){cvt_pk_bf16(yg[0], yg[1]), cvt_pk_bf16(yg[2], yg[3])};
                }
            }
        }
#undef PG8_FD
        if (tid_ < 256) *(PG8_LAS u32x2*)(TAPL + ((u.ui + 1) & 1) * 2048 + (tid_ >> 6) * 512 + (tid_ & 63) * 8) = ntap;
        rstd_commit(RSL, (u.ui + 1) & 1, tid0_, nstat);
    }
};
struct EpiDummy {
    static constexpr bool PERM = true, AFTER_DRAIN = false;
    bf16_t* O;
    __device__ __forceinline__ void operator()(const f32x4 (&acc)[2][2][4][2], const Unit& u, int wr, int wc, int fr, int fq) const {
        const int row0 = u.pm * BM + wr * 64 + fr, col0 = u.pn * HALF + wc * 32 + 8 * fq;
#pragma unroll
        for (int ai = 0; ai < 2; ++ai)
#pragma unroll
            for (int m = 0; m < 4; ++m) { const f32x4 v0 = acc[ai][0][m][0] + acc[ai][1][m][0], v1 = acc[ai][0][m][1] + acc[ai][1][m][1];
                u32x4 w; w.x = cvt_pk_bf16(v0[0], v0[1]); w.y = cvt_pk_bf16(v0[2], v0[3]); w.z = cvt_pk_bf16(v1[0], v1[1]); w.w = cvt_pk_bf16(v1[2], v1[3]);
                *(u32x4*)(O + (size_t)(row0 + ai * HALF + m * 16) * FFN1 + col0) = w; }
    }
};
struct EpiHgrn {
    static constexpr bool PERM = true, AFTER_DRAIN = false;
    bf16_t* HB; const float* SSQ; PG8_LAS float* RSL;
    __device__ __forceinline__ void operator()(const f32x4 (&acc)[2][2][4][2], const Unit& u, int wr, int wc, int fr, int fq) const {
        const int part = u.pn >> 2; const int row0 = u.pm * BM + wr * 64 + fr, col0 = (u.pn & 3) * BM + wc * 32 + 8 * fq;
        bf16_t* dst = HB + (size_t)(part == 0 ? 1 : (part == 1 ? 0 : part)) * ((size_t)MTOK * DMODEL); const bool act = (part == 0) || (part == 3);
        const int tid0_ = (wr * 4 + wc) * 64 + fq * 16 + fr; const f32x4 nstat = rstd_issue(SSQ, u.npm, tid0_);
        scale_rows(acc, RSL, u.ui & 1, wr, fr);
#pragma unroll
        for (int ai = 0; ai < 2; ++ai)
#pragma unroll
            for (int m = 0; m < 4; ++m) { bf16_t* rowp = dst + (size_t)(row0 + ai * HALF + m * 16) * DMODEL + col0;
#pragma unroll
                for (int bj = 0; bj < 2; ++bj) { float r[8];
#pragma unroll
                    for (int e = 0; e < 8; ++e) { const float z = acc[ai][bj][m][e >> 2][e & 3]; r[e] = act ? silu_f(z) : z; }
                    u32x4 w;
                    if (part == 1) { w.x = cvt_pk_f16(r[0], r[1]); w.y = cvt_pk_f16(r[2], r[3]); w.z = cvt_pk_f16(r[4], r[5]); w.w = cvt_pk_f16(r[6], r[7]); }
                    else { w.x = cvt_pk_bf16(r[0], r[1]); w.y = cvt_pk_bf16(r[2], r[3]); w.z = cvt_pk_bf16(r[4], r[5]); w.w = cvt_pk_bf16(r[6], r[7]); }
                    *(u32x4*)(rowp + bj * HALF) = w; } }
        rstd_commit(RSL, (u.ui + 1) & 1, tid0_, nstat);
    }
};

template <class Epi, class Sched, bool ALIGN_EPI = false, bool SP2 = false>
__device__ __forceinline__ void gemm_phase(PG8_LAS unsigned char* lds, const Gemm g, const Sched& S, const Epi& E) {
    int tid = threadIdx.x; asm volatile("" : "+v"(tid)); const int wid = __builtin_amdgcn_readfirstlane(tid >> 6), lane = tid & 63, wr = wid >> 2, wc = wid & 3, fr = lane & 15, fq = lane >> 4;
    const int K = g.K, nt = K / BK;
    unsigned voffA[2], voffB[2];
#pragma unroll
    for (int i = 0; i < 2; ++i) { int R, C; stage_rc(tid * 16 + i * 8192, R, C); const int Rb = Epi::PERM ? ((R & ~31) + perm32(R & 31)) : R;
        voffA[i] = (unsigned)(R * g.lda + C) * 2u; voffB[i] = (unsigned)(Rb * K + C) * 2u; }
    const size_t kstep = (size_t)(BK * 2);
    const size_t hstepA = (size_t)HALF * g.lda * 2, hstepB = (size_t)HALF * K * 2;
    const size_t tstepA = 2 * hstepA, tstepB = 2 * hstepB;
    const unsigned ldsw = (unsigned)wid * 1024u;
    const int aoff = lds_byte(wr * 64 + fr, fq * 8), boff = lds_byte(wc * 32 + fr, fq * 8);
#define PG8_SA(b, h) (((b) * 2 + (h)) * HTB)
#define PG8_SB(b, h) ((4 + (b) * 2 + (h)) * HTB)
#define PG8_STAGE(bufoff, gbase, voff) do { _Pragma("unroll") for (int _i = 0; _i < 2; ++_i) \
        __builtin_amdgcn_global_load_lds((const unsigned*)((const char*)(gbase) + (voff)[_i]), (PG8_LAS unsigned*)(lds + (bufoff) + ldsw + _i * 8192), 16, 0, 0); } while (0)
#define PG8_LDA(dst, b, h) do { _Pragma("unroll") for (int m = 0; m < 4; ++m) _Pragma("unroll") for (int k = 0; k < 2; ++k) dst[m][k] = *(const PG8_LAS bf16x8*)(lds + PG8_SA(b, h) + aoff + m * 2048 + k * 1024); } while (0)
#define PG8_LDB(dst, b, h) do { _Pragma("unroll") for (int n = 0; n < 2; ++n) _Pragma("unroll") for (int k = 0; k < 2; ++k) dst[n][k] = *(const PG8_LAS bf16x8*)(lds + PG8_SB(b, h) + boff + n * 2048 + k * 1024); } while (0)
#define PG8_MMA(ai, bj, At, Bt) do { __builtin_amdgcn_s_setprio(1); _Pragma("unroll") for (int m = 0; m < 4; ++m) _Pragma("unroll") for (int n = 0; n < 2; ++n) _Pragma("unroll") for (int k = 0; k < 2; ++k) \
        acc[ai][bj][m][n] = __builtin_amdgcn_mfma_f32_16x16x32_bf16(Bt[n][k], At[m][k], acc[ai][bj][m][n], 0, 0, 0); __builtin_amdgcn_s_setprio(0); } while (0)
#define PG8_WAIT_V(n) asm volatile("s_waitcnt vmcnt(" #n ")" ::: "memory")
#define PG8_WAIT_L(n) asm volatile("s_waitcnt lgkmcnt(" #n ")" ::: "memory")
#define PG8_BAR __builtin_amdgcn_s_barrier()
#define PG8_SCHED __builtin_amdgcn_sched_barrier(0)
    Unit cur, nxt; int ui = 0;
    if (!S.next(0, cur)) return;
    f32x4 acc[2][2][4][2];
#pragma unroll
    for (int a = 0; a < 2; ++a)
#pragma unroll
        for (int b = 0; b < 2; ++b)
#pragma unroll
            for (int m = 0; m < 4; ++m)
#pragma unroll
                for (int n = 0; n < 2; ++n) acc[a][b][m][n] = (f32x4){0.f, 0.f, 0.f, 0.f};
    bf16x8 At[4][2], B0[2][2], B1[2][2];
    const char* cA = (const char*)g.A + (size_t)cur.pm * tstepA; const char* cB = (const char*)g.Bt + (size_t)cur.pn * tstepB;
    S.a_ready(cur);
    if constexpr (SP2) {
        PG8_STAGE(PG8_SB(0, 0), cB, voffB); PG8_STAGE(PG8_SB(0, 1), cB + hstepB, voffB); PG8_STAGE(PG8_SA(0, 0), cA, voffA); PG8_STAGE(PG8_SA(0, 1), cA + hstepA, voffA);
        if (wr == 1) PG8_BAR;
        PG8_WAIT_V(2); PG8_BAR;
        PG8_STAGE(PG8_SB(1, 0), cB + kstep, voffB); PG8_STAGE(PG8_SA(1, 0), cA + kstep, voffA); PG8_STAGE(PG8_SB(1, 1), cB + hstepB + kstep, voffB);
        PG8_WAIT_V(6); PG8_BAR;
    } else {
        PG8_STAGE(PG8_SB(0, 0), cB, voffB); PG8_STAGE(PG8_SA(0, 0), cA, voffA); PG8_STAGE(PG8_SB(0, 1), cB + hstepB, voffB); PG8_STAGE(PG8_SA(0, 1), cA + hstepA, voffA);
        if (wr == 1) PG8_BAR;
        PG8_WAIT_V(4); PG8_BAR;
        PG8_STAGE(PG8_SB(1, 0), cB + kstep, voffB); PG8_STAGE(PG8_SA(1, 0), cA + kstep, voffA); PG8_STAGE(PG8_SB(1, 1), cB + hstepB + kstep, voffB);
        PG8_WAIT_V(6); PG8_BAR;
    }
    for (;;) {
        const bool has_next = S.next(ui + 1, nxt);
        const char* nA = has_next ? (const char*)g.A + (size_t)nxt.pm * tstepA : cA; const char* nB = has_next ? (const char*)g.Bt + (size_t)nxt.pn * tstepB : cB;
        for (int t = 0; t < nt; t += 2) {
            const bool last = (t == nt - 2);
            const char* a1 = cA + (size_t)(t + 1) * kstep;
            const char* a2 = last ? nA : cA + (size_t)(t + 2) * kstep; const char* b2 = last ? nB : cB + (size_t)(t + 2) * kstep;
            const char* a3 = a2 + kstep; const char* b3 = b2 + kstep;
            if (last && has_next) S.a_ready(nxt);
            if constexpr (SP2) {
            PG8_LDB(B0, 0, 0); PG8_LDB(B1, 0, 1); PG8_SCHED; PG8_LDA(At, 0, 0); PG8_STAGE(PG8_SA(1, 1), a1 + hstepA, voffA);
            PG8_WAIT_V(8); PG8_WAIT_L(0); PG8_BAR; PG8_MMA(0, 0, At, B0); PG8_MMA(0, 1, At, B1); PG8_BAR; PG8_SCHED;
            PG8_LDA(At, 0, 1); PG8_STAGE(PG8_SB(0, 0), b2, voffB); PG8_STAGE(PG8_SB(0, 1), b2 + hstepB, voffB); PG8_STAGE(PG8_SA(0, 0), a2, voffA);
            PG8_WAIT_V(8); PG8_WAIT_L(0); PG8_BAR; PG8_MMA(1, 0, At, B0); PG8_MMA(1, 1, At, B1); PG8_BAR; PG8_SCHED;
            PG8_LDB(B0, 1, 0); PG8_LDB(B1, 1, 1); PG8_SCHED; PG8_LDA(At, 1, 0); PG8_STAGE(PG8_SA(0, 1), a2 + hstepA, voffA);
            PG8_WAIT_V(8); PG8_WAIT_L(0); PG8_BAR; PG8_MMA(0, 0, At, B0); PG8_MMA(0, 1, At, B1); PG8_BAR; PG8_SCHED;
            PG8_LDA(At, 1, 1); PG8_STAGE(PG8_SB(1, 0), b3, voffB); PG8_STAGE(PG8_SB(1, 1), b3 + hstepB, voffB); PG8_STAGE(PG8_SA(1, 0), a3, voffA);
            PG8_WAIT_V(8); PG8_WAIT_L(0); PG8_BAR; PG8_MMA(1, 0, At, B0); PG8_MMA(1, 1, At, B1); PG8_BAR; PG8_SCHED;
            } else {
            PG8_LDB(B0, 0, 0); PG8_SCHED; PG8_LDA(At, 0, 0); PG8_STAGE(PG8_SA(1, 1), a1 + hstepA, voffA);
            PG8_WAIT_L(8); PG8_BAR; PG8_WAIT_L(0); PG8_MMA(0, 0, At, B0); PG8_BAR; PG8_SCHED;
            PG8_LDB(B1, 0, 1); PG8_STAGE(PG8_SB(0, 0), b2, voffB);
            PG8_BAR; PG8_WAIT_L(0); PG8_MMA(0, 1, At, B1); PG8_BAR;
            PG8_LDA(At, 0, 1); PG8_STAGE(PG8_SA(0, 0), a2, voffA);
            PG8_BAR; PG8_WAIT_L(0); PG8_MMA(1, 0, At, B0); PG8_BAR; PG8_SCHED;
            PG8_STAGE(PG8_SB(0, 1), b2 + hstepB, voffB);
            PG8_WAIT_V(6); PG8_BAR; PG8_MMA(1, 1, At, B1); PG8_BAR;
            PG8_LDB(B0, 1, 0); PG8_SCHED; PG8_LDA(At, 1, 0); PG8_STAGE(PG8_SA(0, 1), a2 + hstepA, voffA);
            PG8_WAIT_L(8); PG8_BAR; PG8_WAIT_L(0); PG8_MMA(0, 0, At, B0); PG8_BAR; PG8_SCHED;
            PG8_LDB(B1, 1, 1); PG8_STAGE(PG8_SB(1, 0), b3, voffB);
            PG8_BAR; PG8_WAIT_L(0); PG8_MMA(0, 1, At, B1); PG8_BAR;
            PG8_LDA(At, 1, 1); PG8_STAGE(PG8_SA(1, 0), a3, voffA);
            PG8_BAR; PG8_WAIT_L(0); PG8_MMA(1, 0, At, B0); PG8_BAR; PG8_SCHED;
            PG8_STAGE(PG8_SB(1, 1), b3 + hstepB, voffB);
            PG8_WAIT_V(6); PG8_BAR; PG8_MMA(1, 1, At, B1); PG8_BAR;
            }
        }
        if constexpr (ALIGN_EPI) { if (wr == 0) PG8_BAR; }
        if constexpr (!Epi::AFTER_DRAIN) { cur.ui = ui; cur.npn = has_next ? nxt.pn : cur.pn; cur.npm = has_next ? nxt.pm : cur.pm; int l2_ = lane; asm volatile("" : "+v"(l2_)); E(acc, cur, wr, wc, l2_ & 15, l2_ >> 4); S.done(cur); }
        if (!has_next) break;
#pragma unroll
        for (int a = 0; a < 2; ++a)
#pragma unroll
            for (int b = 0; b < 2; ++b)
#pragma unroll
                for (int m = 0; m < 4; ++m)
#pragma unroll
                    for (int n = 0; n < 2; ++n) acc[a][b][m][n] = (f32x4){0.f, 0.f, 0.f, 0.f};
        cur = nxt; cA = nA; cB = nB; ++ui;
        if constexpr (ALIGN_EPI) { if (wr == 1) PG8_BAR; }
    }
    PG8_WAIT_V(0);
    if constexpr (!ALIGN_EPI) { if (wr == 0) PG8_BAR; }
    PG8_BAR;
    if constexpr (Epi::AFTER_DRAIN) { E.fused(acc, cur, wr, wc, fr, fq, lds, wid, lane); S.done(cur); }
#undef PG8_SA
#undef PG8_SB
#undef PG8_STAGE
#undef PG8_LDA
#undef PG8_LDB
#undef PG8_MMA
#undef PG8_WAIT_V
#undef PG8_WAIT_L
#undef PG8_BAR
#undef PG8_SCHED
}
}
namespace attn_body {
using bf16=__hip_bfloat16;
using bf16x8=__attribute__((ext_vector_type(8)))short;
using s16x4=__attribute__((ext_vector_type(4)))short;
using f32x16=__attribute__((ext_vector_type(16)))float;
using u32x4=__attribute__((ext_vector_type(4)))unsigned;
constexpr int BATCH=4,NHEAD=16,SEQ=8192,D=64,DM=NHEAD*D;
constexpr int NW=8,QBLK=32,QB=QBLK*NW,KVBLK=64,NQB=SEQ/QB;
constexpr int ATTN_PITCH=DM, ATTN_UNIT_ROWS=QB;
__device__ __forceinline__ int crow(int r,int hi){return (r&3)+8*(r>>2)+4*hi;}
#define SBAR() __builtin_amdgcn_sched_barrier(0)
__device__ __forceinline__ void cmask(f32x16&p0,f32x16&p1,int jb,int qrel,int hi){
  const float NEG=-INFINITY; int kb=64*jb+4*hi;
  #pragma unroll
  for(int r=0;r<16;++r){int kv=kb+(r&3)+8*(r>>2); if(kv>qrel)p0[r]=NEG; if(kv+32>qrel)p1[r]=NEG;}
}

constexpr int NSLOT=3, SLOTB=8192;
constexpr int LDS_K=0, LDS_V=NSLOT*SLOTB, LDS_WS=2*NSLOT*SLOTB, LDS_OST=LDS_WS+NW*64*4, LDS_BYTES=LDS_OST+NW*4096; constexpr int LDS_KX=LDS_BYTES, LDS_SCAN=LDS_KX+SEQ*8, LDS_TOTAL=LDS_SCAN+64;
constexpr float C2=0.125f*1.4426950408889634f;
__device__ __forceinline__ void glds16(const void*gsrc,unsigned lds_dst){unsigned keep;
  asm volatile("s_mov_b32 %0, m0\n\ts_mov_b32 m0, %2\n\ts_nop 0\n\tglobal_load_lds_dwordx4 %1, off\n\ts_mov_b32 m0, %0":"=&s"(keep):"v"(gsrc),"s"(lds_dst):"memory");}
__device__ __forceinline__ float max3f(float a,float b,float c){float r;asm("v_max3_f32 %0, %1, %2, %3":"=v"(r):"v"(a),"v"(b),"v"(c));return r;}
__device__ __forceinline__ float max2f(float a,float b){float r;asm("v_max_f32_e32 %0, %1, %2":"=v"(r):"v"(a),"v"(b));return r;}
__device__ __forceinline__ float fadd_s(float a,float b){float r;asm("v_add_f32_e32 %0, %1, %2":"=v"(r):"v"(a),"v"(b));return r;}
__device__ __forceinline__ float fsub_s(float a,float b){float r;asm("v_sub_f32_e32 %0, %1, %2":"=v"(r):"v"(a),"v"(b));return r;}
typedef float f32x2_t __attribute__((ext_vector_type(2))); typedef __bf16 bf16x2_t __attribute__((ext_vector_type(2)));
__device__ __forceinline__ unsigned cvtpk_s(float lo,float hi){f32x2_t v={lo,hi};bf16x2_t b=__builtin_convertvector(v,bf16x2_t);return __builtin_bit_cast(unsigned,b);}
#define WAIT_BAR(N) asm volatile("s_waitcnt vmcnt(" #N ") lgkmcnt(0)\n\ts_barrier":::"memory")

typedef unsigned u32x2_t __attribute__((ext_vector_type(2))); typedef float f32x4_t __attribute__((ext_vector_type(4)));
__device__ __forceinline__ u32x2_t split3(float x){ const unsigned p1=cvtpk_s(x,0.f)&0xffffu; const float r1=x-__uint_as_float(p1<<16); const unsigned p2=cvtpk_s(r1,0.f)&0xffffu; const float r2=r1-__uint_as_float(p2<<16);
  const unsigned p3=cvtpk_s(r2,0.f)&0xffffu; return (u32x2_t){p1|(p2<<16),p3|(0x3F80u<<16)}; }
__device__ __forceinline__ bf16x8 mkqx(float x,int hi){ const unsigned p1=cvtpk_s(x,0.f)&0xffffu; const float r1=x-__uint_as_float(p1<<16); const unsigned p2=cvtpk_s(r1,0.f)&0xffffu; const float r2=r1-__uint_as_float(p2<<16);
  const unsigned p3=cvtpk_s(r2,0.f)&0xffffu; u32x4 w=(u32x4){0x3F803F80u,0x3F80u|(p1<<16),p2|(p3<<16),0u}; if(hi)w=(u32x4){0u,0u,0u,0u}; return __builtin_bit_cast(bf16x8,w); }
__device__ __forceinline__ bf16x8 kxa(u32x2_t q){ return __builtin_bit_cast(bf16x8,(u32x4){q.x,q.y,0x3F803F80u,0u}); }
__device__ __forceinline__ void qkt(f32x16&p0,f32x16&p1,const char*Kslot,const bf16x8*qr,bf16x8 kx0,bf16x8 kx1,bf16x8 qx,int r32,int hi){
  const char*kb=Kslot+hi*1024+r32*16;
  p0=__builtin_amdgcn_mfma_f32_32x32x16_bf16(kx0,qx,f32x16{},0,0,0);p1=__builtin_amdgcn_mfma_f32_32x32x16_bf16(kx1,qx,f32x16{},0,0,0);
  #pragma unroll
  for(int d0=0;d0<4;++d0){
    const bf16x8 b0=*reinterpret_cast<const bf16x8*>(kb+d0*2048);
    const bf16x8 b1=*reinterpret_cast<const bf16x8*>(kb+d0*2048+512);
    p0=__builtin_amdgcn_mfma_f32_32x32x16_bf16(b0,qr[d0],p0,0,0,0);p1=__builtin_amdgcn_mfma_f32_32x32x16_bf16(b1,qr[d0],p1,0,0,0);}
}
typedef __attribute__((address_space(3))) const char* lds_cptr;
typedef short v4i16_t __attribute__((ext_vector_type(4)));
__device__ __forceinline__ void kload8(bf16x8*kf,lds_cptr kp){
  kf[0]=*(const __attribute__((address_space(3))) bf16x8*)(kp);      kf[1]=*(const __attribute__((address_space(3))) bf16x8*)(kp+512);
  kf[2]=*(const __attribute__((address_space(3))) bf16x8*)(kp+2048); kf[3]=*(const __attribute__((address_space(3))) bf16x8*)(kp+2560);
  kf[4]=*(const __attribute__((address_space(3))) bf16x8*)(kp+4096); kf[5]=*(const __attribute__((address_space(3))) bf16x8*)(kp+4608);
  kf[6]=*(const __attribute__((address_space(3))) bf16x8*)(kp+6144); kf[7]=*(const __attribute__((address_space(3))) bf16x8*)(kp+6656);
}
__device__ __forceinline__ void kload2(bf16x8*kf,lds_cptr kp,int j){ kf[2*j]=*(const __attribute__((address_space(3))) bf16x8*)(kp+j*2048); kf[2*j+1]=*(const __attribute__((address_space(3))) bf16x8*)(kp+j*2048+512); }
__device__ __forceinline__ s16x4 vtr(lds_cptr p){ return __builtin_bit_cast(s16x4,__builtin_amdgcn_ds_read_tr16_b64_v4i16((__attribute__((address_space(3))) v4i16_t*)p)); }
__device__ __forceinline__ float rowmax(const f32x16&p0,const f32x16&p1){
  float a=max3f(p0[0],p0[1],p1[0]),b=max3f(p0[2],p0[3],p1[1]);a=max3f(a,p1[2],p1[3]);
  #pragma unroll
  for(int r=4;r<16;r+=4){a=max3f(a,p0[r],p0[r+1]);b=max3f(b,p0[r+2],p0[r+3]);a=max3f(a,p1[r],p1[r+1]);b=max3f(b,p1[r+2],p1[r+3]);}
  const float m=max2f(a,b);
  auto rr=__builtin_amdgcn_permlane32_swap(__float_as_uint(m),__float_as_uint(m),false,false);
  return max2f(__uint_as_float(rr[0]),__uint_as_float(rr[1]));
}
__device__ __forceinline__ void pv(f32x16*o,int vb,bf16x8 pa0,bf16x8 pa1,bf16x8 pa2,bf16x8 pa3){
  #pragma unroll
  for(int d0=0;d0<2;++d0){s16x4 lo[4],hi[4];
    #pragma unroll
    for(int ks=0;ks<4;++ks){
      asm volatile("ds_read_b64_tr_b16 %0,%1 offset:%c2":"=&v"(lo[ks]):"v"(vb),"i"(d0*4096+ks*1024):"memory");
      asm volatile("ds_read_b64_tr_b16 %0,%1 offset:%c2":"=&v"(hi[ks]):"v"(vb),"i"(d0*4096+ks*1024+512):"memory");}
    asm volatile("s_waitcnt lgkmcnt(0)":::"memory");SBAR();
    #define PK(k) (bf16x8){lo[k][0],lo[k][1],lo[k][2],lo[k][3],hi[k][0],hi[k][1],hi[k][2],hi[k][3]}
    o[d0]=__builtin_amdgcn_mfma_f32_32x32x16_bf16(pa0,PK(0),o[d0],0,0,0);
    o[d0]=__builtin_amdgcn_mfma_f32_32x32x16_bf16(pa1,PK(1),o[d0],0,0,0);
    o[d0]=__builtin_amdgcn_mfma_f32_32x32x16_bf16(pa2,PK(2),o[d0],0,0,0);
    o[d0]=__builtin_amdgcn_mfma_f32_32x32x16_bf16(pa3,PK(3),o[d0],0,0,0);
    #undef PK
  }
}

#ifndef ATTN_STORE16
#define ATTN_STORE16(p,v) (*(u32x4*)(p)=(v))
#endif
template<int THRL> __device__ __forceinline__ void attn_unit(int b,int h,int qb,const bf16*Q,const bf16*__restrict__ K,const bf16*__restrict__ V,bf16*O,const float*__restrict__ LFt,bool newbh,char*shm){
  int tid=threadIdx.x; asm volatile("":"+v"(tid)); const int lane=tid&63,r32=lane&31,hi=lane>>5; const int wid=__builtin_amdgcn_readfirstlane(tid>>6);
  const long rowbase=(long)b*SEQ; const int q0=qb*QB;
  const bf16*Qw=Q+(rowbase+q0+wid*QBLK)*DM+h*D;
  const bf16*Kh=K+rowbase*DM+h*D,*Vh=V+rowbase*DM+h*D;
  const unsigned lds0=(unsigned)(uintptr_t)shm;
  float*wsf=(float*)(shm+LDS_WS)+wid*64;
  const bf16*ksrc=Kh+(long)lane*DM+wid*8;
  const bf16*vsrc=Vh+(long)(16*(wid&3)+(lane>>2))*DM+(wid>>2)*32+(lane&3)*8;
  const unsigned kdst=lds0+LDS_K+wid*1024, vdst=lds0+LDS_V+wid*1024;
  #define DMA_K(t,slot) glds16(ksrc+(long)(t)*KVBLK*DM,(unsigned)__builtin_amdgcn_readfirstlane(kdst+(slot)))
  #define DMA_V(t,slot) glds16(vsrc+(long)(t)*KVBLK*DM,(unsigned)__builtin_amdgcn_readfirstlane(vdst+(slot)))
  const int vb0=(int)(lds0+LDS_V)+((lane>>4)&1)*32+(lane&3)*8+(4*hi+((lane&15)>>2))*64;
  const char*Kbase=shm+LDS_K; bf16x8 kf[8];
  const lds_cptr shm3=(lds_cptr)shm; const lds_cptr kp0=shm3+LDS_K+hi*1024+r32*16; const lds_cptr vp0=shm3+LDS_V+((lane>>4)&1)*32+(lane&3)*8+(4*hi+((lane&15)>>2))*64;
  const int NT=(q0+QB)/KVBLK;
  if(newbh){
    typedef __attribute__((address_space(3))) char* lds_wptr; const lds_wptr shmw=(lds_wptr)shm;
    const float*lp=LFt+((long)(b*NHEAD+h)*SEQ+16*tid);
    const f32x4_t a0=*(const f32x4_t*)lp,a1=*(const f32x4_t*)(lp+4),a2=*(const f32x4_t*)(lp+8),a3=*(const f32x4_t*)(lp+12);
    const float v_[16]={a0[0],a0[1],a0[2],a0[3],a1[0],a1[1],a1[2],a1[3],a2[0],a2[1],a2[2],a2[3],a3[0],a3[1],a3[2],a3[3]};
    float loc=0.f;
    #pragma unroll
    for(int i=0;i<16;++i)loc+=v_[i];
    float inc=loc;
    #pragma unroll
    for(int o_=1;o_<64;o_<<=1){const float t_=__shfl_up(inc,o_); if(lane>=o_)inc+=t_;}
    __attribute__((address_space(3))) float*wt=(__attribute__((address_space(3))) float*)(shmw+LDS_SCAN);
    if(lane==63)wt[wid]=inc;
    asm volatile("s_waitcnt vmcnt(0) lgkmcnt(0)\n\ts_barrier":::"memory");
    float run=inc-loc;
    #pragma unroll
    for(int w_=0;w_<NW;++w_){const float tw=wt[w_]; if(w_<wid)run+=tw;}
    __attribute__((address_space(3))) u32x4*kxw=(__attribute__((address_space(3))) u32x4*)(shmw+LDS_KX+tid*128);
    #pragma unroll
    for(int i=0;i<16;i+=2){ run+=v_[i]; const u32x2_t e0=split3(run*(-1.4426950408889634f)); run+=v_[i+1]; const u32x2_t e1=split3(run*(-1.4426950408889634f)); kxw[i>>1]=(u32x4){e0.x,e0.y,e1.x,e1.y}; }
    asm volatile("s_waitcnt lgkmcnt(0)\n\ts_barrier":::"memory");
  }
  DMA_K(0,0);DMA_V(0,0);DMA_K(1,SLOTB);
  bf16x8 qr[4];
  #pragma unroll
  for(int d0=0;d0<4;++d0)qr[d0]=*reinterpret_cast<const bf16x8*>(&Qw[(long)r32*DM+d0*16+hi*8]);
  float mhat=0.f,l_reg=0.f;f32x16 o[2];o[0]=f32x16{};o[1]=f32x16{};bf16x8 qx=mkqx(0.f,hi);u32x2_t kq0,kq1;
  const __attribute__((address_space(3))) char*kxp=shm3+LDS_KX+r32*8;
  #define LDKQ(t) do{ kq0=*(const __attribute__((address_space(3))) u32x2_t*)(kxp+(t)*512); kq1=*(const __attribute__((address_space(3))) u32x2_t*)(kxp+(t)*512+256); }while(0)
  const int qrel=wid*QBLK+r32;
  #define CMASK(P0,P1,t) do{int jb_=(t)-(NT-4); if(jb_>=0)cmask(P0,P1,jb_,qrel,hi);}while(0)
  bool resc=false;
  #define START(P0,P1) do{ const float rm=rowmax(P0,P1); resc=false; \
    { const float dl=rm; mhat=fadd_s(mhat,dl); \
      _Pragma("unroll") for(int r=0;r<16;++r){P0[r]=fsub_s(P0[r],dl);P1[r]=fsub_s(P1[r],dl);} \
      qx=mkqx(-mhat,hi); } \
    _Pragma("unroll") for(int r=0;r<16;++r)P0[r]=__builtin_amdgcn_exp2f(P0[r]); }while(0)
  #define RESC() do{ if(resc){ asm volatile("s_waitcnt lgkmcnt(0)":::"memory"); \
      _Pragma("unroll") for(int d_=0;d_<2;++d_) _Pragma("unroll") for(int r=0;r<16;++r)o[d_][r]*=wsf[crow(r,hi)]; } }while(0)
  f32x16 pA0,pA1,pB0,pB1;
  int sl_prev=0,sl_cur=0,sl_next=SLOTB;
  #define ROT() do{sl_prev=sl_cur;sl_cur=sl_next;sl_next=(sl_next==(NSLOT-1)*SLOTB)?0:sl_next+SLOTB;}while(0)
  DMA_K(2,2*SLOTB);
  WAIT_BAR(3);
  LDKQ(0); qkt(pA0,pA1,Kbase,qr,kxa(kq0),kxa(kq1),qx,r32,hi);asm volatile("s_nop 15\n\ts_nop 7":"+v"(pA0),"+v"(pA1));CMASK(pA0,pA1,0); LDKQ(1);
  START(pA0,pA1);
  _Pragma("unroll") for(int r=0;r<16;++r)pA1[r]=__builtin_amdgcn_exp2f(pA1[r]);
  WAIT_BAR(0);
  DMA_K(3,0);DMA_V(1,SLOTB);
  ROT();
  kload8(kf,kp0+sl_cur);
  WAIT_BAR(2);
  s16x4 vlo[8],vhi[8]; u32x4 pw0,pw1,pw2,pw3;
  #define PKW(P,B) cvtpk_s(P[B],P[B+1])
  #define PAF(k) __builtin_bit_cast(bf16x8,pw##k)
  #define VFR(i) (bf16x8){vlo[i][0],vlo[i][1],vlo[i][2],vlo[i][3],vhi[i][0],vhi[i][1],vhi[i][2],vhi[i][3]}
  #define PIN(x) asm volatile("":"+v"(x))
  #define MX3(a,b,c) __builtin_fmaxf(__builtin_fmaxf((a),(b)),(c))
  #define GAPA(MF,A0,A1,A2,A3,W0,W1,PW) do{ MF; sacc+=A0; sacc+=A1; sacc+=A2; sacc+=A3; PIN(sacc); W0; W1; PIN(PW); SBAR(); }while(0)
  #define EX(v) __builtin_amdgcn_exp2f(v)
  #define GAPB(MF,X,B) do{ MF; X[B]=EX(X[B]); X[B+1]=EX(X[B+1]); X[B+2]=EX(X[B+2]); X[B+3]=EX(X[B+3]); PIN(X); SBAR(); }while(0)
  #define VRD(i) do{ vlo[i]=vtr(vp_+(((i)>>2)*4096+((i)&3)*1024)); vhi[i]=vtr(vp_+(((i)>>2)*4096+((i)&3)*1024+512)); }while(0)
  #define KRD(G,j) do{ if(G){ kload2(kf,kp0+sl_next,j); SBAR(); } }while(0)
  #define STEP(C0,C1,P0,P1,t,GK,GV,GL) do{ SBAR(); \
    const lds_cptr vp_=vp0+sl_prev; \
    VRD(0); SBAR(); float sacc=(P0[0]+P0[1]); \
    GAPA(C0=__builtin_amdgcn_mfma_f32_32x32x16_bf16(kf[0],qr[0],C0,0,0,0), P0[2],P0[3],P0[4],P0[5],     pw0[0]=PKW(P0,0), pw0[1]=PKW(P0,2), pw0); \
    VRD(4); SBAR(); GAPA(C1=__builtin_amdgcn_mfma_f32_32x32x16_bf16(kf[1],qr[0],C1,0,0,0), P0[6],P0[7],P0[8],P0[9],     pw0[2]=PKW(P0,4), pw0[3]=PKW(P0,6), pw0); \
    VRD(1); SBAR(); GAPA(C0=__builtin_amdgcn_mfma_f32_32x32x16_bf16(kf[2],qr[1],C0,0,0,0),   P0[10],P0[11],P0[12],P0[13], pw1[0]=PKW(P0,8), pw1[1]=PKW(P0,10), pw1); \
    VRD(5); SBAR(); GAPA(C1=__builtin_amdgcn_mfma_f32_32x32x16_bf16(kf[3],qr[1],C1,0,0,0),   P0[14],P0[15],P1[0],P1[1],   pw1[2]=PKW(P0,12),pw1[3]=PKW(P0,14), pw1); \
    VRD(2); SBAR(); GAPA(C0=__builtin_amdgcn_mfma_f32_32x32x16_bf16(kf[4],qr[2],C0,0,0,0),   P1[2],P1[3],P1[4],P1[5],     pw2[0]=PKW(P1,0), pw2[1]=PKW(P1,2), pw2); \
    VRD(6); SBAR(); GAPA(C1=__builtin_amdgcn_mfma_f32_32x32x16_bf16(kf[5],qr[2],C1,0,0,0),   P1[6],P1[7],P1[8],P1[9],     pw2[2]=PKW(P1,4), pw2[3]=PKW(P1,6), pw2); \
    VRD(3); SBAR(); GAPA(C0=__builtin_amdgcn_mfma_f32_32x32x16_bf16(kf[6],qr[3],C0,0,0,0),   P1[10],P1[11],P1[12],P1[13], pw3[0]=PKW(P1,8), pw3[1]=PKW(P1,10), pw3); \
    VRD(7); SBAR(); GAPA(C1=__builtin_amdgcn_mfma_f32_32x32x16_bf16(kf[7],qr[3],C1,0,0,0),   P1[14],P1[15],0.f,0.f,       pw3[2]=PKW(P1,12),pw3[3]=PKW(P1,14), pw3); \
    l_reg+=sacc; if(GL){LDKQ((t)+1);} \
    if(GK){DMA_K((t)+3,sl_cur);} if(GV){DMA_V((t)+1,sl_next);} \
    CMASK(C0,C1,t); \
    { float a=MX3(C0[0],C0[1],C1[0]),b=MX3(C0[2],C0[3],C1[1]); a=MX3(a,C1[2],C1[3]); \
      _Pragma("unroll") for(int r=4;r<16;r+=4){a=MX3(a,C0[r],C0[r+1]);b=MX3(b,C0[r+2],C0[r+3]);a=MX3(a,C1[r],C1[r+1]);b=MX3(b,C1[r+2],C1[r+3]);} \
      float rm=__builtin_fmaxf(a,b); { auto rr=__builtin_amdgcn_permlane32_swap(__float_as_uint(rm),__float_as_uint(rm),false,false); rm=__builtin_fmaxf(__uint_as_float(rr[0]),__uint_as_float(rr[1])); } \
      resc=false; \
      if(__builtin_expect(__any(rm>(float)THRL),0)){ const float dl=__builtin_fmaxf(rm,0.f); mhat+=dl; \
        _Pragma("unroll") for(int r=0;r<16;++r){C0[r]-=dl;C1[r]-=dl;} \
        qx=mkqx(-mhat,hi); \
        const float f=__builtin_amdgcn_exp2f(-dl); l_reg*=f; if(hi==0)wsf[r32]=f; resc=true; } } \
    SBAR(); \
    GAPB(o[0]=__builtin_amdgcn_mfma_f32_32x32x16_bf16(PAF(0),VFR(0),o[0],0,0,0), C0,0); \
    GAPB(o[1]=__builtin_amdgcn_mfma_f32_32x32x16_bf16(PAF(0),VFR(4),o[1],0,0,0), C0,4); \
    KRD(GL,0); GAPB(o[0]=__builtin_amdgcn_mfma_f32_32x32x16_bf16(PAF(1),VFR(1),o[0],0,0,0), C0,8); \
    KRD(GL,1); GAPB(o[1]=__builtin_amdgcn_mfma_f32_32x32x16_bf16(PAF(1),VFR(5),o[1],0,0,0), C0,12); \
    KRD(GL,2); GAPB(o[0]=__builtin_amdgcn_mfma_f32_32x32x16_bf16(PAF(2),VFR(2),o[0],0,0,0), C1,0); \
    KRD(GL,3); GAPB(o[1]=__builtin_amdgcn_mfma_f32_32x32x16_bf16(PAF(2),VFR(6),o[1],0,0,0), C1,4); \
    GAPB(o[0]=__builtin_amdgcn_mfma_f32_32x32x16_bf16(PAF(3),VFR(3),o[0],0,0,0), C1,8); \
    GAPB(o[1]=__builtin_amdgcn_mfma_f32_32x32x16_bf16(PAF(3),VFR(7),o[1],0,0,0), C1,12); \
    if(GL){ P0=__builtin_amdgcn_mfma_f32_32x32x16_bf16(kxa(kq0),qx,f32x16{},0,0,0); P1=__builtin_amdgcn_mfma_f32_32x32x16_bf16(kxa(kq1),qx,f32x16{},0,0,0); } \
    }while(0)
  pB0=__builtin_amdgcn_mfma_f32_32x32x16_bf16(kxa(kq0),qx,f32x16{},0,0,0); pB1=__builtin_amdgcn_mfma_f32_32x32x16_bf16(kxa(kq1),qx,f32x16{},0,0,0);
  int t=1;
  #undef CMASK
  #define CMASK(P0,P1,t) do{}while(0)
  for(;t+5<NT;t+=2){
    STEP(pB0,pB1,pA0,pA1,t,true,true,true);     WAIT_BAR(2); RESC(); ROT();
    STEP(pA0,pA1,pB0,pB1,t+1,true,true,true);   WAIT_BAR(2); RESC(); ROT();
  }
  #undef CMASK
  #define CMASK(P0,P1,t) do{int jb_=(t)-(NT-4); if(jb_>=0)cmask(P0,P1,jb_,qrel,hi);}while(0)
  #define ENDW(tt) do{ if((tt)+3<NT){WAIT_BAR(2);} else if((tt)+2<NT){WAIT_BAR(1);} else {WAIT_BAR(0);} }while(0)
  for(;t+1<NT;t+=2){
    STEP(pB0,pB1,pA0,pA1,t,(t+3<NT),(t+1<NT),(t+1<NT));       ENDW(t);   RESC(); ROT();
    STEP(pA0,pA1,pB0,pB1,t+1,(t+4<NT),(t+2<NT),(t+2<NT));     ENDW(t+1); RESC(); ROT();
  }
  STEP(pB0,pB1,pA0,pA1,NT-1,false,false,false); RESC();
  { float sacc=pB0[0]+pB0[1]; _Pragma("unroll") for(int r=2;r<16;++r)sacc+=pB0[r]; _Pragma("unroll") for(int r=0;r<16;++r)sacc+=pB1[r]; l_reg+=sacc;
    pw0=(u32x4){PKW(pB0,0),PKW(pB0,2),PKW(pB0,4),PKW(pB0,6)};pw1=(u32x4){PKW(pB0,8),PKW(pB0,10),PKW(pB0,12),PKW(pB0,14)};pw2=(u32x4){PKW(pB1,0),PKW(pB1,2),PKW(pB1,4),PKW(pB1,6)};pw3=(u32x4){PKW(pB1,8),PKW(pB1,10),PKW(pB1,12),PKW(pB1,14)};
    SBAR(); pv(o,vb0+sl_cur,PAF(0),PAF(1),PAF(2),PAF(3)); }
  #undef PKW
  #undef PAF
  #undef VFR
  #undef PIN
  #undef MX3
  #undef GAPA
  #undef GAPB
  #undef EX
  #undef VRD
  #undef KRD
  #undef STEP
  #undef ENDW
  {auto rr=__builtin_amdgcn_permlane32_swap(__float_as_uint(l_reg),__float_as_uint(l_reg),false,false);l_reg=__uint_as_float(rr[0])+__uint_as_float(rr[1]);}
  if(hi==0)wsf[32+r32]=l_reg;asm volatile("s_waitcnt lgkmcnt(0)":::"memory");
  float rli[16];
  #pragma unroll
  for(int r=0;r<16;++r)rli[r]=__builtin_amdgcn_rcpf(wsf[32+crow(r,hi)]);
  bf16*Ow=O+(rowbase+q0+wid*QBLK)*DM+h*D;
  { bf16*stg=(bf16*)(shm+LDS_OST)+wid*2048;
    #pragma unroll
    for(int r=0;r<16;++r){const int orow=crow(r,hi);
      #pragma unroll
      for(int d0=0;d0<2;++d0)stg[orow*64+d0*32+r32]=__float2bfloat16(o[d0][r]*rli[r]);}
    asm volatile("s_waitcnt lgkmcnt(0)":::"memory");
    #pragma unroll
    for(int i=0;i<4;++i){const int row=i*8+(lane>>3),ch=lane&7; const u32x4 v=*(const u32x4*)(stg+row*64+ch*8); ATTN_STORE16(Ow+(long)row*DM+ch*8,v);} }
  asm volatile("s_waitcnt lgkmcnt(0)\n\ts_barrier":::"memory");
  #undef DMA_K
  #undef DMA_V
  #undef CMASK
  #undef START
  #undef RESC
  #undef ROT
}
constexpr int ATTN_LDS_BYTES=LDS_TOTAL;
struct AttnTensors { const bf16* Q; const bf16* K; const bf16* V; bf16* O; const float* LFt; };
struct AttnUnit { int bh; int qb; };
struct StaticOrder {
  int vcu,G;
  __device__ __forceinline__ explicit StaticOrder(int grid,int v):vcu(v),G(grid){}
  __device__ __forceinline__ bool next(int i,AttnUnit&u)const{ const int v=vcu+(i>>3)*G; if(v>=256)return false; const int s=v&15,r=(i>>1)&3; u.bh=(v>>5)*8+2*r+((v>>4)&1); u.qb=(i&1)?s:31-s; return true; }
  __device__ __forceinline__ void a_ready(const AttnUnit&)const{}
  __device__ __forceinline__ void done(const AttnUnit&)const{}
};
template<class Sched,int THRL=64> __device__ __forceinline__ void attn_phase(char*lds,const AttnTensors&T,const Sched&S){
  AttnUnit u; int pbh=-1;
  for(int i=0;S.next(i,u);++i){ S.a_ready(u); attn_unit<THRL>(u.bh/NHEAD,u.bh%NHEAD,u.qb,T.Q,T.K,T.V,T.O,T.LFt,u.bh!=pbh,lds); pbh=u.bh; S.done(u); }
}
#undef SBAR
#undef WAIT_BAR
}
namespace hg {
#define HLAS __attribute__((address_space(3)))
#define HG_BAR() asm volatile("s_waitcnt lgkmcnt(0)\n\ts_barrier" ::: "memory")
typedef short bf16x8 __attribute__((ext_vector_type(8)));
typedef float f32x4 __attribute__((ext_vector_type(4)));
typedef unsigned u32x4 __attribute__((ext_vector_type(4)));
typedef unsigned u32x2 __attribute__((ext_vector_type(2)));
typedef unsigned short u16;
constexpr int L_QD = 0, L_KI = 17408, L_IVT = 34816, L_KST = 53248, L_AM = 71680, L_TOT = 80896, L_SSQ = 82944, L_DECL = 83456, L_CIN = 83968, L_END = L_CIN + 128 * 272;
constexpr int P_QD = 272, P_T = 144;
constexpr int NUNITS = 4096;
typedef float pk_f32x2 __attribute__((ext_vector_type(2))); typedef __bf16 pk_bf16x2 __attribute__((ext_vector_type(2)));
__device__ __forceinline__ unsigned pk2(float lo, float hi) { const pk_f32x2 v = {lo, hi}; return __builtin_bit_cast(unsigned, __builtin_convertvector(v, pk_bf16x2)); }
__device__ __forceinline__ unsigned f2bf(float f) { return pk2(f, f) & 0xffffu; }
__device__ __forceinline__ float bf2f(unsigned h) { return __builtin_bit_cast(float, h << 16); }
__device__ __forceinline__ float h2f(u16 h) { return (float)__builtin_bit_cast(_Float16, h); }

struct Tensors { const u16* HLF; const u16* HQ; const u16* HI; const u16* HG; u16* US; float* DEC; const float* onorm_g; const float* LB; u16* OG; u16* SFC; float* PB; };

template <bool PA> struct Raw { u16 fl[16]; u16 q[16]; u32x4 iv[2]; };
template <bool PA> __device__ __forceinline__ void load_raw(const Tensors& T, int unit, int tid, Raw<PA>& r) {
    const int bh = unit >> 7, n = unit & 127, b = bh >> 3, h = bh & 7; const size_t rowbase = (size_t)b * 8192 + (size_t)n * 64;
    const int d = tid & 127, qt = tid >> 7;
    const u16* lfp = T.HLF + (rowbase + 16 * qt) * 1024 + 128 * h + d;
#pragma unroll
    for (int i = 0; i < 16; ++i) r.fl[i] = lfp[(size_t)i * 1024];
    if (!PA) { const u16* qp = T.HQ + (rowbase + 16 * qt) * 1024 + 128 * h + d;
#pragma unroll
        for (int i = 0; i < 16; ++i) r.q[i] = qp[(size_t)i * 1024]; }
#pragma unroll
    for (int it = 0; it < 2; ++it) { const int idx = tid + it * 512; const int s = idx >> 4, vg = idx & 15;
        r.iv[it] = *(const u32x4*)(T.HI + (rowbase + s) * 1024 + 128 * h + 8 * vg); }
}
template <bool PA> __device__ __forceinline__ float prep(HLAS unsigned char* L, const Tensors& T, int unit, int h, int tid, const Raw<PA>& r, float Bacc) {
    const int d = tid & 127, qt = tid >> 7;
    float kk[16], cs[16]; float run = 0.f;
    const float lb = T.LB[128 * h + d];
#pragma unroll
    for (int i = 0; i < 16; ++i) kk[i] = h2f(r.fl[i]);
#pragma unroll
    for (int i = 0; i < 16; ++i) { const float sg = __builtin_amdgcn_rcpf(1.0f + __expf(-kk[i])); const float f = lb + (1.0f - lb) * sg;
        kk[i] = (1.0f - lb) * (1.0f - sg); run += __logf(f); cs[i] = run; }
    HLAS float* TOT = (HLAS float*)(L + L_TOT);
    TOT[qt * 128 + d] = run;
    HG_BAR();
    const float t0 = TOT[d], t1 = TOT[128 + d], t2 = TOT[256 + d], t3 = TOT[384 + d];
    const float pre = (qt > 0 ? t0 : 0.f) + (qt > 1 ? t1 : 0.f) + (qt > 2 ? t2 : 0.f);
    const float blast = ((t0 + t1) + t2) + t3;
    {
        unsigned w[8];
#pragma unroll
        for (int i = 0; i < 16; i += 2) {
            const float k0 = kk[i], k1 = kk[i + 1];
            const float e0 = __expf(blast - (pre + cs[i])), e1 = __expf(blast - (pre + cs[i + 1]));
            w[i >> 1] = pk2(k0 * e0, k1 * e1);
        }
        HLAS u32x4* dst = (HLAS u32x4*)(L + L_KST + d * P_T + qt * 32);
        dst[0] = (u32x4){w[0], w[1], w[2], w[3]}; dst[1] = (u32x4){w[4], w[5], w[6], w[7]};
        if (qt == 0) ((HLAS float*)(L + L_DECL))[d] = __expf(blast);
    }
    if (!PA) {
        float q[16];
#pragma unroll
        for (int i = 0; i < 16; ++i) q[i] = bf2f(r.q[i]);
#pragma unroll
        for (int i = 0; i < 16; ++i) { const float bb = pre + cs[i]; const float k = kk[i];
            *(HLAS u16*)(L + L_QD + (16 * qt + i) * P_QD + d * 2) = (u16)f2bf(q[i] * __expf(bb));
            *(HLAS u16*)(L + L_KI + (16 * qt + i) * P_QD + d * 2) = (u16)f2bf(k * __expf(-bb)); }
    }
    return blast;
}
__device__ __forceinline__ int ivt_off(int row, int chunk) { return row * P_T + ((chunk ^ ((row >> 3) & 7)) << 4); }
__device__ __forceinline__ void stage_ivt(HLAS unsigned char* L, const u32x4 (&iv)[2], int tid) {
#pragma unroll
    for (int it = 0; it < 2; ++it) { const int idx = tid + it * 512; const int s = idx >> 4, vg = idx & 15;
        const u32x4 w = iv[it];
#pragma unroll
        for (int j = 0; j < 8; ++j) { const unsigned dw = w[j >> 1]; *(HLAS u16*)(L + L_IVT + ivt_off(8 * vg + j, s >> 3) + (s & 7) * 2) = (u16)((j & 1) ? (dw >> 16) : (dw & 0xffffu)); } }
}
#define HG_MFMA(X, Y, C) __builtin_amdgcn_mfma_f32_16x16x32_bf16((X), (Y), (C), 0, 0, 0)

__device__ __forceinline__ void phaseB(const Tensors& T, int vb, int tid) {
    const int g = vb * 512 + tid, d4 = g & 31, v = (g >> 5) & 127, bh = g >> 12;
    u32x2* p = (u32x2*)T.SFC + ((size_t)(bh * 8) * 128 + v) * 32 + d4;
    const f32x4* dp = (const f32x4*)T.PB + (size_t)(bh * 8) * 32 + d4;
    f32x4 S = (f32x4){0.f, 0.f, 0.f, 0.f};
    u32x2 u[8]; f32x4 dc[8];
#pragma unroll
    for (int j = 0; j < 8; ++j) { u[j] = p[(size_t)j * 4096]; dc[j] = dp[(size_t)j * 32]; }
#pragma unroll
    for (int j = 0; j < 8; ++j) {
        p[(size_t)j * 4096] = (u32x2){pk2(S[0], S[1]), pk2(S[2], S[3])};
        const f32x4 uu = (f32x4){bf2f(u[j].x & 0xffffu), bf2f(u[j].x >> 16), bf2f(u[j].y & 0xffffu), bf2f(u[j].y >> 16)};
        S = dc[j] * S + uu;
    }
}
__device__ __forceinline__ void phaseC_unit(HLAS unsigned char* L, const Tensors& T, int unit, int tid, const Raw<false>& raw, f32x4 (&S)[8]) {
    const int bh = unit >> 7, n = unit & 127, b = bh >> 3, h = bh & 7; const size_t rowbase = (size_t)b * 8192 + (size_t)n * 64;
    const int lane = tid & 63, w = tid >> 6, lr = lane & 15, kq = lane >> 4;
    const int ct = w & 3, wh = w >> 2;
    u32x2 hgt[4];
#pragma unroll
    for (int vi = 0; vi < 4; ++vi) hgt[vi] = *(const u32x2*)(T.HG + (rowbase + 16 * ct + lr) * 1024 + 128 * h + 64 * wh + 16 * vi + 4 * kq);
    prep<false>(L, T, unit, h, tid, raw, 0.f);
    stage_ivt(L, raw.iv, tid);
    {
        HLAS unsigned char* sx = L + L_CIN + (16 * w + lr) * 272 + 8 * kq;
#pragma unroll
        for (int dt = 0; dt < 8; ++dt) *(HLAS u32x2*)(sx + 32 * dt) = (u32x2){pk2(S[dt][0], S[dt][1]), pk2(S[dt][2], S[dt][3])};
    }
    HG_BAR();
    {
        f32x4 ua[8];
#pragma unroll
        for (int dt = 0; dt < 8; ++dt) ua[dt] = (f32x4){0.f, 0.f, 0.f, 0.f};
#pragma unroll
        for (int ks = 0; ks < 2; ++ks) {
            const bf16x8 Y = *(const HLAS bf16x8*)(L + L_IVT + ivt_off(16 * w + lr, 4 * ks + kq));
#pragma unroll
            for (int dt = 0; dt < 8; ++dt) { const bf16x8 X = *(const HLAS bf16x8*)(L + L_KST + (16 * dt + lr) * P_T + (32 * ks + 8 * kq) * 2); ua[dt] = HG_MFMA(X, Y, ua[dt]); }
        }
        const HLAS f32x4* dl = (const HLAS f32x4*)(L + L_DECL);
#pragma unroll
        for (int dt = 0; dt < 8; ++dt) S[dt] = dl[4 * dt + kq] * S[dt] + ua[dt];
    }
#pragma unroll
    for (int sp = 0; sp < 2; ++sp) { const int st = 2 * wh + sp;
        f32x4 a = (f32x4){0.f, 0.f, 0.f, 0.f};
        if (st <= ct) {
#pragma unroll
            for (int ks = 0; ks < 4; ++ks) { const bf16x8 X = *(const HLAS bf16x8*)(L + L_KI + (16 * st + lr) * P_QD + (32 * ks + 8 * kq) * 2);
                const bf16x8 Y = *(const HLAS bf16x8*)(L + L_QD + (16 * ct + lr) * P_QD + (32 * ks + 8 * kq) * 2); a = HG_MFMA(X, Y, a); }
        }
        const int c = 16 * ct + lr, s0 = 16 * st + 4 * kq;
        float m[4];
#pragma unroll
        for (int e = 0; e < 4; ++e) m[e] = (st <= ct && s0 + e <= c) ? a[e] : 0.f;
        *(HLAS u32x2*)(L + L_AM + c * P_T + s0 * 2) = (u32x2){pk2(m[0], m[1]), pk2(m[2], m[3])};
    }
    HG_BAR();
    f32x4 acc[4];
#pragma unroll
    for (int vi = 0; vi < 4; ++vi) acc[vi] = (f32x4){0.f, 0.f, 0.f, 0.f};
#pragma unroll
    for (int vi = 0; vi < 4; ++vi) {
#pragma unroll
        for (int ks = 0; ks < 2; ++ks) { const bf16x8 X = *(const HLAS bf16x8*)(L + L_IVT + ivt_off(64 * wh + 16 * vi + lr, 4 * ks + kq));
            const bf16x8 Y = *(const HLAS bf16x8*)(L + L_AM + (16 * ct + lr) * P_T + (32 * ks + 8 * kq) * 2); acc[vi] = HG_MFMA(X, Y, acc[vi]); }
#pragma unroll
        for (int ks = 0; ks < 4; ++ks) { const bf16x8 Y = *(const HLAS bf16x8*)(L + L_QD + (16 * ct + lr) * P_QD + (32 * ks + 8 * kq) * 2); const bf16x8 X = *(const HLAS bf16x8*)(L + L_CIN + (64 * wh + 16 * vi + lr) * 272 + (32 * ks + 8 * kq) * 2); acc[vi] = HG_MFMA(X, Y, acc[vi]); }
    }
    float ss = 0.f;
#pragma unroll
    for (int vi = 0; vi < 4; ++vi) ss += (acc[vi][0] * acc[vi][0] + acc[vi][1] * acc[vi][1]) + (acc[vi][2] * acc[vi][2] + acc[vi][3] * acc[vi][3]);
    ss += __shfl_xor(ss, 16); ss += __shfl_xor(ss, 32);
    HLAS float* SSQ = (HLAS float*)(L + L_SSQ);
    if (kq == 0) SSQ[wh * 64 + 16 * ct + lr] = ss;
    HG_BAR();
    const float tot = SSQ[16 * ct + lr] + SSQ[64 + 16 * ct + lr];
    const float rstd = 1.0f / sqrtf(tot * (1.0f / 128.0f) + 1e-6f);
    const size_t orow = (rowbase + 16 * ct + lr) * 1024 + 128 * h;
#pragma unroll
    for (int vi = 0; vi < 4; ++vi) { const int v0 = 64 * wh + 16 * vi + 4 * kq;
        const f32x4 gn = *(const f32x4*)(T.onorm_g + 128 * h + v0);
        const u32x2 gg = hgt[vi];
        const float o0 = acc[vi][0] * rstd * gn[0] * bf2f(gg.x & 0xffffu), o1 = acc[vi][1] * rstd * gn[1] * bf2f(gg.x >> 16);
        const float o2 = acc[vi][2] * rstd * gn[2] * bf2f(gg.y & 0xffffu), o3 = acc[vi][3] * rstd * gn[3] * bf2f(gg.y >> 16);
        *(u32x2*)(T.OG + orow + v0) = (u32x2){pk2(o0, o1), pk2(o2, o3)}; }
    HG_BAR();
}
constexpr int A_KST = 0, A_IVT = 34816, A_TOT = 69632, A_DECL = 71680, A_END = 72192;
struct RawA { u16 fl[32]; u32x4 iv[4]; };
__device__ __forceinline__ void load_rawA(const Tensors& T, size_t rowbase, int h, int tid, RawA& r) {
    const int d = tid & 127, qt = tid >> 7;
    const u16* lfp = T.HLF + (rowbase + 32 * qt) * 1024 + 128 * h + d;
#pragma unroll
    for (int i = 0; i < 32; ++i) r.fl[i] = lfp[(size_t)i * 1024];
#pragma unroll
    for (int it = 0; it < 4; ++it) { const int idx = tid + it * 512; const int s = idx >> 4, vg = idx & 15;
        r.iv[it] = *(const u32x4*)(T.HI + (rowbase + s) * 1024 + 128 * h + 8 * vg); }
}
__device__ __forceinline__ int ivtA_off(int row, int chunk) { return row * 272 + ((chunk ^ ((row >> 3) & 7)) << 4); }
__device__ __forceinline__ void phaseA_unit128(HLAS unsigned char* L, const Tensors& T, int h, int tid, const RawA& r, f32x4 (&S)[8], float& Bsum) {
    const int lane = tid & 63, w = tid >> 6, lr = lane & 15, kq = lane >> 4, d = tid & 127, qt = tid >> 7;
    {
        float kk[32], cs[32]; float run = 0.f;
        const float lb = T.LB[128 * h + d];
#pragma unroll
        for (int i = 0; i < 32; ++i) { const float fl = h2f(r.fl[i]); const float sg = __builtin_amdgcn_rcpf(1.0f + __expf(-fl)); const float f = lb + (1.0f - lb) * sg;
            kk[i] = (1.0f - lb) * (1.0f - sg); run += __logf(f); cs[i] = run; }
        HLAS float* TOT = (HLAS float*)(L + A_TOT);
        TOT[qt * 128 + d] = run;
        HG_BAR();
        const float t0 = TOT[d], t1 = TOT[128 + d], t2 = TOT[256 + d], t3 = TOT[384 + d];
        const float pre = (qt > 0 ? t0 : 0.f) + (qt > 1 ? t1 : 0.f) + (qt > 2 ? t2 : 0.f);
        const float blast = ((t0 + t1) + t2) + t3;
        unsigned wv[16];
#pragma unroll
        for (int i = 0; i < 32; i += 2) wv[i >> 1] = pk2(kk[i] * __expf(blast - (pre + cs[i])), kk[i + 1] * __expf(blast - (pre + cs[i + 1])));
        HLAS u32x4* dst = (HLAS u32x4*)(L + A_KST + d * 272 + qt * 64);
#pragma unroll
        for (int j = 0; j < 4; ++j) dst[j] = (u32x4){wv[4 * j], wv[4 * j + 1], wv[4 * j + 2], wv[4 * j + 3]};
        if (qt == 0) ((HLAS float*)(L + A_DECL))[d] = __expf(blast);
        Bsum += blast;
    }
#pragma unroll
    for (int it = 0; it < 4; ++it) { const int idx = tid + it * 512; const int s = idx >> 4, vg = idx & 15; const u32x4 wd = r.iv[it];
#pragma unroll
        for (int j = 0; j < 8; ++j) { const unsigned dw = wd[j >> 1]; *(HLAS u16*)(L + A_IVT + ivtA_off(8 * vg + j, s >> 3) + (s & 7) * 2) = (u16)((j & 1) ? (dw >> 16) : (dw & 0xffffu)); } }
    HG_BAR();
    f32x4 acc[8];
#pragma unroll
    for (int dt = 0; dt < 8; ++dt) acc[dt] = (f32x4){0.f, 0.f, 0.f, 0.f};
#pragma unroll
    for (int ks = 0; ks < 4; ++ks) {
        const bf16x8 Y = *(const HLAS bf16x8*)(L + A_IVT + ivtA_off(16 * w + lr, 4 * ks + kq));
#pragma unroll
        for (int dt = 0; dt < 8; ++dt) { const bf16x8 X = *(const HLAS bf16x8*)(L + A_KST + (16 * dt + lr) * 272 + (32 * ks + 8 * kq) * 2); acc[dt] = HG_MFMA(X, Y, acc[dt]); }
    }
    const HLAS f32x4* dl = (const HLAS f32x4*)(L + A_DECL);
#pragma unroll
    for (int dt = 0; dt < 8; ++dt) S[dt] = dl[4 * dt + kq] * S[dt] + acc[dt];
    HG_BAR();
}
__device__ __forceinline__ void phaseA_all(HLAS unsigned char* L, const Tensors& T, int u0, int cnt, int tid) {
    const int lane = tid & 63, w = tid >> 6, lr = lane & 15, kq = lane >> 4, blk = u0 >> 4, bh = blk >> 3, b = bh >> 3, h = bh & 7;
    const size_t row0 = (size_t)b * 8192 + (size_t)(blk & 7) * 1024;
    const int nu = cnt >> 1;
    f32x4 S[8]; float Bsum = 0.f;
#pragma unroll
    for (int dt = 0; dt < 8; ++dt) S[dt] = (f32x4){0.f, 0.f, 0.f, 0.f};
    RawA cur; load_rawA(T, row0, h, tid, cur);
    for (int i = 0; i < nu; ++i) { RawA nxt; load_rawA(T, row0 + (size_t)128 * (i + 1 < nu ? i + 1 : i), h, tid, nxt); phaseA_unit128(L, T, h, tid, cur, S, Bsum); cur = nxt; }
    u16* sp = T.SFC + ((size_t)blk * 128 + 16 * w + lr) * 128 + 4 * kq;
#pragma unroll
    for (int dt = 0; dt < 8; ++dt) *(u32x2*)(sp + 16 * dt) = (u32x2){pk2(S[dt][0], S[dt][1]), pk2(S[dt][2], S[dt][3])};
    if ((tid >> 7) == 0) T.PB[(size_t)blk * 128 + (tid & 127)] = __expf(Bsum);
}
__device__ __forceinline__ void phaseC_all(HLAS unsigned char* L, const Tensors& T, int u0, int cnt, int tid) {
    const int lane = tid & 63, w = tid >> 6, lr = lane & 15, kq = lane >> 4, blk = u0 >> 4;
    const int kb = blk & 7, blk0 = blk - kb;
    f32x4 S[8];
#pragma unroll
    for (int dt = 0; dt < 8; ++dt) S[dt] = (f32x4){0.f, 0.f, 0.f, 0.f};
    for (int j = 0; j < kb; ++j) {
        const u16* sf = T.SFC + ((size_t)(blk0 + j) * 128 + 16 * w + lr) * 128 + 4 * kq; const float* pb = T.PB + (size_t)(blk0 + j) * 128 + 4 * kq;
#pragma unroll
        for (int dt = 0; dt < 8; ++dt) { const u32x2 s2 = *(const u32x2*)(sf + 16 * dt); const f32x4 p = *(const f32x4*)(pb + 16 * dt);
            S[dt] = p * S[dt] + (f32x4){bf2f(s2.x & 0xffffu), bf2f(s2.x >> 16), bf2f(s2.y & 0xffffu), bf2f(s2.y >> 16)}; }
    }
    Raw<false> cur; load_raw<false>(T, u0, tid, cur);
    for (int i = 0; i < cnt; ++i) { Raw<false> nxt; load_raw<false>(T, u0 + (i + 1 < cnt ? i + 1 : i), tid, nxt); phaseC_unit(L, T, u0 + i, tid, cur, S); cur = nxt; }
}
}

namespace cg = cooperative_groups;
constexpr int NWAVES = 8;
constexpr int BATCH = 4, T = 8192, D = 1024, H = 16, HD = 64, FF = 2816, FF2 = 5632;
constexpr int M = BATCH * T;
constexpr float RMS_EPS = 1e-6f;
constexpr size_t MiB = 1u << 20;
constexpr size_t WS_WQKV = 1 * MiB;
constexpr size_t WS_WO = WS_WQKV + (size_t)3328 * 1024 * 2;
constexpr size_t WS_WUP0 = WS_WO + (size_t)1024 * 1024 * 2;
constexpr size_t WS_WDN0 = WS_WUP0 + (size_t)5632 * 1024 * 2;
constexpr size_t WS_WHIN = WS_WDN0 + (size_t)1024 * 2816 * 2;
constexpr size_t WS_WHO = WS_WHIN + (size_t)4096 * 1024 * 2;
constexpr size_t WS_WUP1 = WS_WHO + (size_t)1024 * 1024 * 2;
constexpr size_t WS_WDN1 = WS_WUP1 + (size_t)5632 * 1024 * 2;
constexpr size_t WS_WEND = WS_WDN1 + (size_t)1024 * 2816 * 2;
constexpr size_t WS_SSQ = 54 * MiB;
constexpr size_t WS_BIG = 56 * MiB;
constexpr size_t WS_Q = WS_BIG, WS_K = WS_BIG + 64 * MiB, WS_V = WS_BIG + 128 * MiB;
constexpr size_t WS_U = WS_BIG;
constexpr size_t WS_HLF = WS_BIG, WS_HQ = WS_BIG + 64 * MiB, WS_HI = WS_BIG + 128 * MiB, WS_HG = WS_BIG + 192 * MiB, WS_US = WS_BIG + 256 * MiB;
constexpr size_t WS_XN = 312 * MiB;
constexpr size_t WS_UH = 240 * MiB;
constexpr size_t WS_LFT = 504 * MiB;
constexpr size_t WS_DEC = 506 * MiB;
constexpr size_t WS_LB = 53 * MiB;
constexpr size_t WS_CWB = 53 * MiB + 65536;
constexpr size_t WS_PROBE = 53 * MiB + 262144;
constexpr size_t WS_BARW = WS_PROBE + 65536;
constexpr size_t WS_RB = 440 * MiB;
constexpr size_t WS_OG = WS_HQ;
constexpr size_t WS_SFC = 504 * MiB;
constexpr size_t WS_PB = 55 * MiB;
constexpr size_t WS_END = 512 * MiB;
static_assert(WS_WEND <= WS_LB && WS_BARW + 65536 <= WS_BIG && WS_U + (size_t)M * FF * 2 <= WS_UH && WS_UH + (size_t)128 * 4 * FF2 * 4 <= WS_XN && WS_V + 64 * MiB <= WS_XN && WS_HG + 64 * MiB <= WS_XN && WS_US + 128 * MiB <= WS_RB && WS_RB + 64 * MiB <= WS_LFT && WS_SFC + 8 * MiB <= WS_END && WS_SSQ + (size_t)M * 16 <= WS_PB && WS_PB + 131072 <= WS_BIG, "d_ws map");
static_assert(WS_HQ == WS_HLF + 64 * MiB && WS_HI == WS_HLF + 128 * MiB && WS_HG == WS_HLF + 192 * MiB, "EpiHgrn buffer order");
constexpr int LDS_BYTES = 155648;
constexpr int LDS_XH = pg8::STAGE_BYTES, LDS_TAPL = LDS_XH + 16384, LDS_RSL = LDS_TAPL + 4096;
static_assert(LDS_RSL + 2048 <= LDS_BYTES - 64, "epilogue LDS areas");
static_assert(attn_body::ATTN_LDS_BYTES <= LDS_BYTES && hg::L_END <= LDS_BYTES && pg8::STAGE_BYTES <= LDS_BYTES, "LDS map");

#define LAS __attribute__((address_space(3)))
typedef unsigned short bf16;
typedef unsigned v4u __attribute__((ext_vector_type(4)));
typedef float f32x4 __attribute__((ext_vector_type(4)));
typedef float pk_f32x2 __attribute__((ext_vector_type(2))); typedef __bf16 pk_bf16x2 __attribute__((ext_vector_type(2)));
__device__ __forceinline__ unsigned pk2(float lo, float hi) { const pk_f32x2 v = {lo, hi}; return __builtin_bit_cast(unsigned, __builtin_convertvector(v, pk_bf16x2)); }
__device__ __forceinline__ unsigned f2bf(float f) { return pk2(f, f) & 0xffffu; }
__device__ __forceinline__ float wave_sum(float v) {
#pragma unroll
    for (int o = 1; o < 64; o <<= 1) v += __shfl_xor(v, o);
    return v;
}
__device__ __forceinline__ void transpose_item(const float* W, int ldw, int K, int nblk, bf16* WT, LAS float* scr, int item, int lane, bool perm_up = false, const float* gain = nullptr) {
    const int kb = item / nblk, nb = item % nblk, k0 = 64 * kb, n0 = 32 * nb;
    const int n0p = !perm_up ? n0 : (n0 < FF ? 256 * (n0 / 128) + (n0 % 128) : 256 * ((n0 - FF) / 128) + 128 + ((n0 - FF) % 128));
#pragma unroll 8
    for (int i = 0; i < 32; ++i) { const int kk = 2 * i + (lane >> 5); scr[kk * 33 + (lane & 31)] = W[(size_t)(k0 + kk) * ldw + n0 + (lane & 31)] * (gain ? gain[k0 + kk] : 1.0f); }
    asm volatile("s_waitcnt lgkmcnt(0)" ::: "memory");
    const int c = lane & 7;
#pragma unroll
    for (int j = 0; j < 4; ++j) { const int n = (lane >> 3) + 8 * j; const LAS float* s = scr + (8 * c) * 33 + n;
        v4u o; o.x = pk2(s[0 * 33], s[1 * 33]); o.y = pk2(s[2 * 33], s[3 * 33]); o.z = pk2(s[4 * 33], s[5 * 33]); o.w = pk2(s[6 * 33], s[7 * 33]);
        *(v4u*)(WT + (size_t)(n0p + n) * K + k0 + 8 * c) = o; }
    asm volatile("s_waitcnt lgkmcnt(0)" ::: "memory");
}
__device__ __forceinline__ void norm_rows_bf16(const float* src, const float* g, bf16* dst, int gw, int NGW, int lane) {
    f32x4 gg[4];
#pragma unroll
    for (int j = 0; j < 4; ++j) gg[j] = ((const f32x4*)g)[lane + 64 * j];
    for (int m = gw; m < M; m += NGW) {
        const f32x4* xr = (const f32x4*)(src + (size_t)m * D) + lane; f32x4 v[4]; float s = 0.f;
#pragma unroll
        for (int j = 0; j < 4; ++j) { v[j] = xr[64 * j]; s += (v[j].x * v[j].x + v[j].y * v[j].y) + (v[j].z * v[j].z + v[j].w * v[j].w); }
        const float rstd = 1.0f / sqrtf(wave_sum(s) * (1.0f / D) + RMS_EPS);
        unsigned long long* o8 = (unsigned long long*)(dst + (size_t)m * D) + lane;
#pragma unroll
        for (int j = 0; j < 4; ++j) o8[64 * j] = (unsigned long long)pk2(v[j].x * rstd * gg[j].x, v[j].y * rstd * gg[j].y) | ((unsigned long long)pk2(v[j].z * rstd * gg[j].z, v[j].w * rstd * gg[j].w) << 32);
    }
}
__device__ __forceinline__ float ubf_lo(unsigned w) { return __builtin_bit_cast(float, w << 16); }
__device__ __forceinline__ float ubf_hi(unsigned w) { return __builtin_bit_cast(float, w & 0xffff0000u); }
template <bool OUT_F32> __device__ __forceinline__ void norm_rows_rb(const bf16* src, const float* g, void* dstv, int gw, int NGW, int lane) {
    f32x4 gg[4];
#pragma unroll
    for (int j = 0; j < 4; ++j) gg[j] = *(const f32x4*)(g + (j >> 1) * 512 + 8 * lane + (j & 1) * 4);
    for (int m = gw; m < M; m += NGW) {
        const v4u a = *(const v4u*)(src + (size_t)m * D + 8 * lane), b = *(const v4u*)(src + (size_t)m * D + 512 + 8 * lane);
        f32x4 v[4] = {(f32x4){ubf_lo(a.x), ubf_hi(a.x), ubf_lo(a.y), ubf_hi(a.y)}, (f32x4){ubf_lo(a.z), ubf_hi(a.z), ubf_lo(a.w), ubf_hi(a.w)},
                      (f32x4){ubf_lo(b.x), ubf_hi(b.x), ubf_lo(b.y), ubf_hi(b.y)}, (f32x4){ubf_lo(b.z), ubf_hi(b.z), ubf_lo(b.w), ubf_hi(b.w)}};
        float s = 0.f;
#pragma unroll
        for (int j = 0; j < 4; ++j) s += (v[j].x * v[j].x + v[j].y * v[j].y) + (v[j].z * v[j].z + v[j].w * v[j].w);
        const float rstd = 1.0f / sqrtf(wave_sum(s) * (1.0f / D) + RMS_EPS);
#pragma unroll
        for (int j = 0; j < 4; ++j) v[j] = v[j] * rstd * gg[j];
        if (OUT_F32) { float* o = (float*)dstv + (size_t)m * D + 8 * lane;
            *(f32x4*)o = v[0]; *(f32x4*)(o + 4) = v[1]; *(f32x4*)(o + 512) = v[2]; *(f32x4*)(o + 516) = v[3];
        } else { bf16* o = (bf16*)dstv + (size_t)m * D + 8 * lane;
            *(v4u*)o = (v4u){pk2(v[0].x, v[0].y), pk2(v[0].z, v[0].w), pk2(v[1].x, v[1].y), pk2(v[1].z, v[1].w)};
            *(v4u*)(o + 512) = (v4u){pk2(v[2].x, v[2].y), pk2(v[2].z, v[2].w), pk2(v[3].x, v[3].y), pk2(v[3].z, v[3].w)}; }
    }
}
__device__ __forceinline__ float bfs(const bf16* p) { return __builtin_bit_cast(float, (unsigned)(*p) << 16); }
__device__ __forceinline__ void conv_fixup(bf16* ACT, const float* UHf, const bf16* CWB, int pm, int tid) {
    const float* cur = UHf + ((size_t)pm * 2 + 0) * 2 * FF2;
    const float* prv = UHf + ((size_t)(pm - 1) * 2 + 1) * 2 * FF2;
    const bool seq0 = (pm & 31) == 0;
    for (int task = tid; task < 704; task += 512) {
        const int r = task / 352, g = task % 352, pn = g >> 4, cl0 = (g & 15) * 8, gc0 = pn * 128 + cl0, pc = pn * 256 + cl0;
        float a[8];
#pragma unroll
        for (int e = 0; e < 8; ++e) { float y[2];
#pragma unroll
            for (int bj = 0; bj < 2; ++bj) { const int pcb = pc + 128 * bj + e, col = bj * FF + gc0 + e;
                const float u0 = cur[pcb], u1 = cur[FF2 + pcb], p254 = seq0 ? 0.f : prv[pcb], p255 = seq0 ? 0.f : prv[FF2 + pcb];
                const float x = r == 0 ? u0 : u1, x1 = r == 0 ? p255 : u0, x2 = r == 0 ? p254 : p255;
                y[bj] = bfs(CWB + 3 * FF2 + col) + bfs(CWB + col) * x2 + bfs(CWB + FF2 + col) * x1 + bfs(CWB + 2 * FF2 + col) * x; }
            a[e] = y[0] * __builtin_amdgcn_rcpf(1.0f + __expf(-y[0])) * y[1]; }
        v4u o; o.x = pk2(a[0], a[1]); o.y = pk2(a[2], a[3]); o.z = pk2(a[4], a[5]); o.w = pk2(a[6], a[7]);
        *(v4u*)(ACT + (size_t)(pm * 256 + r) * FF + gc0) = o;
    }
}
typedef __attribute__((address_space(1))) unsigned gu32;
#define XB_TMO      128
#define XB_XCNT(j)  (256  + 64 * (j))
#define XB_XSUB(j)  (1280 + 64 * (j))
#define XB_XGEN(j)  (2304 + 64 * (j))
#define XB_TOP      3328
#define XB_TOPGEN   3392
#define XCD_BAR_WORDS 3456
#define XB_SPIN_CAP (1u << 18)

__device__ __forceinline__ unsigned xb_ld(unsigned* p)              { return __hip_atomic_load(p, __ATOMIC_RELAXED, __HIP_MEMORY_SCOPE_AGENT); }
__device__ __forceinline__ unsigned xb_add(unsigned* p, unsigned v) { return __hip_atomic_fetch_add(p, v, __ATOMIC_RELAXED, __HIP_MEMORY_SCOPE_AGENT); }
__device__ __forceinline__ unsigned xb_xcc_id() { return (unsigned)__builtin_amdgcn_s_getreg((3 << 11) | 20) & 0xFu; }
#define XB_SPIN(cond, bar) do { unsigned _sp = 0; while (cond) { __builtin_amdgcn_s_sleep(1); \
    if ((++_sp & 255u) == 0u) { if (xb_ld(&(bar)[XB_TMO])) break; if (_sp > XB_SPIN_CAP) { atomicAdd(&(bar)[XB_TMO], 1u); break; } } } } while (0)

struct XcdBarrier {
    unsigned* bar; unsigned x;
    volatile LAS unsigned* st;
};

__device__ __forceinline__ XcdBarrier xcd_barrier_post(unsigned* bar, volatile LAS unsigned* st) {
    XcdBarrier b; b.bar = bar; b.x = xb_xcc_id(); b.st = st;
    if (threadIdx.x == 0) (void)xb_add(&bar[XB_XCNT(b.x)], 1u);
    return b;
}
__device__ __forceinline__ void xcd_barrier_complete(unsigned* bar, unsigned x, unsigned& nloc, unsigned& nx) {
    const unsigned G = gridDim.x * gridDim.y * gridDim.z;
    unsigned sum, cnt, mine, sp = 0u;
    for (;;) {
        sum = 0u; cnt = 0u; mine = 0u;
#pragma unroll
        for (unsigned j = 0; j < 16; ++j) { const unsigned c = xb_ld(&bar[XB_XCNT(j)]); sum += c; cnt += (c > 0u) ? 1u : 0u; mine = (j == x) ? c : mine; }
        if (sum == G) break;
        __builtin_amdgcn_s_sleep(1);
        if ((++sp & 255u) == 0u) { if (xb_ld(&bar[XB_TMO])) break; if (sp > XB_SPIN_CAP) { atomicAdd(&bar[XB_TMO], 1u); break; } }
    }
    nloc = mine > 0u ? mine : 1u; nx = cnt > 0u ? cnt : 1u;
}

__device__ __forceinline__ void xcd_barrier(const XcdBarrier& b) {
    asm volatile("s_waitcnt vmcnt(0)" ::: "memory");
    __syncthreads();
    if (threadIdx.x == 0) {
        unsigned* bar = b.bar;
        __builtin_amdgcn_s_waitcnt(0);
        unsigned nloc = b.st[0], nx = b.st[1];
        if (nloc == 0u) { xcd_barrier_complete(bar, b.x, nloc, nx); b.st[0] = nloc; b.st[1] = nx; }
        const unsigned old = xb_add(&bar[XB_XSUB(b.x)], 1u);
        const unsigned gen = old / nloc;
        if (old + 1u == (gen + 1u) * nloc) {
            __builtin_amdgcn_fence(__ATOMIC_RELEASE, "agent");
            asm volatile("s_waitcnt vmcnt(0)" ::: "memory");
            const unsigned og = xb_add(&bar[XB_TOP], 1u);
            const unsigned tg = og / nx;
            if (og + 1u == (tg + 1u) * nx) xb_add(&bar[XB_TOPGEN], 1u);
            else XB_SPIN(xb_ld(&bar[XB_TOPGEN]) == tg, bar);
            __builtin_amdgcn_fence(__ATOMIC_ACQUIRE, "agent");
            xb_add(&bar[XB_XGEN(b.x)], 1u);
            asm volatile("s_waitcnt vmcnt(0)" ::: "memory");
        } else {
            XB_SPIN(xb_ld(&bar[XB_XGEN(b.x)]) == gen, bar);
            __builtin_amdgcn_fence(__ATOMIC_ACQUIRE, "agent");
            asm volatile("s_waitcnt vmcnt(0)" ::: "memory");
        }
    }
    __syncthreads();
}

__device__ __forceinline__ void norm16_fl(const float* x, const float* g, bf16* XN, const LAS unsigned char* WFL, const float* b_f, float* LFt, int gw, int lane) {
    f32x4 gg[4];
#pragma unroll
    for (int j = 0; j < 4; ++j) gg[j] = ((const f32x4*)g)[lane + 64 * j];
    for (int r = 0; r < 16; ++r) { const int m = 16 * gw + r;
        const f32x4* xr = (const f32x4*)(x + (size_t)m * D) + lane; f32x4 v[4]; float s = 0.f;
#pragma unroll
        for (int j = 0; j < 4; ++j) { v[j] = xr[64 * j]; s += (v[j].x * v[j].x + v[j].y * v[j].y) + (v[j].z * v[j].z + v[j].w * v[j].w); }
        const float rstd = 1.0f / sqrtf(wave_sum(s) * (1.0f / D) + RMS_EPS);
        unsigned long long* o8 = (unsigned long long*)(XN + (size_t)m * D) + lane;
#pragma unroll
        for (int j = 0; j < 4; ++j) o8[64 * j] = (unsigned long long)pk2(v[j].x * rstd * gg[j].x, v[j].y * rstd * gg[j].y) | ((unsigned long long)pk2(v[j].z * rstd * gg[j].z, v[j].w * rstd * gg[j].w) << 32);
    }
    asm volatile("s_waitcnt vmcnt(0)" ::: "memory");
    const int lr = lane & 15, kq = lane >> 4;
    const bf16* arow = XN + (size_t)(16 * gw + lr) * D + 8 * kq;
    f32x4 acc = (f32x4){0.f, 0.f, 0.f, 0.f};
    hg::bf16x8 XA[32];
#pragma unroll
    for (int ks = 0; ks < 32; ++ks) XA[ks] = *(const hg::bf16x8*)(arow + 32 * ks);
    f32x4 acc2 = (f32x4){0.f, 0.f, 0.f, 0.f};
#pragma unroll
    for (int ks = 0; ks < 32; ks += 2) { const hg::bf16x8 Y0 = *(const LAS hg::bf16x8*)(WFL + lr * 2064 + (32 * ks + 8 * kq) * 2), Y1 = *(const LAS hg::bf16x8*)(WFL + lr * 2064 + (32 * ks + 32 + 8 * kq) * 2);
        acc = HG_MFMA(XA[ks], Y0, acc); acc2 = HG_MFMA(XA[ks + 1], Y1, acc2); }
    acc = acc + acc2;
    const int t0 = 16 * gw + 4 * kq, b = t0 >> 13, t = t0 & (T - 1); const float bias = b_f[lr];
    f32x4 lf;
#pragma unroll
    for (int e = 0; e < 4; ++e) { const float z = acc[e] + bias; lf[e] = fminf(z, 0.f) - log1pf(__expf(-fabsf(z))); }
    *(f32x4*)(LFt + (size_t)(b * 16 + lr) * T + t) = lf;
}
template <class T> __device__ __forceinline__ T* opq(T* p) { asm volatile("" : "+s"(p)); return p; }
struct Args { const float* in[16]; float* out; unsigned char* ws; };
#if defined(UP_PLAIN)
#define UP_PLAIN_PROBE() do { pg8::Gemm g2{opq(XN), opq((bf16*)(ws + WS_WUP0)), M, FF2, 1024, 1024}; pg8::StaticOrder S2; S2.init(M, FF2, G, bx); pg8::EpiDummy E2{(bf16*)(ws + WS_BIG + 176 * MiB)}; \
    pg8::gemm_phase<pg8::EpiDummy, pg8::StaticOrder, true, true>(L, g2, S2, E2); } while (0)
#else
#define UP_PLAIN_PROBE() do { } while (0)
#endif
#ifndef REP_WO
#define REP_WO 1
#endif
#ifndef REP_HGA
#define REP_HGA 1
#endif
#ifndef REP_NORM
#define REP_NORM 1
#endif
#ifndef REP_UP
#define REP_UP 1
#endif
#ifndef REP_QKV
#define REP_QKV 1
#endif
#ifndef REP_HIN
#define REP_HIN 1
#endif
#if defined(PROBE_A)
#define SYNC_STAMP() do { xcd_barrier(bar); if (bx == 0 && tid == 0) ((unsigned long long*)(ws + WS_PROBE))[nst] = __builtin_amdgcn_s_memrealtime(); ++nst; } while (0)
#else
#define SYNC_STAMP() xcd_barrier(bar)
#endif
__global__ void __launch_bounds__(NWAVES * 64, 2) fwd_kernel(Args args) {
    extern __shared__ __attribute__((aligned(16))) unsigned char lds[];
    cg::grid_group grid = cg::this_grid();
    LAS unsigned char* L = (LAS unsigned char*)lds;
#define FRESH_TID() ({ int t_ = threadIdx.x; asm volatile("" : "+v"(t_)); t_; })
    const int tid = threadIdx.x, lane = tid & 63, wave = __builtin_amdgcn_readfirstlane(tid >> 6);
    const int G = gridDim.x, bx = blockIdx.x; const int vcu = (G % 8 == 0) ? (bx % 8) * (G / 8) + bx / 8 : bx;
    const int gw = vcu * NWAVES + wave, NGW = G * NWAVES;
    unsigned char* ws = args.ws;
    const float* x = args.in[0]; float* out = args.out;
    bf16* Wqkv_t = (bf16*)(ws + WS_WQKV); bf16* Wo_t = (bf16*)(ws + WS_WO); bf16* Whin_t = (bf16*)(ws + WS_WHIN); bf16* Who_t = (bf16*)(ws + WS_WHO);
    bf16* XN = (bf16*)(ws + WS_XN); bf16* QO = (bf16*)(ws + WS_Q); bf16* U = (bf16*)(ws + WS_U); float* UHf = (float*)(ws + WS_UH);
    float* LFt = (float*)(ws + WS_LFT); bf16* RB = (bf16*)(ws + WS_RB); float* SSQ = (float*)(ws + WS_SSQ);

    int nst = 1;
    if (tid < 2) ((volatile LAS unsigned*)(L + LDS_BYTES - 64))[tid] = 0u;
    __syncthreads();
#if defined(PROBE_A)
    if (bx == 0 && tid == 0) ((unsigned long long*)(ws + WS_PROBE))[0] = __builtin_amdgcn_s_memrealtime();
#endif
    {
        LAS float* scr = (LAS float*)(L + wave * 8704);
        constexpr int WFL_OFF = 8 * 8704;
        { const int t_ = tid;
#pragma unroll
          for (int kk = 0; kk < 2; ++kk) { const int k = 2 * t_ + kk; const f32x4* wp = (const f32x4*)(args.in[2] + (size_t)k * 3088 + 3072);
#pragma unroll
              for (int q4 = 0; q4 < 4; ++q4) { const f32x4 wv = wp[q4];
#pragma unroll
                  for (int e = 0; e < 4; ++e) *(LAS unsigned short*)(L + WFL_OFF + (4 * q4 + e) * 2064 + k * 2) = (unsigned short)f2bf(wv[e]); } }
          __syncthreads(); }
        constexpr int I_QKV = 16 * 96, I_O = 16 * 32, I_UP = 16 * 176, I_DN = 44 * 32, I_HIN = 16 * 128;
        constexpr int NITEMS = I_QKV + 2 * I_O + 2 * I_UP + 2 * I_DN + I_HIN;
#ifndef REP_PRO
#define REP_PRO 1
#endif
        for (int rep = 0; rep < REP_PRO; ++rep)
        for (int it = gw; it < NITEMS; it += NGW) {
            int r = it;
            if (r < I_QKV) { transpose_item(args.in[2], 3088, 1024, 96, Wqkv_t, scr, r, lane); continue; } r -= I_QKV;
            if (r < I_O) { transpose_item(args.in[4], 1024, 1024, 32, Wo_t, scr, r, lane); continue; } r -= I_O;
            if (r < I_O) { transpose_item(args.in[9], 1024, 1024, 32, Who_t, scr, r, lane); continue; } r -= I_O;
            if (r < I_HIN) { transpose_item(args.in[6], 4096, 1024, 128, Whin_t, scr, r, lane, false, args.in[5]); continue; } r -= I_HIN;
            if (r < I_UP) { transpose_item(args.in[11], FF2, 1024, 176, (bf16*)(ws + WS_WUP0), scr, r, lane, true, args.in[10]); continue; } r -= I_UP;
            if (r < I_UP) { transpose_item(args.in[11] + (size_t)1024 * FF2, FF2, 1024, 176, (bf16*)(ws + WS_WUP1), scr, r, lane, true, args.in[10] + 1024); continue; } r -= I_UP;
            if (r < I_DN) { transpose_item(args.in[14], 1024, FF, 32, (bf16*)(ws + WS_WDN0), scr, r, lane); continue; } r -= I_DN;
            transpose_item(args.in[14] + (size_t)FF * 1024, 1024, FF, 32, (bf16*)(ws + WS_WDN1), scr, r, lane);
        }
        for (int i = bx * 512 + tid; i < 2 * 4 * FF2; i += G * 512) { const int l = i / (4 * FF2), k = (i / FF2) & 3, c = i % FF2;
            ((bf16*)(ws + WS_CWB))[i] = (bf16)f2bf(k < 3 ? args.in[12][(size_t)(l * 3 + k) * FF2 + c] : args.in[13][(size_t)l * FF2 + c]); }
        if (bx == 0) for (int c = tid; c < 1024; c += 512) ((float*)(ws + WS_LB))[c] = 1.0f / (1.0f + expf(args.in[7][c] - args.in[7][1024 + c]));
        norm16_fl(x, args.in[1], XN, L + WFL_OFF, args.in[3], LFt, gw, lane);
        if (bx == 0) for (int i = tid; i < XCD_BAR_WORDS; i += 512) ((unsigned*)(ws + WS_BARW))[i] = 0u;
    }
    grid.sync();
    const XcdBarrier bar = xcd_barrier_post((unsigned*)(ws + WS_BARW), (volatile LAS unsigned*)(L + LDS_BYTES - 64));
#if defined(PROBE_A)
    if (bx == 0 && tid == 0) ((unsigned long long*)(ws + WS_PROBE))[nst] = __builtin_amdgcn_s_memrealtime();
#endif
    ++nst;

    { pg8::Gemm g{opq(XN), opq(Wqkv_t), M, 3072, 1024, 1024}; pg8::StaticOrder S; S.init(M, 3072, G, bx);
      pg8::EpiQKV E{QO, LFt, args.in[3], attn_body::C2};
#ifndef NO_EPIQKV_1
      for (int rep = 0; rep < REP_QKV; ++rep) pg8::gemm_phase<pg8::EpiQKV, pg8::StaticOrder, true, true>(L, g, S, E);
#endif
    }
    SYNC_STAMP();
#ifndef REP_ATT
#define REP_ATT 1
#define ATT_O QO
#else
#define ATT_O XN
#endif
    { const attn_body::AttnTensors AT{(const attn_body::bf16*)QO, (const attn_body::bf16*)(ws + WS_K), (const attn_body::bf16*)(ws + WS_V), (attn_body::bf16*)ATT_O, LFt};
      const attn_body::StaticOrder S(G, vcu);
#ifndef NO_ATTN
      for (int rep = 0; rep < REP_ATT; ++rep) attn_body::attn_phase<attn_body::StaticOrder>((char*)lds, AT, S);
#endif
    }
    SYNC_STAMP();
#define LAYER_TAIL(LY, AOP, BOP, BASE) do { \
    { pg8::Gemm g{opq(AOP), opq(BOP), M, 1024, 1024, 1024}; pg8::StaticOrder S; S.init(M, 1024, G, bx); \
      pg8::EpiRes E{BASE, (BASE) ? (const bf16*)nullptr : (const bf16*)RB, RB, SSQ, (LAS float*)(L + LDS_XH)}; \
      for (int rep = 0; rep < ((LY) == 0 ? REP_WO : 1); ++rep) pg8::gemm_phase<pg8::EpiRes, pg8::StaticOrder, true, true>(L, g, S, E); } \
    SYNC_STAMP(); \
    { pg8::Gemm g{opq(RB), opq((bf16*)(ws + ((LY) == 0 ? WS_WUP0 : WS_WUP1))), M, FF2, 1024, 1024}; pg8::StaticOrder S; S.init(M, FF2, G, bx); \
      pg8::EpiUpConv E{U, UHf, (const bf16*)(ws + WS_CWB) + (LY) * 4 * FF2, (LAS pg8::f32x4*)(L + LDS_XH), L + LDS_TAPL, SSQ, (LAS float*)(L + LDS_RSL)}; \
      { pg8::Unit u0; const int t_ = FRESH_TID(); if (S.next(0, u0) && t_ < 256) { const int k = t_ >> 6, ch = (t_ & 63) * 4;     \
          *(LAS pg8::u32x2_e*)(L + LDS_TAPL + k * 512 + (t_ & 63) * 8) = *(const pg8::u32x2_e*)((const bf16*)(ws + WS_CWB) + (LY) * 4 * FF2 + k * FF2 + (ch < 128 ? u0.pn * 128 + ch : FF + u0.pn * 128 + (ch - 128))); } \
        if (S.next(0, u0)) pg8::rstd_commit((LAS float*)(L + LDS_RSL), 0, t_, pg8::rstd_issue(SSQ, u0.pm, t_));     \
        __syncthreads(); } \
      for (int rep = 0; rep < REP_UP; ++rep) pg8::gemm_phase<pg8::EpiUpConv, pg8::StaticOrder, true, true>(L, g, S, E); } \
    UP_PLAIN_PROBE(); \
    SYNC_STAMP(); \
    { pg8::Gemm g{opq(U), opq((bf16*)(ws + ((LY) == 0 ? WS_WDN0 : WS_WDN1))), M, 1024, FF, FF}; pg8::StaticOrder S; S.init(M, 1024, G, bx); \
      { pg8::Unit fu; for (int i = 0; S.next(i, fu); ++i) conv_fixup(U, UHf, (const bf16*)(ws + WS_CWB) + (LY) * 4 * FF2, fu.pm, FRESH_TID()); \
        asm volatile("s_waitcnt vmcnt(0)" ::: "memory"); __syncthreads(); } \
      pg8::EpiRes E{(const float*)nullptr, RB, RB, SSQ, (LAS float*)(L + LDS_XH)}; \
      pg8::gemm_phase<pg8::EpiRes, pg8::StaticOrder, true, true>(L, g, S, E); } \
    SYNC_STAMP(); } while (0)
    LAYER_TAIL(0, ATT_O, Wo_t, x);
    { pg8::Gemm g{opq(RB), opq(Whin_t), M, 4096, 1024, 1024}; pg8::StaticOrder S; S.init(M, 4096, G, bx);
      pg8::EpiHgrn E{(bf16*)(ws + WS_HLF), SSQ, (LAS float*)(L + LDS_RSL)};
      { pg8::Unit u0; const int t_ = FRESH_TID(); if (S.next(0, u0)) pg8::rstd_commit((LAS float*)(L + LDS_RSL), 0, t_, pg8::rstd_issue(SSQ, u0.pm, t_)); __syncthreads(); }
      for (int rep = 0; rep < REP_HIN; ++rep) pg8::gemm_phase<pg8::EpiHgrn, pg8::StaticOrder, true, true>(L, g, S, E); }
    SYNC_STAMP();
    { const hg::Tensors HT{(const hg::u16*)(ws + WS_HLF), (const hg::u16*)(ws + WS_HQ), (const hg::u16*)(ws + WS_HI), (const hg::u16*)(ws + WS_HG), (hg::u16*)(ws + WS_US), (float*)(ws + WS_DEC), args.in[8], (const float*)(ws + WS_LB), (hg::u16*)(ws + WS_OG), (hg::u16*)(ws + WS_SFC), (float*)(ws + WS_PB)};
      const int upw = hg::NUNITS / G;
#ifndef NO_HGA
      for (int rep = 0; rep < REP_HGA; ++rep) hg::phaseA_all(L, HT, vcu * upw, upw, FRESH_TID());
#endif
      SYNC_STAMP();
#ifndef NO_HGC
#ifndef REP_HGC
#define REP_HGC 1
#endif
      for (int rep = 0; rep < REP_HGC; ++rep) hg::phaseC_all(L, HT, vcu * upw, upw, FRESH_TID());
#endif
      SYNC_STAMP(); }
    LAYER_TAIL(1, (bf16*)(ws + WS_OG), Who_t, (const float*)nullptr);
#if defined(PROBE_A)
    if (bx == 0 && tid == 0) { const unsigned long long* ts = (const unsigned long long*)(ws + WS_PROBE); float fa = 0.f, fb = 0.f;
        for (int i = 1; i < nst; ++i) { const float d = (float)(ts[i] - ts[i - 1]) * (1.0f / 400000.0f); if ((PROBE_A >> i) & 1) fa += d; if ((PROBE_B >> i) & 1) fb += d; }
        ((float*)(ws + WS_PROBE + 1024))[0] = fa; ((float*)(ws + WS_PROBE + 1024))[1] = fb; }
    grid.sync();
    norm_rows_rb<true>(RB, args.in[15], out, gw, NGW, FRESH_TID() & 63);
    grid.sync();
    { const float fa = ((const float*)(ws + WS_PROBE + 1024))[0], fb = ((const float*)(ws + WS_PROBE + 1024))[1];
      for (size_t i = (size_t)bx * 512 + tid; i < (size_t)M * D; i += (size_t)G * 512) out[i] = out[i] * (1.0f + fa) + (i == 0 ? 200.0f * fb : 0.f); }
#else
#if defined(EXTRA_SYNCS)
    for (int i = 0; i < EXTRA_SYNCS; ++i) xcd_barrier(bar);
#endif
    norm_rows_rb<true>(RB, args.in[15], out, gw, NGW, FRESH_TID() & 63);
#endif
}

extern "C" void kernel_launch(void* const* d_in, const int* in_sizes, int n_in, void* d_out, int out_size, void* d_ws, size_t ws_size, hipStream_t stream) {
    static int grid = 0;
    if (grid == 0) {
        if (n_in != 16 || in_sizes[0] != M * D || out_size != M * D || ws_size < WS_END) { fprintf(stderr, "kernel_launch: unexpected shapes / workspace (n_in %d, in0 %d, out %d, ws %zu); nothing launched\n", n_in, n_in > 0 ? in_sizes[0] : -1, out_size, ws_size); grid = -1; return; }
        int dev = 0, cus = 0, per_cu = 0;
        if (hipGetDevice(&dev) != hipSuccess || hipDeviceGetAttribute(&cus, hipDeviceAttributeMultiprocessorCount, dev) != hipSuccess) { grid = -1; return; }
        if (hipFuncSetAttribute((const void*)fwd_kernel, hipFuncAttributeMaxDynamicSharedMemorySize, LDS_BYTES) != hipSuccess) { fprintf(stderr, "kernel_launch: hipFuncSetAttribute failed\n"); grid = -1; return; }
        if (hipOccupancyMaxActiveBlocksPerMultiprocessor(&per_cu, (const void*)fwd_kernel, NWAVES * 64, LDS_BYTES) != hipSuccess || per_cu < 1) { fprintf(stderr, "kernel_launch: occupancy query gives %d\n", per_cu); per_cu = 1; }
        (void)hipGetLastError();
        grid = cus;
        if (grid != 256) { fprintf(stderr, "kernel_launch: built for 256 CUs, device has %d; nothing launched\n", cus); grid = -1; return; }
    }
    if (grid < 0) return;
    Args a{};
    for (int i = 0; i < 16; ++i) a.in[i] = (const float*)d_in[i];
    a.out = (float*)d_out; a.ws = (unsigned char*)d_ws;
    void* kargs[] = {&a};
    const hipError_t e = hipLaunchCooperativeKernel((const void*)fwd_kernel, dim3(grid), dim3(NWAVES * 64), kargs, LDS_BYTES, stream);
    if (e != hipSuccess) fprintf(stderr, "kernel_launch: cooperative launch failed: %s\n", hipGetErrorString(e));
}
```
